# Optimizing an MI355X kernel written in HIP

```python
import math
import jax, jax.numpy as jnp
from jax import lax
import numpy as np

D_MODEL = 4096
BATCH = 1
SEQ = 16384
DEPTH = 4

CHUNK = 64
Q_BLOCK = 128
D_MIX = D_MODEL

GLA_HEADS = 4
GLA_DV = D_MIX // 2 // GLA_HEADS
GLA_DK = GLA_DV // 2
GLA_GATE_RANK = 16
GLA_TAU = 16.0

DIFF_HEADS = 4
DIFF_DV = D_MIX // 4 // DIFF_HEADS
DIFF_DQK = DIFF_DV // 2

SPA_HEADS = 8
SPA_DV = D_MIX // 4 // SPA_HEADS
SPA_LAT = 256
IDX_HEADS = 16
IDX_DIM = 64
IDX_TOPK_MAX = 256

LN_EPS = 1e-5
RMS_EPS = 1e-6

IN_WIDTHS = (
    GLA_HEADS * GLA_DK,
    GLA_HEADS * GLA_DK,
    GLA_HEADS * GLA_DV,
    GLA_GATE_RANK,
    GLA_HEADS * GLA_DV,
    DIFF_HEADS * 2 * DIFF_DQK,
    DIFF_HEADS * 2 * DIFF_DQK,
    DIFF_HEADS * DIFF_DV,
    DIFF_HEADS * DIFF_DV,
    SPA_HEADS * SPA_LAT,
    SPA_LAT,
    IDX_HEADS * IDX_DIM,
    IDX_DIM,
    IDX_HEADS,
    SPA_HEADS * SPA_DV,
)
N_IN = sum(IN_WIDTHS)

kernel_name = "hymba_gla_diff_dsa_deepnorm_trunk"


def _split_points():
    pts, acc = [], 0
    for w in IN_WIDTHS[:-1]:
        acc += w
        pts.append(acc)
    return pts


def _layernorm(x, g, b):
    xf = x.astype(jnp.float32)
    mu = jnp.mean(xf, axis=-1, keepdims=True)
    var = jnp.mean(jnp.square(xf - mu), axis=-1, keepdims=True)
    y = (xf - mu) * lax.rsqrt(var + LN_EPS) * g.astype(jnp.float32) + b.astype(jnp.float32)
    return y.astype(x.dtype)


def _rmsnorm(x, g):
    xf = x.astype(jnp.float32)
    y = xf * lax.rsqrt(jnp.mean(jnp.square(xf), axis=-1, keepdims=True) + RMS_EPS) * g.astype(jnp.float32)
    return y.astype(x.dtype)


def _to_blocks(t, nb):
    b = t.shape[0]
    return jnp.moveaxis(t.reshape(b, nb, Q_BLOCK, *t.shape[2:]), 1, 0)


def _gla(q, k, v, a_lr, w_gate2, b_gate, norm_g):
    f32 = jnp.float32
    bsz, s, _ = q.shape
    nc = s // CHUNK
    shp_k = (bsz, nc, CHUNK, GLA_HEADS, GLA_DK)
    q = q.astype(f32).reshape(shp_k) * (GLA_DK ** -0.5)
    k = k.astype(f32).reshape(shp_k)
    v = v.astype(f32).reshape(bsz, nc, CHUNK, GLA_HEADS, GLA_DV)
    z = (a_lr @ w_gate2 + b_gate).astype(f32)
    log_a = (jax.nn.log_sigmoid(z) / GLA_TAU).reshape(shp_k)
    cum = jnp.cumsum(log_a, axis=2)
    total = cum[:, :, -1]
    k_dec = k * jnp.exp(total[:, :, None] - cum)

    def step(state, inp):
        q_c, k_c, v_c, tot_c = inp
        state = jnp.exp(tot_c)[..., None] * state + jnp.einsum('bchk,bchv->bhkv', k_c, v_c)
        o_c = jnp.einsum('bchk,bhkv->bchv', q_c, state)
        return state, o_c

    xs = (jnp.moveaxis(q, 1, 0), jnp.moveaxis(k_dec, 1, 0), jnp.moveaxis(v, 1, 0), jnp.moveaxis(total, 1, 0))
    s0 = jnp.zeros((bsz, GLA_HEADS, GLA_DK, GLA_DV), f32)
    _, o = lax.scan(step, s0, xs)
    o = jnp.moveaxis(o, 0, 1).reshape(bsz, s, GLA_HEADS, GLA_DV)
    o = _rmsnorm(o, norm_g)
    return o.reshape(bsz, s, GLA_HEADS * GLA_DV)


def _diff_attn(q, k, v, lam_params, norm_g, lam_init):
    bsz, s, _ = q.shape
    nb = s // Q_BLOCK
    q = q.reshape(bsz, s, DIFF_HEADS, 2, DIFF_DQK)
    k = k.reshape(bsz, s, DIFF_HEADS, 2, DIFF_DQK)
    v = v.reshape(bsz, s, DIFF_HEADS, DIFF_DV)
    lp = lam_params.astype(jnp.float32)
    lam = jnp.exp(jnp.sum(lp[0] * lp[1])) - jnp.exp(jnp.sum(lp[2] * lp[3])) + lam_init
    k_chunk = jnp.arange(s) // CHUNK
    scale = DIFF_DQK ** -0.5

    def block(args):
        q_blk, i = args
        q_chunk = (i * Q_BLOCK + jnp.arange(Q_BLOCK)) // CHUNK
        mask = k_chunk[None, :] <= q_chunk[:, None]
        sc = jnp.einsum('bqhmd,bkhmd->bhmqk', q_blk, k).astype(jnp.float32) * scale
        p = jax.nn.softmax(jnp.where(mask, sc, -jnp.inf), axis=-1)
        a = p[:, :, 0] - lam * p[:, :, 1]
        return jnp.einsum('bhqk,bkhd->bqhd', a.astype(v.dtype), v)

    o = lax.map(block, (_to_blocks(q, nb), jnp.arange(nb)))
    o = jnp.moveaxis(o, 0, 1).reshape(bsz, s, DIFF_HEADS, DIFF_DV)
    o = _rmsnorm(o, norm_g) * (1.0 - lam_init)
    return o.reshape(bsz, s, DIFF_HEADS * DIFF_DV)


def _sparse_attn(q, c_kv, iq, ik, iw, kv_norm_g, ik_ln_g, ik_ln_b, w_uv):
    bsz, s, _ = q.shape
    nb = s // Q_BLOCK
    topk = min(IDX_TOPK_MAX, s // 4)
    c = _rmsnorm(c_kv, kv_norm_g)
    ik = _layernorm(ik, ik_ln_g, ik_ln_b)
    q = q.reshape(bsz, s, SPA_HEADS, SPA_LAT)
    iq = iq.reshape(bsz, s, IDX_HEADS, IDX_DIM)
    iw = iw.astype(jnp.float32) * (IDX_HEADS ** -0.5)
    k_chunk = jnp.arange(s) // CHUNK

    def block(args):
        q_blk, iq_blk, iw_blk, i = args
        q_chunk = (i * Q_BLOCK + jnp.arange(Q_BLOCK)) // CHUNK
        admissible = k_chunk[None, :] <= q_chunk[:, None]
        rel = jax.nn.relu(jnp.einsum('bqhd,bsd->bqhs', iq_blk, ik).astype(jnp.float32)) * (IDX_DIM ** -0.5)
        score = jnp.einsum('bqhs,bqh->bqs', rel, iw_blk)
        score = jnp.where(admissible[None], score, -jnp.inf)
        _, idx = lax.top_k(score, topk)
        valid = k_chunk[idx] <= q_chunk[None, :, None]
        c_sel = jax.vmap(lambda cb, ib: cb[ib])(c, idx)
        sc = jnp.einsum('bqhd,bqkd->bqhk', q_blk, c_sel).astype(jnp.float32) * (SPA_LAT ** -0.5)
        p = jax.nn.softmax(jnp.where(valid[:, :, None, :], sc, -jnp.inf), axis=-1).astype(c.dtype)
        o_lat = jnp.einsum('bqhk,bqkd->bqhd', p, c_sel)
        return jnp.einsum('bqhd,hde->bqhe', o_lat, w_uv)

    o = lax.map(block, (_to_blocks(q, nb), _to_blocks(iq, nb), _to_blocks(iw, nb), jnp.arange(nb)))
    o = jnp.moveaxis(o, 0, 1)
    return o.reshape(bsz, s, SPA_HEADS * SPA_DV)


def setup_inputs(seed: int = 0) -> dict:
    key = jax.random.key(seed)
    ks = jax.random.split(key, 16)
    f32 = jnp.float32
    beta = (8.0 * DEPTH) ** -0.25
    nrm = lambda k, shp, sc: jax.random.normal(k, shp, f32) * sc
    return {
        "x": nrm(ks[0], (BATCH, SEQ, D_MODEL), 1.0),
        "w_in": nrm(ks[1], (DEPTH, D_MODEL, N_IN), D_MODEL ** -0.5),
        "w_out": nrm(ks[2], (DEPTH, D_MIX, D_MODEL), beta * D_MIX ** -0.5),
        "gla_w_gate2": nrm(ks[3], (DEPTH, GLA_GATE_RANK, GLA_HEADS * GLA_DK), GLA_GATE_RANK ** -0.5),
        "gla_b_gate": nrm(ks[4], (DEPTH, GLA_HEADS * GLA_DK), 0.1),
        "gla_norm_g": 1.0 + nrm(ks[5], (DEPTH, GLA_DV), 0.02),
        "diff_lambda": nrm(ks[6], (DEPTH, 4, DIFF_DQK), 0.1),
        "diff_norm_g": 1.0 + nrm(ks[7], (DEPTH, DIFF_DV), 0.02),
        "spa_kv_norm_g": 1.0 + nrm(ks[8], (DEPTH, SPA_LAT), 0.02),
        "spa_ik_ln_g": 1.0 + nrm(ks[9], (DEPTH, IDX_DIM), 0.02),
        "spa_ik_ln_b": nrm(ks[10], (DEPTH, IDX_DIM), 0.02),
        "spa_w_uv": nrm(ks[11], (DEPTH, SPA_HEADS, SPA_LAT, SPA_DV), SPA_LAT ** -0.5),
        "post_ln_g": 1.0 + nrm(ks[12], (DEPTH, D_MODEL), 0.02),
        "post_ln_b": nrm(ks[13], (DEPTH, D_MODEL), 0.02),
    }


def reference(x, w_in, w_out, gla_w_gate2, gla_b_gate, gla_norm_g, diff_lambda, diff_norm_g,
              spa_kv_norm_g, spa_ik_ln_g, spa_ik_ln_b, spa_w_uv, post_ln_g, post_ln_b):
    alpha = (2.0 * DEPTH) ** 0.25
    pts = _split_points()
    for l in range(DEPTH):
        h = x @ w_in[l]
        (aq, ak, av, aa, ag, bq, bk, bv, bg, cq, ckv, ciq, cik, ciw, cg) = jnp.split(h, pts, axis=-1)
        o_a = _gla(aq, ak, av, aa, gla_w_gate2[l], gla_b_gate[l], gla_norm_g[l])
        o_a = (o_a.astype(jnp.float32) * jax.nn.silu(ag.astype(jnp.float32))).astype(x.dtype)
        lam_init = 0.8 - 0.6 * math.exp(-0.3 * l)
        o_b = _diff_attn(bq, bk, bv, diff_lambda[l], diff_norm_g[l], lam_init)
        o_b = (o_b.astype(jnp.float32) * jax.nn.silu(bg.astype(jnp.float32))).astype(x.dtype)
        o_c = _sparse_attn(cq, ckv, ciq, cik, ciw, spa_kv_norm_g[l], spa_ik_ln_g[l], spa_ik_ln_b[l], spa_w_uv[l])
        o_c = (o_c.astype(jnp.float32) * jax.nn.silu(cg.astype(jnp.float32))).astype(x.dtype)
        y = jnp.concatenate([o_a, o_b, o_c], axis=-1) @ w_out[l]
        x = _layernorm(alpha * x + y, post_ln_g[l], post_ln_b[l])
    return x
```

```cpp
#include <hip/hip_runtime.h>
#include <cstdio>
#include <cstdint>

#define GAS __attribute__((address_space(1)))
#define LAS __attribute__((address_space(3)))
typedef unsigned short bf16_t;
typedef short s16x4 __attribute__((ext_vector_type(4)));
typedef float f32x16 __attribute__((ext_vector_type(16)));
typedef unsigned u32x2 __attribute__((ext_vector_type(2)));
typedef GAS unsigned gu32;

constexpr int SEQ = 16384, DM = 4096, DEPTH = 4, NIN = 14688, NPAD = 14848;
constexpr int CHUNK = 64, NCHUNK = SEQ / CHUNK;
constexpr int C_AQ = 0, C_AK = 1024, C_AV = 2048, C_AG = 4096, C_BQ = 6144, C_BK = 7168, C_BV = 8192, C_BG = 9216, C_CQ = 10240,
              C_CKV = 12288, C_CIQ = 12544, C_CG = 13568, C_CIK = 14592, C_AA = 14656, C_CIW = 14672;
__host__ __device__ __forceinline__ int srccol(int n) {
    if (n < 4096) return n;
    if (n < 6144) return n + 16;
    if (n < 13568) return n + 16;
    if (n < 14592) return n + 96;
    if (n < 14656) return n - 1008;
    if (n < 14672) return n - 10560;
    if (n < 14688) return n - 1024;
    return -1;
}
namespace pg8 {
#define PG8_LAS __attribute__((address_space(3)))
typedef unsigned short bf16_t;
typedef short bf16x8 __attribute__((ext_vector_type(8)));
typedef float f32x4 __attribute__((ext_vector_type(4)));
typedef unsigned u32x4 __attribute__((ext_vector_type(4)));
constexpr int BM = 256, BK = 64, HALF = 128, HTB = HALF * BK * 2  , STAGE_BYTES = 8 * HTB, NXCD = 8, WGM = 8;

__host__ __device__ __forceinline__ int lds_byte(int r, int c) { const int st = (r >> 4) * 2 + (c >> 5), rr = r & 15, cc = c & 31, ob = rr * 64 + cc * 2; return st * 1024 + (ob ^ (((ob >> 9) & 1) << 5)); }
__host__ __device__ __forceinline__ void stage_rc(int b, int& R, int& C) { const int st = b / 1024, sb = b % 1024, swz = sb ^ (((sb >> 9) & 1) << 5); R = (st >> 1) * 16 + swz / 64; C = (st & 1) * 32 + (swz % 64) / 2; }
__host__ __device__ __forceinline__ int perm32(int rho) { const int n = rho >> 4, i = rho & 15; return 8 * (i >> 2) + 4 * n + (i & 3); }

struct Unit { int pm, pn; };
struct Gemm { const bf16_t* A; const bf16_t* Bt; int M, N, K; };

struct StaticOrder {
    int nM, nN, nwg, G, c;
    __host__ __device__ void init(int M, int N, int G_, int c_) { nM = M / BM; nN = N / BM; nwg = nM * nN; G = G_; c = c_; }
    __host__ __device__ bool next(int i, Unit& u) const {
        const long L = (long)i * G + c; if (L >= nwg) return false;
        int wgid = (int)L; { const int q = nwg / NXCD, r = nwg % NXCD, xcd = wgid % NXCD, off = wgid / NXCD; wgid = (xcd < r ? xcd * (q + 1) : r * (q + 1) + (xcd - r) * q) + off; }
        const int nig = WGM * nN, gid = wgid / nig, fm = gid * WGM, gsz = (nM - fm) < WGM ? (nM - fm) : WGM;
        u.pm = fm + ((wgid % nig) % gsz); u.pn = (wgid % nig) / gsz; return true;
    }
    __device__ __forceinline__ void a_ready(const Unit&) const {}
    __device__ __forceinline__ void done(const Unit&) const {}
};

__device__ __forceinline__ unsigned cvt_pk_bf16(float lo, float hi) { unsigned r; asm volatile("v_cvt_pk_bf16_f32 %0, %1, %2" : "=v"(r) : "v"(lo), "v"(hi)); return r; }
typedef float f32x2 __attribute__((ext_vector_type(2)));
struct EpiBf16Plain {
    static constexpr bool PERM = true, AFTER_DRAIN = false;
    bf16_t* O; int ldc;
    __device__ __forceinline__ void operator()(const f32x4 (&acc)[2][2][4][2], const Unit& u, int wr, int wc, int fr, int fq) const {
        const int row0 = u.pm * BM + wr * 64 + fr, col0 = u.pn * BM + wc * 32 + 8 * fq;
#pragma unroll
        for (int ai = 0; ai < 2; ++ai)
#pragma unroll
            for (int m = 0; m < 4; ++m) { bf16_t* rowp = O + (size_t)(row0 + ai * HALF + m * 16) * ldc + col0;
#pragma unroll
                for (int bj = 0; bj < 2; ++bj) { const f32x4 v0 = acc[ai][bj][m][0], v1 = acc[ai][bj][m][1];
                    u32x4 w; w.x = cvt_pk_bf16(v0[0], v0[1]); w.y = cvt_pk_bf16(v0[2], v0[3]); w.z = cvt_pk_bf16(v1[0], v1[1]); w.w = cvt_pk_bf16(v1[2], v1[3]);
                    *(u32x4*)(rowp + bj * HALF) = w; } }
    }
};
struct EpiResid {
    static constexpr bool PERM = false, AFTER_DRAIN = false;
    const float* Xin; float* Xout; int ldc; float alpha;
    __device__ __forceinline__ void operator()(const f32x4 (&acc)[2][2][4][2], const Unit& u, int wr, int wc, int fr, int fq) const {
        const int row0 = u.pm * BM + wr * 64 + fr, col0 = u.pn * BM + wc * 32 + 4 * fq;
#pragma unroll
        for (int ai = 0; ai < 2; ++ai)
#pragma unroll
            for (int m = 0; m < 4; ++m) { const size_t off = (size_t)(row0 + ai * HALF + m * 16) * ldc + col0;
#pragma unroll
                for (int bj = 0; bj < 2; ++bj)
#pragma unroll
                    for (int n = 0; n < 2; ++n) { const f32x4 xi = *(const f32x4*)(Xin + off + bj * HALF + n * 16);
                        *(f32x4*)(Xout + off + bj * HALF + n * 16) = xi * alpha + acc[ai][bj][m][n]; }
                asm volatile("" ::: "memory"); }
    }
};
template <class Epi, class Sched, bool ALIGN_EPI = false, bool SP2 = false>
__device__ __forceinline__ void gemm_phase(PG8_LAS unsigned char* lds, const Gemm g, const Sched& S, const Epi& E) {
    int tid_ = threadIdx.x; asm volatile("" : "+v"(tid_));
    const int tid = tid_, wid = __builtin_amdgcn_readfirstlane(tid >> 6), lane = tid & 63, wr = wid >> 2, wc = wid & 3, fr = lane & 15, fq = lane >> 4;
    const int K = g.K, nt = K / BK;
    unsigned voffA[2], voffB[2];
#pragma unroll
    for (int i = 0; i < 2; ++i) { int R, C; stage_rc(tid * 16 + i * 8192, R, C); const int Rb = Epi::PERM ? ((R & ~31) + perm32(R & 31)) : R;
        voffA[i] = (unsigned)(R * K + C) * 2u; voffB[i] = (unsigned)(Rb * K + C) * 2u; }
    const size_t kstep = (size_t)(BK * 2);
    const size_t hstep = (size_t)HALF * K * 2;
    const size_t tstep = 2 * hstep;
    const unsigned ldsw = (unsigned)wid * 1024u;
    const int aoff = lds_byte(wr * 64 + fr, fq * 8), boff = lds_byte(wc * 32 + fr, fq * 8);
#define PG8_SA(b, h) (((b) * 2 + (h)) * HTB)
#define PG8_SB(b, h) ((4 + (b) * 2 + (h)) * HTB)
#define PG8_STAGE(bufoff, gbase, voff) do { _Pragma("unroll") for (int _i = 0; _i < 2; ++_i) \
        __builtin_amdgcn_global_load_lds((const unsigned*)((const char*)(gbase) + (voff)[_i]), (PG8_LAS unsigned*)(lds + (bufoff) + ldsw + _i * 8192), 16, 0, 0); } while (0)
#define PG8_LDA(dst, b, h) do { _Pragma("unroll") for (int m = 0; m < 4; ++m) _Pragma("unroll") for (int k = 0; k < 2; ++k) dst[m][k] = *(const PG8_LAS bf16x8*)(lds + PG8_SA(b, h) + aoff + m * 2048 + k * 1024); } while (0)
#define PG8_LDB(dst, b, h) do { _Pragma("unroll") for (int n = 0; n < 2; ++n) _Pragma("unroll") for (int k = 0; k < 2; ++k) dst[n][k] = *(const PG8_LAS bf16x8*)(lds + PG8_SB(b, h) + boff + n * 2048 + k * 1024); } while (0)
#define PG8_MMA(ai, bj, At, Bt) do { __builtin_amdgcn_s_setprio(1); _Pragma("unroll") for (int m = 0; m < 4; ++m) _Pragma("unroll") for (int n = 0; n < 2; ++n) _Pragma("unroll") for (int k = 0; k < 2; ++k) \
        acc[ai][bj][m][n] = __builtin_amdgcn_mfma_f32_16x16x32_bf16(Bt[n][k], At[m][k], acc[ai][bj][m][n], 0, 0, 0); __builtin_amdgcn_s_setprio(0); } while (0)
#define PG8_WAIT_V(n) asm volatile("s_waitcnt vmcnt(" #n ")" ::: "memory")
#define PG8_WAIT_L(n) asm volatile("s_waitcnt lgkmcnt(" #n ")" ::: "memory")
#define PG8_BAR __builtin_amdgcn_s_barrier()
#define PG8_SCHED __builtin_amdgcn_sched_barrier(0)
    Unit cur, nxt; int ui = 0;
    if (!S.next(0, cur)) return;
    f32x4 acc[2][2][4][2];
#pragma unroll
    for (int a = 0; a < 2; ++a)
#pragma unroll
        for (int b = 0; b < 2; ++b)
#pragma unroll
            for (int m = 0; m < 4; ++m)
#pragma unroll
                for (int n = 0; n < 2; ++n) acc[a][b][m][n] = (f32x4){0.f, 0.f, 0.f, 0.f};
    bf16x8 At[4][2], B0[2][2], B1[2][2];
    const char* cA = (const char*)g.A + (size_t)cur.pm * tstep; const char* cB = (const char*)g.Bt + (size_t)cur.pn * tstep;
    S.a_ready(cur);
    if constexpr (SP2) {
        PG8_STAGE(PG8_SB(0, 0), cB, voffB); PG8_STAGE(PG8_SB(0, 1), cB + hstep, voffB); PG8_STAGE(PG8_SA(0, 0), cA, voffA); PG8_STAGE(PG8_SA(0, 1), cA + hstep, voffA);
        if (wr == 1) PG8_BAR;
        PG8_WAIT_V(2); PG8_BAR;
        PG8_STAGE(PG8_SB(1, 0), cB + kstep, voffB); PG8_STAGE(PG8_SA(1, 0), cA + kstep, voffA); PG8_STAGE(PG8_SB(1, 1), cB + hstep + kstep, voffB);
        PG8_WAIT_V(6); PG8_BAR;
    } else {
        PG8_STAGE(PG8_SB(0, 0), cB, voffB); PG8_STAGE(PG8_SA(0, 0), cA, voffA); PG8_STAGE(PG8_SB(0, 1), cB + hstep, voffB); PG8_STAGE(PG8_SA(0, 1), cA + hstep, voffA);
        if (wr == 1) PG8_BAR;
        PG8_WAIT_V(4); PG8_BAR;
        PG8_STAGE(PG8_SB(1, 0), cB + kstep, voffB); PG8_STAGE(PG8_SA(1, 0), cA + kstep, voffA); PG8_STAGE(PG8_SB(1, 1), cB + hstep + kstep, voffB);
        PG8_WAIT_V(6); PG8_BAR;
    }
    for (;;) {
        const bool has_next = S.next(ui + 1, nxt);
        const char* nA = has_next ? (const char*)g.A + (size_t)nxt.pm * tstep : cA; const char* nB = has_next ? (const char*)g.Bt + (size_t)nxt.pn * tstep : cB;
        for (int t = 0; t < nt; t += 2) {
            const bool last = (t == nt - 2);
            const char* a1 = cA + (size_t)(t + 1) * kstep;
            const char* a2 = last ? nA : cA + (size_t)(t + 2) * kstep; const char* b2 = last ? nB : cB + (size_t)(t + 2) * kstep;
            const char* a3 = a2 + kstep; const char* b3 = b2 + kstep;
            if (last && has_next) S.a_ready(nxt);
            if constexpr (SP2) {
            PG8_LDB(B0, 0, 0); PG8_LDB(B1, 0, 1); PG8_SCHED; PG8_LDA(At, 0, 0); PG8_STAGE(PG8_SA(1, 1), a1 + hstep, voffA);
            PG8_WAIT_V(8); PG8_WAIT_L(0); PG8_BAR; PG8_MMA(0, 0, At, B0); PG8_MMA(0, 1, At, B1); PG8_BAR; PG8_SCHED;
            PG8_LDA(At, 0, 1); PG8_STAGE(PG8_SB(0, 0), b2, voffB); PG8_STAGE(PG8_SB(0, 1), b2 + hstep, voffB); PG8_STAGE(PG8_SA(0, 0), a2, voffA);
            PG8_WAIT_V(8); PG8_WAIT_L(0); PG8_BAR; PG8_MMA(1, 0, At, B0); PG8_MMA(1, 1, At, B1); PG8_BAR; PG8_SCHED;
            PG8_LDB(B0, 1, 0); PG8_LDB(B1, 1, 1); PG8_SCHED; PG8_LDA(At, 1, 0); PG8_STAGE(PG8_SA(0, 1), a2 + hstep, voffA);
            PG8_WAIT_V(8); PG8_WAIT_L(0); PG8_BAR; PG8_MMA(0, 0, At, B0); PG8_MMA(0, 1, At, B1); PG8_BAR; PG8_SCHED;
            PG8_LDA(At, 1, 1); PG8_STAGE(PG8_SB(1, 0), b3, voffB); PG8_STAGE(PG8_SB(1, 1), b3 + hstep, voffB); PG8_STAGE(PG8_SA(1, 0), a3, voffA);
            PG8_WAIT_V(8); PG8_WAIT_L(0); PG8_BAR; PG8_MMA(1, 0, At, B0); PG8_MMA(1, 1, At, B1); PG8_BAR; PG8_SCHED;
            } else {
            PG8_LDB(B0, 0, 0); PG8_SCHED; PG8_LDA(At, 0, 0); PG8_STAGE(PG8_SA(1, 1), a1 + hstep, voffA);
            PG8_WAIT_L(8); PG8_BAR; PG8_WAIT_L(0); PG8_MMA(0, 0, At, B0); PG8_BAR; PG8_SCHED;
            PG8_LDB(B1, 0, 1); PG8_STAGE(PG8_SB(0, 0), b2, voffB);
            PG8_BAR; PG8_WAIT_L(0); PG8_MMA(0, 1, At, B1); PG8_BAR;
            PG8_LDA(At, 0, 1); PG8_STAGE(PG8_SA(0, 0), a2, voffA);
            PG8_BAR; PG8_WAIT_L(0); PG8_MMA(1, 0, At, B0); PG8_BAR; PG8_SCHED;
            PG8_STAGE(PG8_SB(0, 1), b2 + hstep, voffB);
            PG8_WAIT_V(6); PG8_BAR; PG8_MMA(1, 1, At, B1); PG8_BAR;
            PG8_LDB(B0, 1, 0); PG8_SCHED; PG8_LDA(At, 1, 0); PG8_STAGE(PG8_SA(0, 1), a2 + hstep, voffA);
            PG8_WAIT_L(8); PG8_BAR; PG8_WAIT_L(0); PG8_MMA(0, 0, At, B0); PG8_BAR; PG8_SCHED;
            PG8_LDB(B1, 1, 1); PG8_STAGE(PG8_SB(1, 0), b3, voffB);
            PG8_BAR; PG8_WAIT_L(0); PG8_MMA(0, 1, At, B1); PG8_BAR;
            PG8_LDA(At, 1, 1); PG8_STAGE(PG8_SA(1, 0), a3, voffA);
            PG8_BAR; PG8_WAIT_L(0); PG8_MMA(1, 0, At, B0); PG8_BAR; PG8_SCHED;
            PG8_STAGE(PG8_SB(1, 1), b3 + hstep, voffB);
            PG8_WAIT_V(6); PG8_BAR; PG8_MMA(1, 1, At, B1); PG8_BAR;
            }
        }
        if constexpr (ALIGN_EPI) { if (wr == 0) PG8_BAR; }
        if constexpr (!Epi::AFTER_DRAIN) { E(acc, cur, wr, wc, fr, fq); S.done(cur); }
        if (!has_next) break;
#pragma unroll
        for (int a = 0; a < 2; ++a)
#pragma unroll
            for (int b = 0; b < 2; ++b)
#pragma unroll
                for (int m = 0; m < 4; ++m)
#pragma unroll
                    for (int n = 0; n < 2; ++n) acc[a][b][m][n] = (f32x4){0.f, 0.f, 0.f, 0.f};
        cur = nxt; cA = nA; cB = nB; ++ui;
        if constexpr (ALIGN_EPI) { if (wr == 1) PG8_BAR; }
    }
    PG8_WAIT_V(0);
    if constexpr (!ALIGN_EPI) { if (wr == 0) PG8_BAR; }
    PG8_BAR;
    if constexpr (Epi::AFTER_DRAIN) { E.fused(acc, cur, wr, wc, fr, fq, lds, wid, lane); S.done(cur); }
#undef PG8_SA
#undef PG8_SB
#undef PG8_STAGE
#undef PG8_LDA
#undef PG8_LDB
#undef PG8_MMA
#undef PG8_WAIT_V
#undef PG8_WAIT_L
#undef PG8_BAR
#undef PG8_SCHED
}
}
using pg8::bf16x8; using pg8::f32x4; using pg8::u32x4;
namespace dattn {
constexpr int D = 128, LDQ = NPAD, LDK = NPAD, LDO = 2048;
constexpr float SCALE = 0.08838834764831845f;
constexpr float THR = 8.f;
constexpr int NW = 8, QBLK = 32, KVBLK = 64, QB = NW * QBLK;
constexpr int SHM_V = KVBLK * D * 2, SHM_K = KVBLK * D * 2;
constexpr int LDS_BYTES = 2 * SHM_V + 2 * SHM_K + NW * 64 * 4;

#define KSWZ(row, colB) ((row) * 256 + ((colB) ^ (((row) & 7) << 4)))
#define SBAR() __builtin_amdgcn_sched_barrier(0)
__device__ __forceinline__ int v_st(int k, int c) { const int kk = (k & ~0xC) | ((k & 4) << 1) | ((k & 8) >> 1); return ((kk >> 3) * 4 + (c >> 5)) * 512 + ((kk & 7) * 32 + (c & 31)) * 2; }
__device__ __forceinline__ int v_rd_base(int lane) { return ((lane & 3) << 3) | (((lane >> 2) & 3) << 6) | (((lane >> 4) & 1) << 5) | (((lane >> 5) & 1) << 8); }
constexpr int v_rd_off(int d0, int ks, int half) { return d0 * 512 + ks * 4096 + half * 2048; }
__device__ __forceinline__ int crow(int r, int hi) { return (r & 3) + 8 * (r >> 2) + 4 * hi; }
__device__ __forceinline__ unsigned cvtpk(float lo, float hi) { unsigned r; asm volatile("v_cvt_pk_bf16_f32 %0, %1, %2" : "=v"(r) : "v"(lo), "v"(hi)); return r; }
__device__ __forceinline__ bf16x8 load8(const bf16_t* p) { return *reinterpret_cast<const bf16x8*>(p); }

__device__ __forceinline__ void partialSM(f32x16& p0, f32x16& p1, float& m_reg, float& mn, float& alpha) {
    float pmax = p0[0]; for (int r = 1; r < 16; ++r) pmax = fmaxf(pmax, p0[r]); for (int r = 0; r < 16; ++r) pmax = fmaxf(pmax, p1[r]);
    { auto rr = __builtin_amdgcn_permlane32_swap(__float_as_uint(pmax), __float_as_uint(pmax), false, false);
      pmax = fmaxf(__uint_as_float(rr[0]), __uint_as_float(rr[1])); }
    constexpr float C2 = 1.4426950408889634f * SCALE;
    if (__builtin_expect(__all((pmax - m_reg) * SCALE <= THR), 1)) { mn = m_reg; alpha = 1.f; }
    else { mn = fmaxf(m_reg, pmax); alpha = __builtin_amdgcn_exp2f((m_reg - mn) * C2); m_reg = mn; }
    const float mnL = -mn * C2;
    for (int r = 0; r < 16; ++r) p0[r] = fmaf(p0[r], C2, mnL); for (int r = 0; r < 16; ++r) p1[r] = fmaf(p1[r], C2, mnL);
    for (int r = 0; r < 16; ++r) p0[r] = __builtin_amdgcn_exp2f(p0[r]);
}
__device__ __forceinline__ void finishSM(f32x16& p0, f32x16& p1, float alpha, float& l_reg, bf16x8& pa0, bf16x8& pa1, bf16x8& pa2, bf16x8& pa3) {
    for (int r = 0; r < 16; ++r) p1[r] = __builtin_amdgcn_exp2f(p1[r]);
    float ps = 0; for (int r = 0; r < 16; ++r) ps += p0[r]; for (int r = 0; r < 16; ++r) ps += p1[r];
    { auto rr = __builtin_amdgcn_permlane32_swap(__float_as_uint(ps), __float_as_uint(ps), false, false);
      ps = __uint_as_float(rr[0]) + __uint_as_float(rr[1]); }
    l_reg = l_reg * alpha + ps;
#define PK4(P, B_, OUT) do { unsigned a0 = cvtpk(P[B_+0], P[B_+1]), a1 = cvtpk(P[B_+2], P[B_+3]);                          \
        unsigned b0 = cvtpk(P[B_+4], P[B_+5]), b1 = cvtpk(P[B_+6], P[B_+7]);                                             \
        auto r0 = __builtin_amdgcn_permlane32_swap(a0, b0, false, false); auto r1 = __builtin_amdgcn_permlane32_swap(a1, b1, false, false); \
        u32x4 w = {r0[0], r1[0], r0[1], r1[1]}; OUT = *reinterpret_cast<bf16x8*>(&w); } while (0)
    PK4(p0, 0, pa0); PK4(p0, 8, pa1); PK4(p1, 0, pa2); PK4(p1, 8, pa3);
#undef PK4
}
template <int KB>
__device__ __forceinline__ void qkt(f32x16& p0, f32x16& p1, const char* K_lds, int r32, int hi, const bf16x8* qr) {
    p0 = f32x16{}; p1 = f32x16{};
    const char* kb[4];
#pragma unroll
    for (int dd = 0; dd < 4; ++dd) kb[dd] = K_lds + KB * SHM_K + KSWZ(r32, (dd * 16 + hi * 8) * 2);
#pragma unroll
    for (int d0 = 0; d0 < 8; ++d0) { const char* a = kb[d0 & 3] + (d0 >> 2) * 128;
        bf16x8 b0 = *reinterpret_cast<const bf16x8*>(a);
        bf16x8 b1 = *reinterpret_cast<const bf16x8*>(a + 32 * 256);
        p0 = __builtin_amdgcn_mfma_f32_32x32x16_bf16(b0, qr[d0], p0, 0, 0, 0);
        p1 = __builtin_amdgcn_mfma_f32_32x32x16_bf16(b1, qr[d0], p1, 0, 0, 0); }
}
template <int VB>
__device__ __forceinline__ void pv_tile(f32x16* o, int vb0, bf16x8 pa0, bf16x8 pa1, bf16x8 pa2, bf16x8 pa3) {
#define TRRD(dst, off) asm volatile("ds_read_b64_tr_b16 %0, %1 offset:%2" : "=&v"(dst) : "v"(vb0), "i"(off) : "memory")
#define PV_D0(d0) do { s16x4 l0, l1, l2, l3, h0, h1, h2, h3; constexpr int b_ = VB * SHM_V + v_rd_off(d0, 0, 0);   \
        TRRD(l0, b_); TRRD(h0, b_ + 2048); TRRD(l1, b_ + 4096); TRRD(h1, b_ + 6144); TRRD(l2, b_ + 8192); TRRD(h2, b_ + 10240); TRRD(l3, b_ + 12288); TRRD(h3, b_ + 14336); \
        asm volatile("s_waitcnt lgkmcnt(0)" ::: "memory"); SBAR();                                                   \
        o[d0] = __builtin_amdgcn_mfma_f32_32x32x16_bf16(pa0, (bf16x8){l0[0], l0[1], l0[2], l0[3], h0[0], h0[1], h0[2], h0[3]}, o[d0], 0, 0, 0);   \
        o[d0] = __builtin_amdgcn_mfma_f32_32x32x16_bf16(pa1, (bf16x8){l1[0], l1[1], l1[2], l1[3], h1[0], h1[1], h1[2], h1[3]}, o[d0], 0, 0, 0);   \
        o[d0] = __builtin_amdgcn_mfma_f32_32x32x16_bf16(pa2, (bf16x8){l2[0], l2[1], l2[2], l2[3], h2[0], h2[1], h2[2], h2[3]}, o[d0], 0, 0, 0);   \
        o[d0] = __builtin_amdgcn_mfma_f32_32x32x16_bf16(pa3, (bf16x8){l3[0], l3[1], l3[2], l3[3], h3[0], h3[1], h3[2], h3[3]}, o[d0], 0, 0, 0); } while (0)
    PV_D0(0); PV_D0(1); PV_D0(2); PV_D0(3);
#undef PV_D0
#undef TRRD
}

struct BlockRef { const bf16_t* Q; const bf16_t* K; const bf16_t* V; float* O; int P0; };
struct Seam { bf16x8 qr[8]; bf16x8 st_v0, st_v1, st_k0, st_k1; };
#define ROW(p, k0, rr) ((p) + (size_t)((k0) + (rr)) * LDK + sc)
#define VMW() asm volatile("s_waitcnt vmcnt(0)" ::: "memory")
#define VMWN(n) asm volatile("s_waitcnt vmcnt(%0)" :: "i"(n) : "memory")
#define SLOAD_H(Kp, Vp, k0) do { S.st_v0 = load8(ROW(Vp, k0, sr)); S.st_v1 = load8(ROW(Vp, k0, 32 + sr));              \
                         S.st_k0 = load8(ROW(Kp, k0, sr)); S.st_k1 = load8(ROW(Kp, k0, 32 + sr)); } while (0)
#define SWRITE_HK(bf) do { *(bf16x8*)(K_lds + (bf) * SHM_K + kws) = S.st_k0; *(bf16x8*)(K_lds + (bf) * SHM_K + kws + 32 * 256) = S.st_k1; } while (0)
#define SWRITE_HV(bf) do { *(bf16x8*)(V_lds + (bf) * SHM_V + vst0) = S.st_v0; *(bf16x8*)(V_lds + (bf) * SHM_V + vst1) = S.st_v1; } while (0)
#define SWRITE_H(bf) do { SWRITE_HV(bf); SWRITE_HK(bf); } while (0)
__device__ __forceinline__ void prime(const BlockRef& cur, char* lds, Seam& S) {
    int tid_ = threadIdx.x; asm volatile("" : "+v"(tid_));
    const int tid = tid_, wid = __builtin_amdgcn_readfirstlane(tid >> 6), lane = tid & 63, r32 = lane & 31, hi = lane >> 5;
    const int sr = tid >> 4, sc = (tid & 15) * 8, kws = KSWZ(sr, sc * 2); char* K_lds = lds + 2 * SHM_V;
#pragma unroll
    for (int d0 = 0; d0 < 8; ++d0) S.qr[d0] = load8(cur.Q + (size_t)(wid * QBLK + r32) * LDQ + d0 * 16 + hi * 8);
    SLOAD_H(cur.K, cur.V, 0); VMW(); SWRITE_HK(0);
    __syncthreads();
}
__device__ __forceinline__ void block(const BlockRef& cur, const BlockRef& nxt, char* lds, Seam& S) {
    int tid_ = threadIdx.x; asm volatile("" : "+v"(tid_));
    const int tid = tid_, wid = __builtin_amdgcn_readfirstlane(tid >> 6), lane = tid & 63, r32 = lane & 31, hi = lane >> 5;
    const int NT = cur.P0 / KVBLK + 4;
    const int qlo = cur.P0 + wid * QBLK;
    const int qend = qlo | 63;
    char* V_lds = lds; char* K_lds = lds + 2 * SHM_V;
    float* ws = (float*)(lds + 2 * SHM_V + 2 * SHM_K) + wid * 64; float* li_l = ws, * al_l = ws + 32;
    float m_reg = -1e30f, l_reg = 0; f32x16 o[4] = {};
    const int sr = tid >> 4, sc = (tid & 15) * 8, vst0 = v_st(sr, sc), vst1 = v_st(32 + sr, sc), kws = KSWZ(sr, sc * 2);
    const int vb0 = (int)(uintptr_t)V_lds + v_rd_base(lane);
    const bf16_t* Kh = cur.K; const bf16_t* Vh = cur.V;
#define RESC(a) do { if (__any((a) < 1.f)) { if (hi == 0) al_l[r32] = (a); asm volatile("s_waitcnt lgkmcnt(0)" ::: "memory");              \
                     for (int d_ = 0; d_ < 4; ++d_) for (int r = 0; r < 16; ++r) o[d_][r] *= al_l[crow(r, hi)]; } } while (0)
#define KBASE(t) ((t) * KVBLK)
#define MASKT(P0_, P1_, t) do { if (KBASE(t) > qend) { const float NEG_ = -__builtin_inff(); _Pragma("unroll") for (int r_ = 0; r_ < 16; ++r_) { P0_[r_] = NEG_; P1_[r_] = NEG_; } } } while (0)
    constexpr int NQL = 8;
#define SEAM_K0() do { VMWN(NQL); SWRITE_HK(0); SBAR(); } while (0)
    f32x16 pA0, pA1, pB0, pB1; float mnA, mnB, alA, alB; bf16x8 pa0, pa1, pa2, pa3;
    SWRITE_HV(0); SBAR();
    if (NT > 1) { SLOAD_H(Kh, Vh, KBASE(1)); }
    SBAR(); qkt<0>(pA0, pA1, K_lds, r32, hi, S.qr);
    MASKT(pA0, pA1, 0); partialSM(pA0, pA1, m_reg, mnA, alA);
    if (NT > 1) { VMW(); SWRITE_H(1); }
    __syncthreads();
#define HALF_STEP(PX0, PX1, mnX, alX, PY0, PY1, alY, t, KB, VB, SB) do {                                                      \
        SBAR(); qkt<KB>(PX0, PX1, K_lds, r32, hi, S.qr);                                                                      \
        finishSM(PY0, PY1, alY, l_reg, pa0, pa1, pa2, pa3); SBAR();                                                           \
        if ((t) + 1 < NT) { SLOAD_H(Kh, Vh, KBASE((t) + 1)); SBAR(); }                                                        \
        pv_tile<VB>(o, vb0, pa0, pa1, pa2, pa3); MASKT(PX0, PX1, (t)); partialSM(PX0, PX1, m_reg, mnX, alX);                  \
        __syncthreads();                                                                                                      \
        if ((t) + 1 < NT) { VMW(); SWRITE_H(SB); }                                                                            \
        RESC(alX); __syncthreads(); } while (0)
    for (int t = 1; t + 1 < NT; t += 2) {
        HALF_STEP(pB0, pB1, mnB, alB, pA0, pA1, alA, t, 1, 0, 0);
        HALF_STEP(pA0, pA1, mnA, alA, pB0, pB1, alB, t + 1, 0, 1, 1);
    }
    SBAR(); qkt<1>(pB0, pB1, K_lds, r32, hi, S.qr); SBAR();
    SLOAD_H(nxt.K, nxt.V, 0); SBAR();
#pragma unroll
    for (int d0 = 0; d0 < 8; ++d0) S.qr[d0] = load8(nxt.Q + (size_t)(wid * QBLK + r32) * LDQ + d0 * 16 + hi * 8);
    SBAR();
    finishSM(pA0, pA1, alA, l_reg, pa0, pa1, pa2, pa3); SBAR();
    pv_tile<0>(o, vb0, pa0, pa1, pa2, pa3);
    MASKT(pB0, pB1, NT - 1); partialSM(pB0, pB1, m_reg, mnB, alB); __syncthreads(); RESC(alB);
    finishSM(pB0, pB1, alB, l_reg, pa0, pa1, pa2, pa3); SBAR(); pv_tile<1>(o, vb0, pa0, pa1, pa2, pa3);
    SBAR(); SEAM_K0();
    if (hi == 0) li_l[r32] = l_reg; asm volatile("s_waitcnt lgkmcnt(0)" ::: "memory");
    float rli[16];
#pragma unroll
    for (int r = 0; r < 16; ++r) rli[r] = __builtin_amdgcn_rcpf(li_l[crow(r, hi)]);
    float* Ow = cur.O + (size_t)(wid * QBLK) * LDO;
#pragma unroll
    for (int r = 0; r < 16; ++r) { const int orow = crow(r, hi);
#pragma unroll
        for (int d0 = 0; d0 < 4; ++d0) Ow[(size_t)orow * LDO + d0 * 32 + r32] = o[d0][r] * rli[r]; }
    __syncthreads();
#undef RESC
#undef KBASE
#undef MASKT
#undef SEAM_K0
#undef HALF_STEP
}
#undef ROW
#undef VMW
#undef VMWN
#undef SLOAD_H
#undef SWRITE_HK
#undef SWRITE_HV
#undef SWRITE_H
#undef KSWZ
#undef SBAR
}
#define XB_TMO      128
#define XB_XCNT(j)  (256  + 64 * (j))
#define XB_XSUB(j)  (1280 + 64 * (j))
#define XB_XGEN(j)  (2304 + 64 * (j))
#define XB_TOP      3328
#define XB_TOPGEN   3392
#define XCD_BAR_WORDS 3456
#define XB_SPIN_CAP (1u << 18)

__device__ __forceinline__ unsigned xb_ld(unsigned* p)              { return __hip_atomic_load(p, __ATOMIC_RELAXED, __HIP_MEMORY_SCOPE_AGENT); }
__device__ __forceinline__ unsigned xb_add(unsigned* p, unsigned v) { return __hip_atomic_fetch_add(p, v, __ATOMIC_RELAXED, __HIP_MEMORY_SCOPE_AGENT); }
__device__ __forceinline__ unsigned xb_xcc_id() { return (unsigned)__builtin_amdgcn_s_getreg((3 << 11) | 20) & 0xFu; }
#define XB_SPIN(cond, bar) do { unsigned _sp = 0; while (cond) { __builtin_amdgcn_s_sleep(1); \
    if ((++_sp & 255u) == 0u) { if (xb_ld(&(bar)[XB_TMO])) break; if (_sp > XB_SPIN_CAP) { atomicAdd(&(bar)[XB_TMO], 1u); break; } } } } while (0)

struct XcdBarrier {
    unsigned* bar; unsigned x;
    volatile LAS unsigned* st;
};

__device__ __forceinline__ XcdBarrier xcd_barrier_post(unsigned* bar, volatile LAS unsigned* st) {
    XcdBarrier b; b.bar = bar; b.x = xb_xcc_id(); b.st = st;
    if (threadIdx.x == 0) (void)xb_add(&bar[XB_XCNT(b.x)], 1u);
    return b;
}
__device__ __forceinline__ void xcd_barrier_complete(unsigned* bar, unsigned x, unsigned& nloc, unsigned& nx) {
    const unsigned G = gridDim.x * gridDim.y * gridDim.z;
    unsigned sum, cnt, mine, sp = 0u;
    for (;;) {
        sum = 0u; cnt = 0u; mine = 0u;
#pragma unroll
        for (unsigned j = 0; j < 16; ++j) { const unsigned c = xb_ld(&bar[XB_XCNT(j)]); sum += c; cnt += (c > 0u) ? 1u : 0u; mine = (j == x) ? c : mine; }
        if (sum == G) break;
        __builtin_amdgcn_s_sleep(1);
        if ((++sp & 255u) == 0u) { if (xb_ld(&bar[XB_TMO])) break; if (sp > XB_SPIN_CAP) { atomicAdd(&bar[XB_TMO], 1u); break; } }
    }
    nloc = mine > 0u ? mine : 1u; nx = cnt > 0u ? cnt : 1u;
}

__device__ __forceinline__ void xcd_barrier(const XcdBarrier& b) {
    asm volatile("s_waitcnt vmcnt(0)" ::: "memory");
    __syncthreads();
    if (threadIdx.x == 0) {
        unsigned* bar = b.bar;
        __builtin_amdgcn_s_waitcnt(0);
        unsigned nloc = b.st[0], nx = b.st[1];
        if (nloc == 0u) { xcd_barrier_complete(bar, b.x, nloc, nx); b.st[0] = nloc; b.st[1] = nx; }
        const unsigned old = xb_add(&bar[XB_XSUB(b.x)], 1u);
        const unsigned gen = old / nloc;
        if (old + 1u == (gen + 1u) * nloc) {
            __builtin_amdgcn_fence(__ATOMIC_RELEASE, "agent");
            asm volatile("s_waitcnt vmcnt(0)" ::: "memory");
            const unsigned og = xb_add(&bar[XB_TOP], 1u);
            const unsigned tg = og / nx;
            if (og + 1u == (tg + 1u) * nx) xb_add(&bar[XB_TOPGEN], 1u);
            else XB_SPIN(xb_ld(&bar[XB_TOPGEN]) == tg, bar);
            __builtin_amdgcn_fence(__ATOMIC_ACQUIRE, "agent");
            xb_add(&bar[XB_XGEN(b.x)], 1u);
            asm volatile("s_waitcnt vmcnt(0)" ::: "memory");
        } else {
            XB_SPIN(xb_ld(&bar[XB_XGEN(b.x)]) == gen, bar);
            __builtin_amdgcn_fence(__ATOMIC_ACQUIRE, "agent");
            asm volatile("s_waitcnt vmcnt(0)" ::: "memory");
        }
    }
    __syncthreads();
}
constexpr size_t MiB = 1u << 20;
constexpr size_t WS_CTL = 0, CTL_ZERO_BYTES = 1 * MiB;
constexpr size_t WS_WTIN = 2 * MiB;
constexpr size_t WS_WTOUT = WS_WTIN + (size_t)DEPTH * NPAD * DM * 2;
constexpr size_t WS_WUVT = WS_WTOUT + (size_t)DEPTH * DM * DM * 2;
constexpr size_t WS_XB = WS_WUVT + 2 * MiB;
constexpr size_t WS_XF = WS_XB + (size_t)SEQ * DM * 2;
constexpr size_t WS_H = WS_XF + (size_t)SEQ * DM * 4;
constexpr size_t WS_O = WS_H + (size_t)SEQ * NPAD * 2;
constexpr size_t WS_CN = WS_O + (size_t)SEQ * DM * 2;
constexpr size_t WS_IKN = WS_CN + (size_t)SEQ * 256 * 2;
constexpr size_t WS_KDT = WS_IKN + (size_t)SEQ * 64 * 2;
constexpr size_t WS_DEC = WS_KDT + (size_t)NCHUNK * 1024 * 64 * 2;
constexpr size_t WS_VT = WS_DEC + (size_t)NCHUNK * 1024 * 4;
constexpr size_t WS_OA = WS_VT + (size_t)NCHUNK * 2048 * 64 * 2;
constexpr size_t WS_OD = WS_OA + (size_t)SEQ * 2048 * 4;
constexpr size_t WS_END = WS_OD + (size_t)SEQ * 2048 * 4;
constexpr int CW_TMO = 0;
constexpr int CW_BAR = 4096, BAR_STRIDE = 4096;
constexpr int CW_Q = 200000;
static_assert((CW_Q + 64 * 16 + 64) * 4 <= (int)CTL_ZERO_BYTES && CW_BAR + 32 * BAR_STRIDE <= CW_Q, "CTL map");
constexpr int NWAVES = 8;
constexpr int WREG = 18432;
constexpr int MISC_OFF = NWAVES * WREG;
constexpr int LDS_BYTES = MISC_OFF + 512;
static_assert(pg8::STAGE_BYTES <= MISC_OFF && dattn::LDS_BYTES <= MISC_OFF, "LDS map");

#define LDS_WAIT() asm volatile("s_waitcnt lgkmcnt(0)" ::: "memory")
#define VM_WAIT() asm volatile("s_waitcnt vmcnt(0)" ::: "memory")
typedef __bf16 bf16x2v __attribute__((ext_vector_type(2)));
typedef float f32x2 __attribute__((ext_vector_type(2)));
__device__ __forceinline__ unsigned cvtpk_c(float lo, float hi) { f32x2 v = {lo, hi}; bf16x2v b = __builtin_convertvector(v, bf16x2v); return __builtin_bit_cast(unsigned, b); }
__device__ __forceinline__ float bf2f(unsigned b) { return __uint_as_float(b << 16); }
__device__ __forceinline__ float bflo(unsigned w) { return __uint_as_float(w << 16); }
__device__ __forceinline__ float bfhi(unsigned w) { return __uint_as_float(w & 0xffff0000u); }
__device__ __forceinline__ bf16x8 pack8f(float a0, float a1, float a2, float a3, float a4, float a5, float a6, float a7) {
    u32x4 w = {cvtpk_c(a0, a1), cvtpk_c(a2, a3), cvtpk_c(a4, a5), cvtpk_c(a6, a7)}; return __builtin_bit_cast(bf16x8, w); }
__device__ __forceinline__ float wave_sum(float v) {
#pragma unroll
    for (int o = 1; o < 64; o <<= 1) v += __shfl_xor(v, o);
    return v;
}
__device__ __forceinline__ float silu(float x) { return x / (1.f + __expf(-x)); }
#define MFMA16(a, b, c) __builtin_amdgcn_mfma_f32_16x16x32_bf16((a), (b), (c), 0, 0, 0)
#define MFMA32(a, b, c) __builtin_amdgcn_mfma_f32_32x32x16_bf16((a), (b), (c), 0, 0, 0)

struct Frame {
    LAS unsigned char* lds;
    volatile LAS unsigned* MISC;
    gu32* ctl;
    unsigned char* ws;
    int tid, lane, wave, vcu, G;
};
#define B_WTIN(F)  ((bf16_t*)((F).ws + WS_WTIN))
#define B_WTOUT(F) ((bf16_t*)((F).ws + WS_WTOUT))
#define B_WUVT(F)  ((bf16_t*)((F).ws + WS_WUVT))
#define B_XB(F)    ((bf16_t*)((F).ws + WS_XB))
#define B_XF(F)    ((float*)((F).ws + WS_XF))
#define B_H(F)     ((bf16_t*)((F).ws + WS_H))
#define B_O(F)     ((bf16_t*)((F).ws + WS_O))
#define B_CN(F)    ((bf16_t*)((F).ws + WS_CN))
#define B_IKN(F)   ((bf16_t*)((F).ws + WS_IKN))
#define B_KDT(F)   ((bf16_t*)((F).ws + WS_KDT))
#define B_DEC(F)   ((float*)((F).ws + WS_DEC))
#define B_VT(F)    ((bf16_t*)((F).ws + WS_VT))
#define B_OA(F)    ((float*)((F).ws + WS_OA))
#define B_OD(F)    ((float*)((F).ws + WS_OD))
__device__ __forceinline__ int grab(Frame& F, int qidx) {
    if (F.tid == 0) F.MISC[2] = __hip_atomic_fetch_add((unsigned*)(F.ctl + CW_Q + 64 * qidx), 1u, __ATOMIC_RELAXED, __HIP_MEMORY_SCOPE_AGENT);
    __syncthreads(); const int v = (int)F.MISC[2]; __syncthreads(); return v;
}
template <bool REMAP>
__device__ __forceinline__ void tr_item(const float* W, int K, int ldw, bf16_t* WT, int nblk, LAS float* scr, int item, int lane) {
    const int kb = item / nblk, nb = item - kb * nblk, k0 = 64 * kb, n0 = 32 * nb;
    const int sc = REMAP ? srccol(n0 + (lane & 31)) : n0 + (lane & 31);
#pragma unroll 8
    for (int i = 0; i < 32; ++i) { const int kk = 2 * i + (lane >> 5); scr[kk * 33 + (lane & 31)] = sc >= 0 ? W[(size_t)(k0 + kk) * ldw + sc] : 0.f; }
    LDS_WAIT();
    const int c = lane & 7;
#pragma unroll
    for (int j = 0; j < 4; ++j) { const int nn = (lane >> 3) + 8 * j; const LAS float* s = scr + (8 * c) * 33 + nn;
        u32x4 o; o.x = cvtpk_c(s[0 * 33], s[1 * 33]); o.y = cvtpk_c(s[2 * 33], s[3 * 33]); o.z = cvtpk_c(s[4 * 33], s[5 * 33]); o.w = cvtpk_c(s[6 * 33], s[7 * 33]);
        *(u32x4*)(WT + (size_t)(n0 + nn) * K + k0 + 8 * c) = o; }
    LDS_WAIT();
}
__device__ __forceinline__ void p0_prologue(Frame& F, const float* x_in, const float* w_in, const float* w_out, const float* w_uv) {
    LAS float* scr = (LAS float*)(F.lds + F.wave * 16384);
    const int gw = F.vcu * NWAVES + F.wave, NGW = F.G * NWAVES;
    constexpr int I_IN = (DM / 64) * (NPAD / 32), I_OUT = (DM / 64) * (DM / 32), I_UV = (256 / 64) * (128 / 32);
    constexpr int N_IN = DEPTH * I_IN, N_OUT = DEPTH * I_OUT, N_UV = DEPTH * 8 * I_UV;
    for (int it = gw; it < N_IN + N_OUT + N_UV; it += NGW) {
        int r = it;
        if (r < N_IN) { const int l = r / I_IN; r -= l * I_IN;
            tr_item<true>(w_in + (size_t)l * DM * NIN, DM, NIN, B_WTIN(F) + (size_t)l * NPAD * DM, NPAD / 32, scr, r, F.lane); continue; }
        r -= N_IN;
        if (r < N_OUT) { const int l = r / I_OUT; r -= l * I_OUT;
            tr_item<false>(w_out + (size_t)l * DM * DM, DM, DM, B_WTOUT(F) + (size_t)l * DM * DM, DM / 32, scr, r, F.lane); continue; }
        r -= N_OUT;
        { const int lh = r / I_UV; r -= lh * I_UV;
          tr_item<false>(w_uv + (size_t)lh * 256 * 128, 256, 128, B_WUVT(F) + (size_t)lh * 128 * 256, 128 / 32, scr, r, F.lane); }
    }
    const f32x4* xs = (const f32x4*)x_in;
    for (size_t i = (size_t)gw * 64 + F.lane; i < (size_t)SEQ * DM / 8; i += (size_t)NGW * 64) {
        const f32x4 a = xs[2 * i], b = xs[2 * i + 1];
        u32x4 o = {cvtpk_c(a[0], a[1]), cvtpk_c(a[2], a[3]), cvtpk_c(b[0], b[1]), cvtpk_c(b[2], b[3])};
        *(u32x4*)(B_XB(F) + 8 * i) = o;
    }
}

__device__ __forceinline__ void prep_phase(Frame& F, int l, const float* w_gate2, const float* b_gate, const float* kv_g, const float* ik_g, const float* ik_b) {
    int lane_ = F.lane; asm volatile("" : "+v"(lane_));
    const int gw = F.vcu * NWAVES + F.wave, NGW = F.G * NWAVES, lane = lane_;
    const bf16_t* H = B_H(F);
    {
        const float* kvg = kv_g + l * 256; const float* ikg = ik_g + l * 64; const float* ikb = ik_b + l * 64;
        const f32x4 g4 = *(const f32x4*)(kvg + 4 * lane); const float g1 = ikg[lane], b1 = ikb[lane];
        for (int t = gw; t < SEQ; t += NGW) {
            const bf16_t* hr = H + (size_t)t * NPAD;
            const u32x2 raw = *(const u32x2*)(hr + C_CKV + 4 * lane);
            const float v0 = bflo(raw.x), v1 = bfhi(raw.x), v2 = bflo(raw.y), v3 = bfhi(raw.y);
            const float ss = wave_sum((v0 * v0 + v1 * v1) + (v2 * v2 + v3 * v3));
            const float rs = rsqrtf(ss * (1.f / 256.f) + 1e-6f);
            u32x2 o; o.x = cvtpk_c(v0 * rs * g4[0], v1 * rs * g4[1]); o.y = cvtpk_c(v2 * rs * g4[2], v3 * rs * g4[3]);
            *(u32x2*)(B_CN(F) + (size_t)t * 256 + 4 * lane) = o;
            const float x = bf2f(hr[C_CIK + lane]);
            const float mu = wave_sum(x) * (1.f / 64.f); const float d = x - mu;
            const float var = wave_sum(d * d) * (1.f / 64.f);
            const float y = d * rsqrtf(var + 1e-5f) * g1 + b1;
            B_IKN(F)[(size_t)t * 64 + lane] = (bf16_t)(cvtpk_c(y, 0.f) & 0xffffu);
        }
    }
    {
        LAS float* aas = (LAS float*)(F.lds + F.wave * 16384);
        const float* W2 = w_gate2 + (size_t)l * 16 * 1024; const float* BG = b_gate + (size_t)l * 1024;
        for (int u = gw; u < NCHUNK * 16; u += NGW) {
            const int c = u >> 4, dk = (u & 15) * 64 + lane;
            { const bf16_t* ap = H + (size_t)(64 * c + lane) * NPAD + C_AA;
              const bf16x8 a0 = *(const bf16x8*)ap, a1 = *(const bf16x8*)(ap + 8);
#pragma unroll
              for (int j = 0; j < 8; ++j) { aas[lane * 16 + j] = bf2f((unsigned short)a0[j]); aas[lane * 16 + 8 + j] = bf2f((unsigned short)a1[j]); } }
            float w2[16];
#pragma unroll
            for (int r = 0; r < 16; ++r) w2[r] = W2[r * 1024 + dk];
            const float bgv = BG[dk];
            LDS_WAIT();
            float total = 0.f;
            for (int t = 0; t < 64; ++t) {
                float z = bgv;
#pragma unroll
                for (int r = 0; r < 16; ++r) z += aas[t * 16 + r] * w2[r];
                total += (fminf(z, 0.f) - log1pf(expf(-fabsf(z)))) * (1.f / 16.f);
            }
            B_DEC(F)[(size_t)c * 1024 + dk] = expf(total);
            float run = 0.f;
            for (int t8 = 0; t8 < 8; ++t8) {
                float kd[8];
#pragma unroll
                for (int j = 0; j < 8; ++j) { const int t = 8 * t8 + j;
                    float z = bgv;
#pragma unroll
                    for (int r = 0; r < 16; ++r) z += aas[t * 16 + r] * w2[r];
                    run += (fminf(z, 0.f) - log1pf(expf(-fabsf(z)))) * (1.f / 16.f);
                    kd[j] = bf2f(H[(size_t)(64 * c + t) * NPAD + C_AK + dk]) * expf(total - run); }
                *(bf16x8*)(B_KDT(F) + ((size_t)c * 1024 + dk) * 64 + 8 * t8) = pack8f(kd[0], kd[1], kd[2], kd[3], kd[4], kd[5], kd[6], kd[7]);
            }
            LDS_WAIT();
        }
    }
    for (int u = gw; u < NCHUNK * 32; u += NGW) {
        const int c = u >> 5, dv = (u & 31) * 64 + lane;
#pragma unroll
        for (int t8 = 0; t8 < 8; ++t8) {
            unsigned short v[8];
#pragma unroll
            for (int j = 0; j < 8; ++j) v[j] = H[(size_t)(64 * c + 8 * t8 + j) * NPAD + C_AV + dv];
            u32x4 o = {(unsigned)v[0] | ((unsigned)v[1] << 16), (unsigned)v[2] | ((unsigned)v[3] << 16), (unsigned)v[4] | ((unsigned)v[5] << 16), (unsigned)v[6] | ((unsigned)v[7] << 16)};
            *(u32x4*)(B_VT(F) + ((size_t)c * 2048 + dv) * 64 + 8 * t8) = o;
        }
    }
}

__device__ __forceinline__ void post_phase(Frame& F, int l, float lam_init, const float* gla_g, const float* dlam, const float* diff_g) {
    int lane_ = F.lane; asm volatile("" : "+v"(lane_));
    const int gw = F.vcu * NWAVES + F.wave, NGW = F.G * NWAVES, lane = lane_;
    float lam;
    { const float* lp = dlam + (size_t)l * 512;
      const float p0 = lp[lane] * lp[128 + lane] + lp[64 + lane] * lp[192 + lane];
      const float p1 = lp[256 + lane] * lp[384 + lane] + lp[320 + lane] * lp[448 + lane];
      lam = expf(wave_sum(p0)) - expf(wave_sum(p1)) + lam_init; }
    { const float* g = gla_g + (size_t)l * 512;
      const f32x4 ga = *(const f32x4*)(g + 8 * lane), gb = *(const f32x4*)(g + 8 * lane + 4);
      for (int u = gw; u < SEQ * 4; u += NGW) {
          const int t = u >> 2, hd = u & 3;
          const float* src = B_OA(F) + (size_t)t * 2048 + hd * 512 + 8 * lane;
          const f32x4 a = *(const f32x4*)src, b = *(const f32x4*)(src + 4);
          const float ss = wave_sum((a[0] * a[0] + a[1] * a[1]) + (a[2] * a[2] + a[3] * a[3]) + (b[0] * b[0] + b[1] * b[1]) + (b[2] * b[2] + b[3] * b[3]));
          const float rs = rsqrtf(ss * (1.f / 512.f) + 1e-6f);
          const u32x4 gr = *(const u32x4*)(B_H(F) + (size_t)t * NPAD + C_AG + hd * 512 + 8 * lane);
          u32x4 o;
          o.x = cvtpk_c(a[0] * rs * ga[0] * silu(bflo(gr.x)), a[1] * rs * ga[1] * silu(bfhi(gr.x)));
          o.y = cvtpk_c(a[2] * rs * ga[2] * silu(bflo(gr.y)), a[3] * rs * ga[3] * silu(bfhi(gr.y)));
          o.z = cvtpk_c(b[0] * rs * gb[0] * silu(bflo(gr.z)), b[1] * rs * gb[1] * silu(bfhi(gr.z)));
          o.w = cvtpk_c(b[2] * rs * gb[2] * silu(bflo(gr.w)), b[3] * rs * gb[3] * silu(bfhi(gr.w)));
          *(u32x4*)(B_O(F) + (size_t)t * DM + hd * 512 + 8 * lane) = o;
      } }
    { const float* g = diff_g + (size_t)l * 256;
      const f32x4 g4 = *(const f32x4*)(g + 4 * lane); const float post = 1.f - lam_init;
      for (int u = gw; u < SEQ * 4; u += NGW) {
          const int t = u >> 2, hd = u & 3;
          const float* src = B_OD(F) + (size_t)t * 2048 + hd * 512 + 4 * lane;
          const f32x4 a0 = *(const f32x4*)src, a1 = *(const f32x4*)(src + 256);
          const f32x4 d = a0 - a1 * lam;
          const float ss = wave_sum((d[0] * d[0] + d[1] * d[1]) + (d[2] * d[2] + d[3] * d[3]));
          const float rs = rsqrtf(ss * (1.f / 256.f) + 1e-6f) * post;
          const u32x2 gr = *(const u32x2*)(B_H(F) + (size_t)t * NPAD + C_BG + hd * 256 + 4 * lane);
          u32x2 o;
          o.x = cvtpk_c(d[0] * rs * g4[0] * silu(bflo(gr.x)), d[1] * rs * g4[1] * silu(bfhi(gr.x)));
          o.y = cvtpk_c(d[2] * rs * g4[2] * silu(bflo(gr.y)), d[3] * rs * g4[3] * silu(bfhi(gr.y)));
          *(u32x2*)(B_O(F) + (size_t)t * DM + 2048 + hd * 256 + 4 * lane) = o;
      } }
}

__device__ __forceinline__ void ln_phase(Frame& F, int l, const float* ln_g, const float* ln_b, float* outp) {
    int lane_ = F.lane; asm volatile("" : "+v"(lane_));
    const int gw = F.vcu * NWAVES + F.wave, NGW = F.G * NWAVES, lane = lane_;
    const float* g = ln_g + (size_t)l * DM; const float* b = ln_b + (size_t)l * DM;
    float* dst = (l == DEPTH - 1) ? outp : B_XF(F);
    for (int t = gw; t < SEQ; t += NGW) {
        const f32x4* xr = (const f32x4*)(B_XF(F) + (size_t)t * DM) + lane;
        f32x4 v[16]; float s = 0.f;
#pragma unroll
        for (int j = 0; j < 16; ++j) { v[j] = xr[64 * j]; s += (v[j][0] + v[j][1]) + (v[j][2] + v[j][3]); }
        const float mean = wave_sum(s) * (1.f / DM); float s2 = 0.f;
#pragma unroll
        for (int j = 0; j < 16; ++j) { v[j] = v[j] - mean; s2 += (v[j][0] * v[j][0] + v[j][1] * v[j][1]) + (v[j][2] * v[j][2] + v[j][3] * v[j][3]); }
        const float rstd = rsqrtf(wave_sum(s2) * (1.f / DM) + 1e-5f);
        f32x4* orow = (f32x4*)(dst + (size_t)t * DM) + lane;
        u32x2* brow = (u32x2*)(B_XB(F) + (size_t)t * DM) + lane;
#pragma unroll
        for (int j = 0; j < 16; ++j) {
            const f32x4 gg = *((const f32x4*)g + lane + 64 * j), bb = *((const f32x4*)b + lane + 64 * j);
            const f32x4 y = v[j] * rstd * gg + bb;
            orow[64 * j] = y;
            u32x2 w; w.x = cvtpk_c(y[0], y[1]); w.y = cvtpk_c(y[2], y[3]); brow[64 * j] = w;
        }
    }
}
namespace gla {
constexpr int KD_ROW = 144, Q_ROW = 528, V_ROW = 144;
constexpr int L_KD = 0, L_Q = L_KD + 256 * KD_ROW, L_V = L_Q + 64 * Q_ROW, L_DEC = L_V + 128 * V_ROW, L_END = L_DEC + 1024;
}
static_assert(gla::L_END <= MISC_OFF, "GLA LDS map");
__device__ __forceinline__ void gla_unit(Frame& F, int unit) {
    using namespace gla;
    int tid_ = F.tid; asm volatile("" : "+v"(tid_));
    const int tid = tid_, lane = tid & 63, c16 = lane & 15, g = lane >> 4, wave = F.wave;
    const int head = unit >> 2, blk = unit & 3;
    const int dv0 = 128 * blk + 16 * wave;
    LAS unsigned char* lds = F.lds;
    f32x4 S[16];
#pragma unroll
    for (int T = 0; T < 16; ++T) S[T] = (f32x4){0.f, 0.f, 0.f, 0.f};
    const bf16_t* kd_g = B_KDT(F) + (size_t)head * 256 * 64 + (size_t)tid * 8;
    const bf16_t* q_g = B_H(F) + (size_t)(tid >> 5) * NPAD + C_AQ + head * 256 + (tid & 31) * 8;
    const bf16_t* v_g = B_VT(F) + ((size_t)head * 512 + 128 * blk) * 64 + (size_t)tid * 8;
    const float* d_g = B_DEC(F) + head * 256 + (tid & 63) * 4;
    const int kd_w = (tid >> 3) * KD_ROW + (tid & 7) * 16;
    const int q_w = (tid >> 5) * Q_ROW + (tid & 31) * 16;
    const int v_w = (tid >> 3) * V_ROW + (tid & 7) * 16;
    u32x4 skd[4], sq[4], sv[2]; f32x4 sd;
#define GLA_LOAD(c_) do { _Pragma("unroll") for (int i = 0; i < 4; ++i) skd[i] = *(const u32x4*)(kd_g + (size_t)(c_) * 1024 * 64 + i * 4096); \
        _Pragma("unroll") for (int i = 0; i < 4; ++i) sq[i] = *(const u32x4*)(q_g + (size_t)(64 * (c_) + 16 * i) * NPAD);                        \
        _Pragma("unroll") for (int i = 0; i < 2; ++i) sv[i] = *(const u32x4*)(v_g + (size_t)(c_) * 2048 * 64 + i * 4096);                        \
        if (tid < 64) sd = *(const f32x4*)(d_g + (size_t)(c_) * 1024); } while (0)
#define GLA_WRITE() do { _Pragma("unroll") for (int i = 0; i < 4; ++i) *(LAS u32x4*)(lds + L_KD + kd_w + i * 64 * KD_ROW) = skd[i];            \
        _Pragma("unroll") for (int i = 0; i < 4; ++i) *(LAS u32x4*)(lds + L_Q + q_w + i * 16 * Q_ROW) = sq[i];                                   \
        _Pragma("unroll") for (int i = 0; i < 2; ++i) *(LAS u32x4*)(lds + L_V + v_w + i * 64 * V_ROW) = sv[i];                                   \
        if (tid < 64) *(LAS f32x4*)(lds + L_DEC + tid * 16) = sd; } while (0)
    const int a_rd = L_KD + c16 * KD_ROW + 16 * g;
    const int b_rd = L_V + (16 * wave + c16) * V_ROW + 16 * g;
    const int q_rd = L_Q + c16 * Q_ROW + 8 * g;
    const int d_rd = L_DEC + 16 * g;
    float* o_l = B_OA(F) + (size_t)(4 * g) * 2048 + head * 512 + dv0 + c16;
    GLA_LOAD(0);
    __syncthreads();
    GLA_WRITE();
    for (int c = 0; c < NCHUNK; ++c) {
        __syncthreads();
        if (c + 1 < NCHUNK) GLA_LOAD(c + 1);
        const bf16x8 vb0 = *(const LAS bf16x8*)(lds + b_rd), vb1 = *(const LAS bf16x8*)(lds + b_rd + 64);
#pragma unroll
        for (int T4 = 0; T4 < 4; ++T4) {
            bf16x8 a[4][2]; f32x4 d4[4];
#pragma unroll
            for (int i = 0; i < 4; ++i) { const int T = 4 * T4 + i;
                a[i][0] = *(const LAS bf16x8*)(lds + a_rd + T * 16 * KD_ROW); a[i][1] = *(const LAS bf16x8*)(lds + a_rd + T * 16 * KD_ROW + 64);
                d4[i] = *(const LAS f32x4*)(lds + d_rd + 64 * T); }
#pragma unroll
            for (int i = 0; i < 4; ++i) { const int T = 4 * T4 + i;
                f32x4 acc = (f32x4){0.f, 0.f, 0.f, 0.f};
                acc = MFMA16(a[i][0], vb0, acc); acc = MFMA16(a[i][1], vb1, acc);
                S[T] = S[T] * d4[i] + acc; }
        }
        bf16x8 sb[8];
#pragma unroll
        for (int s = 0; s < 8; ++s) sb[s] = pack8f(S[2 * s][0], S[2 * s][1], S[2 * s][2], S[2 * s][3], S[2 * s + 1][0], S[2 * s + 1][1], S[2 * s + 1][2], S[2 * s + 1][3]);
#pragma unroll
        for (int tt = 0; tt < 4; ++tt) {
            u32x2 ql[8], qh[8];
#pragma unroll
            for (int s = 0; s < 8; ++s) { ql[s] = *(const LAS u32x2*)(lds + q_rd + tt * 16 * Q_ROW + 64 * s); qh[s] = *(const LAS u32x2*)(lds + q_rd + tt * 16 * Q_ROW + 64 * s + 32); }
            f32x4 acc = (f32x4){0.f, 0.f, 0.f, 0.f};
#pragma unroll
            for (int s = 0; s < 8; ++s) { const u32x4 aw = {ql[s].x, ql[s].y, qh[s].x, qh[s].y}; acc = MFMA16(__builtin_bit_cast(bf16x8, aw), sb[s], acc); }
            float* op = o_l + (size_t)(64 * c + 16 * tt) * 2048;
#pragma unroll
            for (int r = 0; r < 4; ++r) op[(size_t)r * 2048] = acc[r] * 0.0625f;
        }
        __syncthreads();
        if (c + 1 < NCHUNK) GLA_WRITE();
    }
#undef GLA_LOAD
#undef GLA_WRITE
}
__device__ __forceinline__ unsigned f2key(float s) { const unsigned b = __float_as_uint(s); return b ^ ((b >> 31) ? 0xFFFFFFFFu : 0x80000000u); }
__device__ __forceinline__ int half_sum(int c) { c += __shfl_xor(c, 1); c += __shfl_xor(c, 2); c += __shfl_xor(c, 4); c += __shfl_xor(c, 8); c += __shfl_xor(c, 16); return c; }
__device__ __forceinline__ unsigned half_of(unsigned long long b, int hh) { return hh ? (unsigned)(b >> 32) : (unsigned)b; }
__device__ __forceinline__ void compact256(LAS unsigned* cv, LAS unsigned* ci, int& cnt, unsigned& thr, int lane32, int hh) {
    unsigned k[16], id[16];
#pragma unroll
    for (int i = 0; i < 16; ++i) { const int e = lane32 + 32 * i; k[i] = (e < cnt) ? cv[e] : 0u; id[i] = ci[e]; }
    unsigned T = 0u;
    for (int b = 31; b >= 0; --b) {
        const unsigned cand = T | (1u << b); int c = 0;
#pragma unroll
        for (int i = 0; i < 16; ++i) c += (k[i] >= cand) ? 1 : 0;
        c = half_sum(c);
        if (c >= 256) T = cand;
    }
    int ngt = 0;
#pragma unroll
    for (int i = 0; i < 16; ++i) ngt += (k[i] > T) ? 1 : 0;
    ngt = half_sum(ngt);
    const int rties = 256 - ngt;
    const unsigned ltm = (1u << lane32) - 1u;
    int kept = 0, tieseen = 0;
#pragma unroll
    for (int i = 0; i < 16; ++i) {
        const bool gt = k[i] > T, eq = (k[i] == T) && (T != 0u);
        const unsigned meq = half_of(__ballot(eq), hh);
        const int trank = tieseen + __popc(meq & ltm);
        const bool keep = gt || (eq && trank < rties);
        const unsigned mk = half_of(__ballot(keep), hh);
        const int pos = kept + __popc(mk & ltm);
        if (keep) { cv[pos] = k[i]; ci[pos] = id[i]; }
        kept += __popc(mk); tieseen += __popc(meq);
    }
    cnt = kept; thr = T;
}
__device__ __forceinline__ int goff(int row, int ch) { return 512 * row + 16 * ((ch & 16) | ((ch & 15) ^ (((row & 3) << 2) | ((row >> 2) & 3)))); }

__device__ __forceinline__ void sparse_unit(Frame& F, int l, int unit) {
    int lane_ = F.lane; asm volatile("" : "+v"(lane_));
    const int lane = lane_, wave = F.wave, r32 = lane & 31, hh = lane >> 5, c16 = lane & 15, g = lane >> 4;
    const int t0 = 16 * unit, tq0 = t0 + 2 * wave;
    const int N = 64 * ((t0 >> 6) + 1), nkb = N >> 5;
    LAS unsigned char* reg = F.lds + wave * WREG;
    LAS unsigned* cv = (LAS unsigned*)(reg + hh * 2048);
    LAS unsigned* ci = (LAS unsigned*)(reg + 4096 + hh * 2048);
    LAS unsigned short* sel = (LAS unsigned short*)(reg + 16384);
    const bf16_t* H = B_H(F);
    int cnt = 0;
    {
        const int qq = (r32 >> 2) & 1, hd = (r32 & 3) + 4 * (r32 >> 3);
        bf16x8 A[4];
#pragma unroll
        for (int s = 0; s < 4; ++s) A[s] = *(const bf16x8*)(H + (size_t)(tq0 + qq) * NPAD + C_CIQ + hd * 64 + 16 * s + 8 * hh);
        float wv[16];
        { const bf16_t* wp = H + (size_t)(tq0 + hh) * NPAD + C_CIW;
          const bf16x8 w0 = *(const bf16x8*)wp, w1 = *(const bf16x8*)(wp + 8);
#pragma unroll
          for (int j = 0; j < 8; ++j) { wv[j] = bf2f((unsigned short)w0[j]) * 0.03125f; wv[8 + j] = bf2f((unsigned short)w1[j]) * 0.03125f; } }
        unsigned thr = 0u;
        const unsigned ltm = (1u << r32) - 1u;
        const bf16_t* kp = B_IKN(F) + (size_t)r32 * 64 + 8 * hh;
        for (int kb = 0; kb < nkb; ++kb) {
            bf16x8 B[4];
#pragma unroll
            for (int s = 0; s < 4; ++s) B[s] = *(const bf16x8*)(kp + (size_t)kb * 32 * 64 + 16 * s);
            f32x16 acc = {};
#pragma unroll
            for (int s = 0; s < 4; ++s) acc = MFMA32(A[s], B[s], acc);
            float sc = 0.f;
#pragma unroll
            for (int j = 0; j < 16; ++j) sc = fmaf(fmaxf(acc[j], 0.f), wv[j], sc);
            const unsigned key = f2key(sc);
            const bool f = key > thr;
            const unsigned mh = half_of(__ballot(f), hh);
            const int pos = cnt + __popc(mh & ltm);
            if (f) { cv[pos] = key; ci[pos] = (unsigned)(32 * kb + r32); }
            cnt += __popc(mh);
            if (__any(cnt > 480)) compact256(cv, ci, cnt, thr, r32, hh);
        }
        if (__any(cnt > 256)) compact256(cv, ci, cnt, thr, r32, hh);
#pragma unroll
        for (int i = 0; i < 8; ++i) { const int e = r32 + 32 * i; if (e < cnt) sel[hh * 256 + e] = (unsigned short)ci[e]; }
    }
    const int ns0 = __shfl(cnt, 0), ns1 = __shfl(cnt, 32);
    LDS_WAIT();
    const int q4 = c16 >> 2, p4 = c16 & 3;
    const int trx = (q4 << 2) | g;
    const unsigned gb = (unsigned)(uintptr_t)reg;
    unsigned tra[8];
#pragma unroll
    for (int c = 0; c < 8; ++c) tra[c] = gb + 512 * (4 * g + q4) + 8 * (p4 & 1) + 16 * ((2 * c + (p4 >> 1)) ^ trx);
    LAS unsigned short* ol = (LAS unsigned short*)(reg + 8192);
#pragma unroll 1
    for (int qi = 0; qi < 2; ++qi) {
        const int tq = tq0 + qi, ns = qi ? ns1 : ns0;
        bf16x8 qf[8];
#pragma unroll
        for (int s = 0; s < 8; ++s) { bf16x8 z = {}; qf[s] = (c16 < 8) ? *(const bf16x8*)(H + (size_t)tq * NPAD + C_CQ + c16 * 256 + 32 * s + 8 * g) : z; }
        f32x4 Z[16];
#pragma unroll
        for (int c = 0; c < 16; ++c) Z[c] = (f32x4){0.f, 0.f, 0.f, 0.f};
        float m = -1e30f, ls = 0.f;
        const int nsb = (ns + 15) >> 4;
        for (int j = 0; j < nsb; ++j) {
            u32x4 dat[8];
#pragma unroll
            for (int i = 0; i < 8; ++i) { const int row = hh + 2 * i, e = 16 * j + row; const int idx = (e < ns) ? (int)sel[qi * 256 + e] : 0;
                dat[i] = *(const u32x4*)(B_CN(F) + (size_t)idx * 256 + 8 * r32); }
#pragma unroll
            for (int i = 0; i < 8; ++i) { const int row = hh + 2 * i; *(LAS u32x4*)(reg + goff(row, r32)) = dat[i]; }
            f32x4 st = (f32x4){0.f, 0.f, 0.f, 0.f};
#pragma unroll
            for (int s = 0; s < 8; ++s) { const bf16x8 a = *(const LAS bf16x8*)(reg + goff(c16, 4 * s + g)); st = MFMA16(a, qf[s], st); }
            float mloc = -__builtin_inff();
#pragma unroll
            for (int r = 0; r < 4; ++r) { const int e = 16 * j + 4 * g + r; const float v = (e < ns) ? st[r] * 0.0625f : -__builtin_inff(); st[r] = v; mloc = fmaxf(mloc, v); }
            mloc = fmaxf(mloc, __shfl_xor(mloc, 16)); mloc = fmaxf(mloc, __shfl_xor(mloc, 32));
            const float mn = fmaxf(m, mloc), alpha = __expf(m - mn);
            float ps = 0.f;
#pragma unroll
            for (int r = 0; r < 4; ++r) { const float p = __expf(st[r] - mn); st[r] = p; ps += p; }
            ps += __shfl_xor(ps, 16); ps += __shfl_xor(ps, 32);
            ls = ls * alpha + ps; m = mn;
            const bf16x8 pa = pack8f(st[0], st[1], st[2], st[3], 0.f, 0.f, 0.f, 0.f);
            if (__any(alpha < 1.f)) {
                float ar[4];
#pragma unroll
                for (int r = 0; r < 4; ++r) ar[r] = __shfl(alpha, 4 * g + r);
#pragma unroll
                for (int c = 0; c < 16; ++c)
#pragma unroll
                    for (int r = 0; r < 4; ++r) Z[c][r] *= ar[r];
            }
#define TRRD(dst, a, off) asm volatile("ds_read_b64_tr_b16 %0, %1 offset:%2" : "=&v"(dst) : "v"(a), "i"(off) : "memory")
#pragma unroll
            for (int c = 0; c < 8; c += 2) {
                s16x4 l0, l1, l2, l3;
                TRRD(l0, tra[c], 0); TRRD(l1, tra[c], 256); TRRD(l2, tra[c + 1], 0); TRRD(l3, tra[c + 1], 256);
                asm volatile("s_waitcnt lgkmcnt(0)" ::: "memory"); __builtin_amdgcn_sched_barrier(0);
                Z[c] = MFMA16(pa, ((bf16x8){l0[0], l0[1], l0[2], l0[3], 0, 0, 0, 0}), Z[c]);
                Z[c + 8] = MFMA16(pa, ((bf16x8){l1[0], l1[1], l1[2], l1[3], 0, 0, 0, 0}), Z[c + 8]);
                Z[c + 1] = MFMA16(pa, ((bf16x8){l2[0], l2[1], l2[2], l2[3], 0, 0, 0, 0}), Z[c + 1]);
                Z[c + 9] = MFMA16(pa, ((bf16x8){l3[0], l3[1], l3[2], l3[3], 0, 0, 0, 0}), Z[c + 9]);
            }
#undef TRRD
        }
        float inv[4];
#pragma unroll
        for (int r = 0; r < 4; ++r) inv[r] = 1.f / __shfl(ls, 4 * g + r);
        if (g < 2) {
#pragma unroll
            for (int c = 0; c < 16; ++c) {
                const int lat = 16 * c + c16;
#pragma unroll
                for (int r = 0; r < 4; ++r) ol[(qi * 8 + 4 * g + r) * 256 + lat] = (unsigned short)(cvtpk_c(Z[c][r] * inv[r], 0.f) & 0xffffu);
            }
        }
    }
    LDS_WAIT();
    __syncthreads();
    {
        const int hd = wave;
        bf16x8 A[8];
#pragma unroll
        for (int s = 0; s < 8; ++s) A[s] = *(const LAS bf16x8*)(F.lds + (c16 >> 1) * WREG + 8192 + (((c16 & 1) * 8 + hd) * 256 + 32 * s + 8 * g) * 2);
        const bf16_t* wb = B_WUVT(F) + ((size_t)(l * 8 + hd) * 128 + c16) * 256 + 8 * g;
#pragma unroll 1
        for (int n = 0; n < 8; ++n) {
            f32x4 acc = (f32x4){0.f, 0.f, 0.f, 0.f};
#pragma unroll
            for (int s = 0; s < 8; ++s) { const bf16x8 b = *(const bf16x8*)(wb + (size_t)n * 16 * 256 + 32 * s); acc = MFMA16(A[s], b, acc); }
#pragma unroll
            for (int r = 0; r < 4; ++r) { const int t = t0 + 4 * g + r; const int col = hd * 128 + 16 * n + c16;
                const float gt = bf2f(H[(size_t)t * NPAD + C_CG + col]);
                B_O(F)[(size_t)t * DM + 3072 + col] = (bf16_t)(cvtpk_c(acc[r] * silu(gt), 0.f) & 0xffffu); }
        }
    }
}
__device__ __forceinline__ dattn::BlockRef dattn_ref(const bf16_t* H, float* OD, int id) {
    dattn::BlockRef r; const int qb = 63 - (id >> 4), ph = id & 15, hd = ph >> 2, mp = (ph >> 1) & 1, e = ph & 1;
    r.Q = H + (size_t)(qb * 256) * NPAD + C_BQ + hd * 256 + mp * 128; r.K = H + C_BK + hd * 256 + mp * 128; r.V = H + C_BV + hd * 256 + e * 128;
    r.O = OD + (size_t)(qb * 256) * 2048 + hd * 512 + mp * 256 + e * 128; r.P0 = qb * 256; return r;
}
__device__ __forceinline__ void mix_phase(Frame& F, int l) {
#ifndef MIXMASK
#define MIXMASK 7
#endif
    if (MIXMASK & 1) for (int u = grab(F, l * 4 + 0); u < 16; u = grab(F, l * 4 + 0)) gla_unit(F, u);
    {

        int cur = (MIXMASK & 2) ? grab(F, l * 4 + 1) : 1024;
        if (cur < 1024) {
            dattn::Seam S;
            dattn::BlockRef rc = dattn_ref(B_H(F), B_OD(F), cur);
            dattn::prime(rc, (char*)F.lds, S);
            for (;;) {
                const int nx = grab(F, l * 4 + 1); const bool last = nx >= 1024;
                const dattn::BlockRef rn = last ? rc : dattn_ref(B_H(F), B_OD(F), nx);
                dattn::block(rc, rn, (char*)F.lds, S);
                if (last) break;
                rc = rn;
            }
            VM_WAIT(); __syncthreads();
        }
    }
    if (MIXMASK & 4) for (int u = grab(F, l * 4 + 2); u < SEQ / 16; u = grab(F, l * 4 + 2)) sparse_unit(F, l, SEQ / 16 - 1 - u);
}

struct Args { const float* in[14]; float* out; unsigned char* ws; int ph_lo, ph_hi, li, pad; };
constexpr int NPHASE = 1 + 6 * DEPTH;
__global__ void __launch_bounds__(NWAVES * 64, 2) trunk_fwd(Args args) {
    extern __shared__ __attribute__((aligned(16))) unsigned char lds[];
    Frame F;
    F.lds = (LAS unsigned char*)lds;
    F.MISC = (volatile LAS unsigned*)(F.lds + MISC_OFF);
    F.tid = threadIdx.x; F.lane = F.tid & 63; F.wave = __builtin_amdgcn_readfirstlane(F.tid >> 6);
    F.G = gridDim.x; { const int bx = blockIdx.x; F.vcu = (F.G % 8 == 0) ? (bx % 8) * (F.G / 8) + bx / 8 : bx; }
    F.ws = args.ws;
    F.ctl = (gu32*)(args.ws + WS_CTL);
    if (F.tid < 128) ((LAS unsigned*)(F.lds + MISC_OFF))[F.tid] = 0u;
    __syncthreads();
    XcdBarrier bar = xcd_barrier_post((unsigned*)(F.ctl + CW_BAR) + args.li * BAR_STRIDE, F.MISC + 0);
    const int lo = args.ph_lo, hi = args.ph_hi;
#ifndef PMASK
#define PMASK 0x7f
#endif
#define IN(k) (lo <= (k) && (k) < hi)
#define SEAM(k) do { if ((k) + 1 < hi) xcd_barrier(bar); } while (0)
    if ((PMASK & 1) && IN(0)) { p0_prologue(F, args.in[0], args.in[1], args.in[2], args.in[11]); SEAM(0); }
    for (int l = 0; l < DEPTH; ++l) {
        const int pb = 1 + 6 * l;
        const float lam_init = 0.8f - 0.6f * expf(-0.3f * (float)l);
        if ((PMASK & 2) && IN(pb + 0)) {
            pg8::Gemm g{B_XB(F), B_WTIN(F) + (size_t)l * NPAD * DM, SEQ, NPAD, DM}; pg8::StaticOrder S; S.init(SEQ, NPAD, F.G, (int)blockIdx.x);
            pg8::EpiBf16Plain E{B_H(F), NPAD};
            pg8::gemm_phase<pg8::EpiBf16Plain, pg8::StaticOrder, true, true>(F.lds, g, S, E);
            SEAM(pb + 0);
        }
        if ((PMASK & 4) && IN(pb + 1)) { prep_phase(F, l, args.in[3], args.in[4], args.in[8], args.in[9], args.in[10]); SEAM(pb + 1); }
        if ((PMASK & 8) && IN(pb + 2)) { mix_phase(F, l); SEAM(pb + 2); }
        if ((PMASK & 16) && IN(pb + 3)) { post_phase(F, l, lam_init, args.in[5], args.in[6], args.in[7]); SEAM(pb + 3); }
        if ((PMASK & 32) && IN(pb + 4)) {
            pg8::Gemm g{B_O(F), B_WTOUT(F) + (size_t)l * DM * DM, SEQ, DM, DM}; pg8::StaticOrder S; S.init(SEQ, DM, F.G, (int)blockIdx.x);
            pg8::EpiResid E{l == 0 ? args.in[0] : B_XF(F), B_XF(F), DM, 1.6817928305074290f};
            pg8::gemm_phase<pg8::EpiResid, pg8::StaticOrder, true, true>(F.lds, g, S, E);
            SEAM(pb + 4);
        }
        if ((PMASK & 64) && IN(pb + 5)) { ln_phase(F, l, args.in[12], args.in[13], args.out); SEAM(pb + 5); }
    }
#undef IN
#undef SEAM
}

#ifndef MK_N_LAUNCHES
#define MK_N_LAUNCHES 1
#endif
extern "C" void kernel_launch(void* const* d_in, const int* in_sizes, int n_in, void* d_out, int out_size, void* d_ws, size_t ws_size, hipStream_t stream) {
    static int grid = 0;
    if (grid == 0) {
        if (n_in != 14 || in_sizes[0] != SEQ * DM || out_size != SEQ * DM || ws_size < WS_END) {
            fprintf(stderr, "kernel_launch: shape mismatch (n_in %d, in0 %d, out %d, ws %zu; need ws >= %zu)\n", n_in, n_in > 0 ? in_sizes[0] : -1, out_size, ws_size, (size_t)WS_END); grid = -1; return; }
        int dev = 0, cus = 0, per_cu = 0;
        if (hipGetDevice(&dev) != hipSuccess || hipDeviceGetAttribute(&cus, hipDeviceAttributeMultiprocessorCount, dev) != hipSuccess) { grid = -1; return; }
        if (hipFuncSetAttribute((const void*)trunk_fwd, hipFuncAttributeMaxDynamicSharedMemorySize, LDS_BYTES) != hipSuccess) { fprintf(stderr, "kernel_launch: hipFuncSetAttribute failed\n"); grid = -1; return; }
        if (hipOccupancyMaxActiveBlocksPerMultiprocessor(&per_cu, (const void*)trunk_fwd, NWAVES * 64, LDS_BYTES) != hipSuccess || per_cu < 1)
            fprintf(stderr, "kernel_launch: occupancy query reports %d workgroups per CU\n", per_cu);
        (void)hipGetLastError();
        grid = cus;
    }
    if (grid < 0) return;
    if (hipMemsetAsync((char*)d_ws + WS_CTL, 0, CTL_ZERO_BYTES, stream) != hipSuccess) return;
    Args a{};
    for (int i = 0; i < 14; ++i) a.in[i] = (const float*)d_in[i];
    a.out = (float*)d_out; a.ws = (unsigned char*)d_ws;
    constexpr int NL = MK_N_LAUNCHES;
    for (int li = 0; li < NL; ++li) {
        a.ph_lo = (NPHASE * li) / NL; a.ph_hi = (NPHASE * (li + 1)) / NL; a.li = li; a.pad = 0;
        hipLaunchKernelGGL(trunk_fwd, dim3(grid), dim3(NWAVES * 64), LDS_BYTES, stream, a);
        const hipError_t le = hipPeekAtLastError();
        if (le != hipSuccess) { fprintf(stderr, "kernel_launch: launch %d failed: %s\n", li, hipGetErrorName(le)); break; }
    }
}
```

```cpp
#include <hip/hip_runtime.h>
#include <cstdio>
#include <cstdint>

#define GAS __attribute__((address_space(1)))
#define LAS __attribute__((address_space(3)))
typedef unsigned short bf16_t;
typedef short s16x4 __attribute__((ext_vector_type(4)));
typedef float f32x16 __attribute__((ext_vector_type(16)));
typedef unsigned u32x2 __attribute__((ext_vector_type(2)));
typedef GAS unsigned gu32;

__device__ __forceinline__ int hw_lane() { int r; asm volatile("v_mbcnt_lo_u32_b32 %0, -1, 0\n\tv_mbcnt_hi_u32_b32 %0, -1, %0" : "=v"(r)); return r; }

constexpr int SEQ = 16384, DM = 4096, DEPTH = 4, NIN = 14688, NPAD = 14848;
constexpr int CHUNK = 64, NCHUNK = SEQ / CHUNK;
constexpr int C_AQ = 0, C_AK = 1024, C_AV = 2048, C_AG = 4096, C_BQ = 6144, C_BK = 7168, C_BV = 8192, C_BG = 9216, C_CQ = 10240,
              C_CKV = 12288, C_CIQ = 12544, C_CG = 13568, C_CIK = 14592, C_AA = 14656, C_CIW = 14672;
__host__ __device__ __forceinline__ int srccol(int n) {
    if (n < 4096) return n;
    if (n < 6144) return n + 16;
    if (n < 13568) return n + 16;
    if (n < 14592) return n + 96;
    if (n < 14656) return n - 1008;
    if (n < 14672) return n - 10560;
    if (n < 14688) return n - 1024;
    return -1;
}
namespace pg8 {
#define PG8_LAS __attribute__((address_space(3)))
typedef unsigned short bf16_t;
typedef short bf16x8 __attribute__((ext_vector_type(8)));
typedef float f32x4 __attribute__((ext_vector_type(4)));
typedef unsigned u32x4 __attribute__((ext_vector_type(4)));
constexpr int BM = 256, BK = 64, HALF = 128, HTB = HALF * BK * 2  , STAGE_BYTES = 8 * HTB, NXCD = 8, WGM = 8;

__host__ __device__ __forceinline__ int lds_byte(int r, int c) { const int st = (r >> 4) * 2 + (c >> 5), rr = r & 15, cc = c & 31, ob = rr * 64 + cc * 2; return st * 1024 + (ob ^ (((ob >> 9) & 1) << 5)); }
__host__ __device__ __forceinline__ void stage_rc(int b, int& R, int& C) { const int st = b / 1024, sb = b % 1024, swz = sb ^ (((sb >> 9) & 1) << 5); R = (st >> 1) * 16 + swz / 64; C = (st & 1) * 32 + (swz % 64) / 2; }
__host__ __device__ __forceinline__ int perm32(int rho) { const int n = rho >> 4, i = rho & 15; return 8 * (i >> 2) + 4 * n + (i & 3); }

struct Unit { int pm, pn; };
struct Gemm { const bf16_t* A; const bf16_t* Bt; int M, N, K; };

struct StaticOrder {
    int nM, nN, nwg, G, c;
    __host__ __device__ void init(int M, int N, int G_, int c_) { nM = M / BM; nN = N / BM; nwg = nM * nN; G = G_; c = c_; }
    __host__ __device__ bool next(int i, Unit& u) const {
        const long L = (long)i * G + c; if (L >= nwg) return false;
        int wgid = (int)L; { const int q = nwg / NXCD, r = nwg % NXCD, xcd = wgid % NXCD, off = wgid / NXCD; wgid = (xcd < r ? xcd * (q + 1) : r * (q + 1) + (xcd - r) * q) + off; }
        const int nig = WGM * nN, gid = wgid / nig, fm = gid * WGM, gsz = (nM - fm) < WGM ? (nM - fm) : WGM;
        u.pm = fm + ((wgid % nig) % gsz); u.pn = (wgid % nig) / gsz; return true;
    }
    __device__ __forceinline__ void a_ready(const Unit&) const {}
    __device__ __forceinline__ void done(const Unit&) const {}
};

__device__ __forceinline__ unsigned cvt_pk_bf16(float lo, float hi) { unsigned r; asm volatile("v_cvt_pk_bf16_f32 %0, %1, %2" : "=v"(r) : "v"(lo), "v"(hi)); return r; }
typedef float f32x2 __attribute__((ext_vector_type(2)));
struct EpiBf16Plain {
    static constexpr bool PERM = true, AFTER_DRAIN = false;
    bf16_t* O; int ldc;
    __device__ __forceinline__ void operator()(const f32x4 (&acc)[2][2][4][2], const Unit& u, int wr, int wc, int fr, int fq) const {
        const int row0 = u.pm * BM + wr * 64 + fr, col0 = u.pn * BM + wc * 32 + 8 * fq;
#pragma unroll
        for (int ai = 0; ai < 2; ++ai)
#pragma unroll
            for (int m = 0; m < 4; ++m) { bf16_t* rowp = O + (size_t)(row0 + ai * HALF + m * 16) * ldc + col0;
#pragma unroll
                for (int bj = 0; bj < 2; ++bj) { const f32x4 v0 = acc[ai][bj][m][0], v1 = acc[ai][bj][m][1];
                    u32x4 w; w.x = cvt_pk_bf16(v0[0], v0[1]); w.y = cvt_pk_bf16(v0[2], v0[3]); w.z = cvt_pk_bf16(v1[0], v1[1]); w.w = cvt_pk_bf16(v1[2], v1[3]);
                    *(u32x4*)(rowp + bj * HALF) = w; } }
    }
};
struct EpiResid {
    static constexpr bool PERM = false, AFTER_DRAIN = false;
    const float* Xin; float* Xout; int ldc; float alpha;
    __device__ __forceinline__ void operator()(const f32x4 (&acc)[2][2][4][2], const Unit& u, int wr, int wc, int fr, int fq) const {
        const int row0 = u.pm * BM + wr * 64 + fr, col0 = u.pn * BM + wc * 32 + 4 * fq;
#pragma unroll
        for (int ai = 0; ai < 2; ++ai)
#pragma unroll
            for (int m = 0; m < 4; ++m) { const size_t off = (size_t)(row0 + ai * HALF + m * 16) * ldc + col0;
#pragma unroll
                for (int bj = 0; bj < 2; ++bj)
#pragma unroll
                    for (int n = 0; n < 2; ++n) { const f32x4 xi = *(const f32x4*)(Xin + off + bj * HALF + n * 16);
                        *(f32x4*)(Xout + off + bj * HALF + n * 16) = xi * alpha + acc[ai][bj][m][n]; }
                asm volatile("" ::: "memory"); }
    }
};
struct EpiResidB {
    static constexpr bool PERM = false, AFTER_DRAIN = false;
    const bf16_t* Xin; float* Xout; int ldc; float alpha;
    __device__ __forceinline__ void operator()(const f32x4 (&acc)[2][2][4][2], const Unit& u, int wr, int wc, int fr, int fq) const {
        const int row0 = u.pm * BM + wr * 64 + fr, col0 = u.pn * BM + wc * 32 + 4 * fq;
#pragma unroll
        for (int ai = 0; ai < 2; ++ai)
#pragma unroll
            for (int m = 0; m < 4; ++m) { const size_t off = (size_t)(row0 + ai * HALF + m * 16) * ldc + col0;
#pragma unroll
                for (int bj = 0; bj < 2; ++bj)
#pragma unroll
                    for (int n = 0; n < 2; ++n) { const unsigned long long w = *(const unsigned long long*)(Xin + off + bj * HALF + n * 16);
                        const unsigned lo = (unsigned)w, hi = (unsigned)(w >> 32);
                        const f32x4 xi = {__uint_as_float(lo << 16), __uint_as_float(lo & 0xffff0000u), __uint_as_float(hi << 16), __uint_as_float(hi & 0xffff0000u)};
                        *(f32x4*)(Xout + off + bj * HALF + n * 16) = xi * alpha + acc[ai][bj][m][n]; }
                asm volatile("" ::: "memory"); }
    }
};
template <class Epi, class Sched, bool ALIGN_EPI = false, bool SP2 = false>
__device__ __forceinline__ void gemm_phase(PG8_LAS unsigned char* lds, const Gemm g, const Sched& S, const Epi& E, int wave_id) {
    int tid_ = wave_id * 64 + hw_lane(); asm volatile("" : "+v"(tid_));
    const int tid = tid_, wid = __builtin_amdgcn_readfirstlane(tid >> 6), lane = tid & 63, wr = wid >> 2, wc = wid & 3, fr = lane & 15, fq = lane >> 4;
    const int K = g.K, nt = K / BK;
    unsigned voffA[2], voffB[2];
#pragma unroll
    for (int i = 0; i < 2; ++i) { int R, C; stage_rc(tid * 16 + i * 8192, R, C); const int Rb = Epi::PERM ? ((R & ~31) + perm32(R & 31)) : R;
        voffA[i] = (unsigned)(R * K + C) * 2u; voffB[i] = (unsigned)(Rb * K + C) * 2u; }
    const size_t kstep = (size_t)(BK * 2);
    const size_t hstep = (size_t)HALF * K * 2;
    const size_t tstep = 2 * hstep;
    const unsigned ldsw = (unsigned)wid * 1024u;
    const int aoff = lds_byte(wr * 64 + fr, fq * 8), boff = lds_byte(wc * 32 + fr, fq * 8);
#define PG8_SA(b, h) (((b) * 2 + (h)) * HTB)
#define PG8_SB(b, h) ((4 + (b) * 2 + (h)) * HTB)
#define PG8_STAGE(bufoff, gbase, voff) do { _Pragma("unroll") for (int _i = 0; _i < 2; ++_i) \
        __builtin_amdgcn_global_load_lds((const unsigned*)((const char*)(gbase) + (voff)[_i]), (PG8_LAS unsigned*)(lds + (bufoff) + ldsw + _i * 8192), 16, 0, 0); } while (0)
#define PG8_LDA(dst, b, h) do { _Pragma("unroll") for (int m = 0; m < 4; ++m) _Pragma("unroll") for (int k = 0; k < 2; ++k) dst[m][k] = *(const PG8_LAS bf16x8*)(lds + PG8_SA(b, h) + aoff + m * 2048 + k * 1024); } while (0)
#define PG8_LDB(dst, b, h) do { _Pragma("unroll") for (int n = 0; n < 2; ++n) _Pragma("unroll") for (int k = 0; k < 2; ++k) dst[n][k] = *(const PG8_LAS bf16x8*)(lds + PG8_SB(b, h) + boff + n * 2048 + k * 1024); } while (0)
#define PG8_MMA(ai, bj, At, Bt) do { __builtin_amdgcn_s_setprio(1); _Pragma("unroll") for (int m = 0; m < 4; ++m) _Pragma("unroll") for (int n = 0; n < 2; ++n) _Pragma("unroll") for (int k = 0; k < 2; ++k) \
        acc[ai][bj][m][n] = __builtin_amdgcn_mfma_f32_16x16x32_bf16(Bt[n][k], At[m][k], acc[ai][bj][m][n], 0, 0, 0); __builtin_amdgcn_s_setprio(0); } while (0)
#define PG8_WAIT_V(n) asm volatile("s_waitcnt vmcnt(" #n ")" ::: "memory")
#define PG8_WAIT_L(n) asm volatile("s_waitcnt lgkmcnt(" #n ")" ::: "memory")
#define PG8_BAR __builtin_amdgcn_s_barrier()
#define PG8_SCHED __builtin_amdgcn_sched_barrier(0)
    Unit cur, nxt; int ui = 0;
    if (!S.next(0, cur)) return;
    f32x4 acc[2][2][4][2];
#pragma unroll
    for (int a = 0; a < 2; ++a)
#pragma unroll
        for (int b = 0; b < 2; ++b)
#pragma unroll
            for (int m = 0; m < 4; ++m)
#pragma unroll
                for (int n = 0; n < 2; ++n) acc[a][b][m][n] = (f32x4){0.f, 0.f, 0.f, 0.f};
    bf16x8 At[4][2], B0[2][2], B1[2][2];
    const char* cA = (const char*)g.A + (size_t)cur.pm * tstep; const char* cB = (const char*)g.Bt + (size_t)cur.pn * tstep;
    S.a_ready(cur);
    if constexpr (SP2) {
        PG8_STAGE(PG8_SB(0, 0), cB, voffB); PG8_STAGE(PG8_SB(0, 1), cB + hstep, voffB); PG8_STAGE(PG8_SA(0, 0), cA, voffA); PG8_STAGE(PG8_SA(0, 1), cA + hstep, voffA);
        if (wr == 1) PG8_BAR;
        PG8_WAIT_V(2); PG8_BAR;
        PG8_STAGE(PG8_SB(1, 0), cB + kstep, voffB); PG8_STAGE(PG8_SA(1, 0), cA + kstep, voffA); PG8_STAGE(PG8_SB(1, 1), cB + hstep + kstep, voffB);
        PG8_WAIT_V(6); PG8_BAR;
    } else {
        PG8_STAGE(PG8_SB(0, 0), cB, voffB); PG8_STAGE(PG8_SA(0, 0), cA, voffA); PG8_STAGE(PG8_SB(0, 1), cB + hstep, voffB); PG8_STAGE(PG8_SA(0, 1), cA + hstep, voffA);
        if (wr == 1) PG8_BAR;
        PG8_WAIT_V(4); PG8_BAR;
        PG8_STAGE(PG8_SB(1, 0), cB + kstep, voffB); PG8_STAGE(PG8_SA(1, 0), cA + kstep, voffA); PG8_STAGE(PG8_SB(1, 1), cB + hstep + kstep, voffB);
        PG8_WAIT_V(6); PG8_BAR;
    }
    for (;;) {
        const bool has_next = S.next(ui + 1, nxt);
        const char* nA = has_next ? (const char*)g.A + (size_t)nxt.pm * tstep : cA; const char* nB = has_next ? (const char*)g.Bt + (size_t)nxt.pn * tstep : cB;
        for (int t = 0; t < nt; t += 2) {
            const bool last = (t == nt - 2);
            const char* a1 = cA + (size_t)(t + 1) * kstep;
            const char* a2 = last ? nA : cA + (size_t)(t + 2) * kstep; const char* b2 = last ? nB : cB + (size_t)(t + 2) * kstep;
            const char* a3 = a2 + kstep; const char* b3 = b2 + kstep;
            if (last && has_next) S.a_ready(nxt);
            if constexpr (SP2) {
            PG8_LDB(B0, 0, 0); PG8_LDB(B1, 0, 1); PG8_SCHED; PG8_LDA(At, 0, 0); PG8_STAGE(PG8_SA(1, 1), a1 + hstep, voffA);
            PG8_WAIT_V(8); PG8_WAIT_L(0); PG8_BAR; PG8_MMA(0, 0, At, B0); PG8_MMA(0, 1, At, B1); PG8_BAR; PG8_SCHED;
            PG8_LDA(At, 0, 1); PG8_STAGE(PG8_SB(0, 0), b2, voffB); PG8_STAGE(PG8_SB(0, 1), b2 + hstep, voffB); PG8_STAGE(PG8_SA(0, 0), a2, voffA);
            PG8_WAIT_V(8); PG8_WAIT_L(0); PG8_BAR; PG8_MMA(1, 0, At, B0); PG8_MMA(1, 1, At, B1); PG8_BAR; PG8_SCHED;
            PG8_LDB(B0, 1, 0); PG8_LDB(B1, 1, 1); PG8_SCHED; PG8_LDA(At, 1, 0); PG8_STAGE(PG8_SA(0, 1), a2 + hstep, voffA);
            PG8_WAIT_V(8); PG8_WAIT_L(0); PG8_BAR; PG8_MMA(0, 0, At, B0); PG8_MMA(0, 1, At, B1); PG8_BAR; PG8_SCHED;
            PG8_LDA(At, 1, 1); PG8_STAGE(PG8_SB(1, 0), b3, voffB); PG8_STAGE(PG8_SB(1, 1), b3 + hstep, voffB); PG8_STAGE(PG8_SA(1, 0), a3, voffA);
            PG8_WAIT_V(8); PG8_WAIT_L(0); PG8_BAR; PG8_MMA(1, 0, At, B0); PG8_MMA(1, 1, At, B1); PG8_BAR; PG8_SCHED;
            } else {
            PG8_LDB(B0, 0, 0); PG8_SCHED; PG8_LDA(At, 0, 0); PG8_STAGE(PG8_SA(1, 1), a1 + hstep, voffA);
            PG8_WAIT_L(8); PG8_BAR; PG8_WAIT_L(0); PG8_MMA(0, 0, At, B0); PG8_BAR; PG8_SCHED;
            PG8_LDB(B1, 0, 1); PG8_STAGE(PG8_SB(0, 0), b2, voffB);
            PG8_BAR; PG8_WAIT_L(0); PG8_MMA(0, 1, At, B1); PG8_BAR;
            PG8_LDA(At, 0, 1); PG8_STAGE(PG8_SA(0, 0), a2, voffA);
            PG8_BAR; PG8_WAIT_L(0); PG8_MMA(1, 0, At, B0); PG8_BAR; PG8_SCHED;
            PG8_STAGE(PG8_SB(0, 1), b2 + hstep, voffB);
            PG8_WAIT_V(6); PG8_BAR; PG8_MMA(1, 1, At, B1); PG8_BAR;
            PG8_LDB(B0, 1, 0); PG8_SCHED; PG8_LDA(At, 1, 0); PG8_STAGE(PG8_SA(0, 1), a2 + hstep, voffA);
            PG8_WAIT_L(8); PG8_BAR; PG8_WAIT_L(0); PG8_MMA(0, 0, At, B0); PG8_BAR; PG8_SCHED;
            PG8_LDB(B1, 1, 1); PG8_STAGE(PG8_SB(1, 0), b3, voffB);
            PG8_BAR; PG8_WAIT_L(0); PG8_MMA(0, 1, At, B1); PG8_BAR;
            PG8_LDA(At, 1, 1); PG8_STAGE(PG8_SA(1, 0), a3, voffA);
            PG8_BAR; PG8_WAIT_L(0); PG8_MMA(1, 0, At, B0); PG8_BAR; PG8_SCHED;
            PG8_STAGE(PG8_SB(1, 1), b3 + hstep, voffB);
            PG8_WAIT_V(6); PG8_BAR; PG8_MMA(1, 1, At, B1); PG8_BAR;
            }
        }
        if constexpr (ALIGN_EPI) { if (wr == 0) PG8_BAR; }
        if constexpr (!Epi::AFTER_DRAIN) { E(acc, cur, wr, wc, fr, fq); S.done(cur); }
        if (!has_next) break;
#pragma unroll
        for (int a = 0; a < 2; ++a)
#pragma unroll
            for (int b = 0; b < 2; ++b)
#pragma unroll
                for (int m = 0; m < 4; ++m)
#pragma unroll
                    for (int n = 0; n < 2; ++n) acc[a][b][m][n] = (f32x4){0.f, 0.f, 0.f, 0.f};
        cur = nxt; cA = nA; cB = nB; ++ui;
        if constexpr (ALIGN_EPI) { if (wr == 1) PG8_BAR; }
    }
    PG8_WAIT_V(0);
    if constexpr (!ALIGN_EPI) { if (wr == 0) PG8_BAR; }
    PG8_BAR;
    if constexpr (Epi::AFTER_DRAIN) { E.fused(acc, cur, wr, wc, fr, fq, lds, wid, lane); S.done(cur); }
#undef PG8_SA
#undef PG8_SB
#undef PG8_STAGE
#undef PG8_LDA
#undef PG8_LDB
#undef PG8_MMA
#undef PG8_WAIT_V
#undef PG8_WAIT_L
#undef PG8_BAR
#undef PG8_SCHED
}
}
using pg8::bf16x8; using pg8::f32x4; using pg8::u32x4;
namespace dattn {
constexpr int D = 128, LDQ = NPAD, LDK = NPAD, LDO = 2048;
constexpr float SCALE = 0.08838834764831845f;
constexpr float THR = 8.f;
constexpr int NW = 8, QBLK = 32, KVBLK = 64, QB = NW * QBLK;
constexpr int SHM_V = KVBLK * D * 2, SHM_K = KVBLK * D * 2;
constexpr int LDS_BYTES = 2 * SHM_V + 2 * SHM_K + NW * 64 * 4;

#define KSWZ(row, colB) ((row) * 256 + ((colB) ^ (((row) & 7) << 4)))
#define SBAR() __builtin_amdgcn_sched_barrier(0)
__device__ __forceinline__ int v_st(int k, int c) { const int kk = (k & ~0xC) | ((k & 4) << 1) | ((k & 8) >> 1); return ((kk >> 3) * 4 + (c >> 5)) * 512 + ((kk & 7) * 32 + (c & 31)) * 2; }
__device__ __forceinline__ int v_rd_base(int lane) { return ((lane & 3) << 3) | (((lane >> 2) & 3) << 6) | (((lane >> 4) & 1) << 5) | (((lane >> 5) & 1) << 8); }
constexpr int v_rd_off(int d0, int ks, int half) { return d0 * 512 + ks * 4096 + half * 2048; }
__device__ __forceinline__ int crow(int r, int hi) { return (r & 3) + 8 * (r >> 2) + 4 * hi; }
__device__ __forceinline__ unsigned cvtpk(float lo, float hi) { unsigned r; asm volatile("v_cvt_pk_bf16_f32 %0, %1, %2" : "=v"(r) : "v"(lo), "v"(hi)); return r; }
__device__ __forceinline__ bf16x8 load8(const bf16_t* p) { return *reinterpret_cast<const bf16x8*>(p); }

__device__ __forceinline__ void partialSM(f32x16& p0, f32x16& p1, float& m_reg, float& mn, float& alpha) {
    float pmax = p0[0]; for (int r = 1; r < 16; ++r) pmax = fmaxf(pmax, p0[r]); for (int r = 0; r < 16; ++r) pmax = fmaxf(pmax, p1[r]);
    { auto rr = __builtin_amdgcn_permlane32_swap(__float_as_uint(pmax), __float_as_uint(pmax), false, false);
      pmax = fmaxf(__uint_as_float(rr[0]), __uint_as_float(rr[1])); }
    constexpr float C2 = 1.4426950408889634f * SCALE;
    if (__builtin_expect(__all((pmax - m_reg) * SCALE <= THR), 1)) { mn = m_reg; alpha = 1.f; }
    else { mn = fmaxf(m_reg, pmax); alpha = __builtin_amdgcn_exp2f((m_reg - mn) * C2); m_reg = mn; }
    const float mnL = -mn * C2;
    for (int r = 0; r < 16; ++r) p0[r] = fmaf(p0[r], C2, mnL); for (int r = 0; r < 16; ++r) p1[r] = fmaf(p1[r], C2, mnL);
    for (int r = 0; r < 16; ++r) p0[r] = __builtin_amdgcn_exp2f(p0[r]);
}
__device__ __forceinline__ void finishSM(f32x16& p0, f32x16& p1, float alpha, float& l_reg, bf16x8& pa0, bf16x8& pa1, bf16x8& pa2, bf16x8& pa3) {
    for (int r = 0; r < 16; ++r) p1[r] = __builtin_amdgcn_exp2f(p1[r]);
    float ps = 0; for (int r = 0; r < 16; ++r) ps += p0[r]; for (int r = 0; r < 16; ++r) ps += p1[r];
    { auto rr = __builtin_amdgcn_permlane32_swap(__float_as_uint(ps), __float_as_uint(ps), false, false);
      ps = __uint_as_float(rr[0]) + __uint_as_float(rr[1]); }
    l_reg = l_reg * alpha + ps;
#define PK4(P, B_, OUT) do { unsigned a0 = cvtpk(P[B_+0], P[B_+1]), a1 = cvtpk(P[B_+2], P[B_+3]);                          \
        unsigned b0 = cvtpk(P[B_+4], P[B_+5]), b1 = cvtpk(P[B_+6], P[B_+7]);                                             \
        auto r0 = __builtin_amdgcn_permlane32_swap(a0, b0, false, false); auto r1 = __builtin_amdgcn_permlane32_swap(a1, b1, false, false); \
        u32x4 w = {r0[0], r1[0], r0[1], r1[1]}; OUT = *reinterpret_cast<bf16x8*>(&w); } while (0)
    PK4(p0, 0, pa0); PK4(p0, 8, pa1); PK4(p1, 0, pa2); PK4(p1, 8, pa3);
#undef PK4
}
template <int KB>
__device__ __forceinline__ void qkt(f32x16& p0, f32x16& p1, const char* K_lds, int r32, int hi, const bf16x8* qr) {
    p0 = f32x16{}; p1 = f32x16{};
    const char* kb[4];
#pragma unroll
    for (int dd = 0; dd < 4; ++dd) kb[dd] = K_lds + KB * SHM_K + KSWZ(r32, (dd * 16 + hi * 8) * 2);
#pragma unroll
    for (int d0 = 0; d0 < 8; ++d0) { const char* a = kb[d0 & 3] + (d0 >> 2) * 128;
        bf16x8 b0 = *reinterpret_cast<const bf16x8*>(a);
        bf16x8 b1 = *reinterpret_cast<const bf16x8*>(a + 32 * 256);
        p0 = __builtin_amdgcn_mfma_f32_32x32x16_bf16(b0, qr[d0], p0, 0, 0, 0);
        p1 = __builtin_amdgcn_mfma_f32_32x32x16_bf16(b1, qr[d0], p1, 0, 0, 0); }
}
template <int VB>
__device__ __forceinline__ void pv_tile(f32x16* o, int vb0, bf16x8 pa0, bf16x8 pa1, bf16x8 pa2, bf16x8 pa3) {
#define TRRD(dst, off) asm volatile("ds_read_b64_tr_b16 %0, %1 offset:%2" : "=&v"(dst) : "v"(vb0), "i"(off) : "memory")
#define PV_D0(d0) do { s16x4 l0, l1, l2, l3, h0, h1, h2, h3; constexpr int b_ = VB * SHM_V + v_rd_off(d0, 0, 0);   \
        TRRD(l0, b_); TRRD(h0, b_ + 2048); TRRD(l1, b_ + 4096); TRRD(h1, b_ + 6144); TRRD(l2, b_ + 8192); TRRD(h2, b_ + 10240); TRRD(l3, b_ + 12288); TRRD(h3, b_ + 14336); \
        asm volatile("s_waitcnt lgkmcnt(0)" ::: "memory"); SBAR();                                                   \
        o[d0] = __builtin_amdgcn_mfma_f32_32x32x16_bf16(pa0, (bf16x8){l0[0], l0[1], l0[2], l0[3], h0[0], h0[1], h0[2], h0[3]}, o[d0], 0, 0, 0);   \
        o[d0] = __builtin_amdgcn_mfma_f32_32x32x16_bf16(pa1, (bf16x8){l1[0], l1[1], l1[2], l1[3], h1[0], h1[1], h1[2], h1[3]}, o[d0], 0, 0, 0);   \
        o[d0] = __builtin_amdgcn_mfma_f32_32x32x16_bf16(pa2, (bf16x8){l2[0], l2[1], l2[2], l2[3], h2[0], h2[1], h2[2], h2[3]}, o[d0], 0, 0, 0);   \
        o[d0] = __builtin_amdgcn_mfma_f32_32x32x16_bf16(pa3, (bf16x8){l3[0], l3[1], l3[2], l3[3], h3[0], h3[1], h3[2], h3[3]}, o[d0], 0, 0, 0); } while (0)
    PV_D0(0); PV_D0(1); PV_D0(2); PV_D0(3);
#undef PV_D0
#undef TRRD
}

struct BlockRef { const bf16_t* Q; const bf16_t* K; const bf16_t* V; float* O; int P0; };
struct Seam { bf16x8 qr[8]; bf16x8 st_v0, st_v1, st_k0, st_k1; };
#define ROW(p, k0, rr) ((p) + (size_t)((k0) + (rr)) * LDK + sc)
#define VMW() asm volatile("s_waitcnt vmcnt(0)" ::: "memory")
#define VMWN(n) asm volatile("s_waitcnt vmcnt(%0)" :: "i"(n) : "memory")
#define SLOAD_H(Kp, Vp, k0) do { S.st_v0 = load8(ROW(Vp, k0, sr)); S.st_v1 = load8(ROW(Vp, k0, 32 + sr));              \
                         S.st_k0 = load8(ROW(Kp, k0, sr)); S.st_k1 = load8(ROW(Kp, k0, 32 + sr)); } while (0)
#define SWRITE_HK(bf) do { *(bf16x8*)(K_lds + (bf) * SHM_K + kws) = S.st_k0; *(bf16x8*)(K_lds + (bf) * SHM_K + kws + 32 * 256) = S.st_k1; } while (0)
#define SWRITE_HV(bf) do { *(bf16x8*)(V_lds + (bf) * SHM_V + vst0) = S.st_v0; *(bf16x8*)(V_lds + (bf) * SHM_V + vst1) = S.st_v1; } while (0)
#define SWRITE_H(bf) do { SWRITE_HV(bf); SWRITE_HK(bf); } while (0)
__device__ __forceinline__ void prime(const BlockRef& cur, char* lds, Seam& S, int wave_id) {
    int tid_ = wave_id * 64 + hw_lane(); asm volatile("" : "+v"(tid_));
    const int tid = tid_, wid = __builtin_amdgcn_readfirstlane(tid >> 6), lane = tid & 63, r32 = lane & 31, hi = lane >> 5;
    const int sr = tid >> 4, sc = (tid & 15) * 8, kws = KSWZ(sr, sc * 2); char* K_lds = lds + 2 * SHM_V;
#pragma unroll
    for (int d0 = 0; d0 < 8; ++d0) S.qr[d0] = load8(cur.Q + (size_t)(wid * QBLK + r32) * LDQ + d0 * 16 + hi * 8);
    SLOAD_H(cur.K, cur.V, 0); VMW(); SWRITE_HK(0);
    __syncthreads();
}
__device__ __forceinline__ void block(const BlockRef& cur, const BlockRef& nxt, char* lds, Seam& S, int wave_id) {
    int tid_ = wave_id * 64 + hw_lane(); asm volatile("" : "+v"(tid_));
    const int tid = tid_, wid = __builtin_amdgcn_readfirstlane(tid >> 6), lane = tid & 63, r32 = lane & 31, hi = lane >> 5;
    const int NT = cur.P0 / KVBLK + 4;
    const int qlo = cur.P0 + wid * QBLK;
    const int qend = qlo | 63;
    char* V_lds = lds; char* K_lds = lds + 2 * SHM_V;
    float* ws = (float*)(lds + 2 * SHM_V + 2 * SHM_K) + wid * 64; float* li_l = ws, * al_l = ws + 32;
    float m_reg = -1e30f, l_reg = 0; f32x16 o[4] = {};
    const int sr = tid >> 4, sc = (tid & 15) * 8, vst0 = v_st(sr, sc), vst1 = v_st(32 + sr, sc), kws = KSWZ(sr, sc * 2);
    const int vb0 = (int)(uintptr_t)V_lds + v_rd_base(lane);
    const bf16_t* Kh = cur.K; const bf16_t* Vh = cur.V;
#define RESC(a) do { if (__any((a) < 1.f)) { if (hi == 0) al_l[r32] = (a); asm volatile("s_waitcnt lgkmcnt(0)" ::: "memory");              \
                     for (int d_ = 0; d_ < 4; ++d_) for (int r = 0; r < 16; ++r) o[d_][r] *= al_l[crow(r, hi)]; } } while (0)
#define KBASE(t) ((t) * KVBLK)
#define MASKT(P0_, P1_, t) do { if (KBASE(t) > qend) { const float NEG_ = -__builtin_inff(); _Pragma("unroll") for (int r_ = 0; r_ < 16; ++r_) { P0_[r_] = NEG_; P1_[r_] = NEG_; } } } while (0)
    constexpr int NQL = 8;
#define SEAM_K0() do { VMWN(NQL); SWRITE_HK(0); SBAR(); } while (0)
    f32x16 pA0, pA1, pB0, pB1; float mnA, mnB, alA, alB; bf16x8 pa0, pa1, pa2, pa3;
    SWRITE_HV(0); SBAR();
    if (NT > 1) { SLOAD_H(Kh, Vh, KBASE(1)); }
    SBAR(); qkt<0>(pA0, pA1, K_lds, r32, hi, S.qr);
    MASKT(pA0, pA1, 0); partialSM(pA0, pA1, m_reg, mnA, alA);
    if (NT > 1) { VMW(); SWRITE_H(1); }
    __syncthreads();
#define HALF_STEP(PX0, PX1, mnX, alX, PY0, PY1, alY, t, KB, VB, SB) do {                                                      \
        SBAR(); qkt<KB>(PX0, PX1, K_lds, r32, hi, S.qr);                                                                      \
        finishSM(PY0, PY1, alY, l_reg, pa0, pa1, pa2, pa3); SBAR();                                                           \
        if ((t) + 1 < NT) { SLOAD_H(Kh, Vh, KBASE((t) + 1)); SBAR(); }                                                        \
        pv_tile<VB>(o, vb0, pa0, pa1, pa2, pa3); MASKT(PX0, PX1, (t)); partialSM(PX0, PX1, m_reg, mnX, alX);                  \
        __syncthreads();                                                                                                      \
        if ((t) + 1 < NT) { VMW(); SWRITE_H(SB); }                                                                            \
        RESC(alX); __syncthreads(); } while (0)
    for (int t = 1; t + 1 < NT; t += 2) {
        HALF_STEP(pB0, pB1, mnB, alB, pA0, pA1, alA, t, 1, 0, 0);
        HALF_STEP(pA0, pA1, mnA, alA, pB0, pB1, alB, t + 1, 0, 1, 1);
    }
    SBAR(); qkt<1>(pB0, pB1, K_lds, r32, hi, S.qr); SBAR();
    SLOAD_H(nxt.K, nxt.V, 0); SBAR();
#pragma unroll
    for (int d0 = 0; d0 < 8; ++d0) S.qr[d0] = load8(nxt.Q + (size_t)(wid * QBLK + r32) * LDQ + d0 * 16 + hi * 8);
    SBAR();
    finishSM(pA0, pA1, alA, l_reg, pa0, pa1, pa2, pa3); SBAR();
    pv_tile<0>(o, vb0, pa0, pa1, pa2, pa3);
    MASKT(pB0, pB1, NT - 1); partialSM(pB0, pB1, m_reg, mnB, alB); __syncthreads(); RESC(alB);
    finishSM(pB0, pB1, alB, l_reg, pa0, pa1, pa2, pa3); SBAR(); pv_tile<1>(o, vb0, pa0, pa1, pa2, pa3);
    SBAR(); SEAM_K0();
    if (hi == 0) li_l[r32] = l_reg; asm volatile("s_waitcnt lgkmcnt(0)" ::: "memory");
    float rli[16];
#pragma unroll
    for (int r = 0; r < 16; ++r) rli[r] = __builtin_amdgcn_rcpf(li_l[crow(r, hi)]);
    float* Ow = cur.O + (size_t)(wid * QBLK) * LDO;
#pragma unroll
    for (int r = 0; r < 16; ++r) { const int orow = crow(r, hi);
#pragma unroll
        for (int d0 = 0; d0 < 4; ++d0) Ow[(size_t)orow * LDO + d0 * 32 + r32] = o[d0][r] * rli[r]; }
    __syncthreads();
#undef RESC
#undef KBASE
#undef MASKT
#undef SEAM_K0
#undef HALF_STEP
}
#undef ROW
#undef VMW
#undef VMWN
#undef SLOAD_H
#undef SWRITE_HK
#undef SWRITE_HV
#undef SWRITE_H
#undef KSWZ
#undef SBAR
}
#define XB_TMO      128
#define XB_XCNT(j)  (256  + 64 * (j))
#define XB_XSUB(j)  (1280 + 64 * (j))
#define XB_XGEN(j)  (2304 + 64 * (j))
#define XB_TOP      3328
#define XB_TOPGEN   3392
#define XCD_BAR_WORDS 3456
#define XB_SPIN_CAP (1u << 18)

__device__ __forceinline__ unsigned xb_ld(unsigned* p)              { return __hip_atomic_load(p, __ATOMIC_RELAXED, __HIP_MEMORY_SCOPE_AGENT); }
__device__ __forceinline__ unsigned xb_add(unsigned* p, unsigned v) { return __hip_atomic_fetch_add(p, v, __ATOMIC_RELAXED, __HIP_MEMORY_SCOPE_AGENT); }
__device__ __forceinline__ unsigned xb_xcc_id() { return (unsigned)__builtin_amdgcn_s_getreg((3 << 11) | 20) & 0xFu; }
#define XB_SPIN(cond, bar) do { unsigned _sp = 0; while (cond) { __builtin_amdgcn_s_sleep(1); \
    if ((++_sp & 255u) == 0u) { if (xb_ld(&(bar)[XB_TMO])) break; if (_sp > XB_SPIN_CAP) { atomicAdd(&(bar)[XB_TMO], 1u); break; } } } } while (0)

struct XcdBarrier {
    unsigned* bar; unsigned x;
    volatile LAS unsigned* st;
};

__device__ __forceinline__ XcdBarrier xcd_barrier_post(unsigned* bar, volatile LAS unsigned* st) {
    XcdBarrier b; b.bar = bar; b.x = xb_xcc_id(); b.st = st;
    if (threadIdx.x == 0) (void)xb_add(&bar[XB_XCNT(b.x)], 1u);
    return b;
}
__device__ __forceinline__ void xcd_barrier_complete(unsigned* bar, unsigned x, unsigned& nloc, unsigned& nx) {
    const unsigned G = gridDim.x * gridDim.y * gridDim.z;
    unsigned sum, cnt, mine, sp = 0u;
    for (;;) {
        sum = 0u; cnt = 0u; mine = 0u;
#pragma unroll
        for (unsigned j = 0; j < 16; ++j) { const unsigned c = xb_ld(&bar[XB_XCNT(j)]); sum += c; cnt += (c > 0u) ? 1u : 0u; mine = (j == x) ? c : mine; }
        if (sum == G) break;
        __builtin_amdgcn_s_sleep(1);
        if ((++sp & 255u) == 0u) { if (xb_ld(&bar[XB_TMO])) break; if (sp > XB_SPIN_CAP) { atomicAdd(&bar[XB_TMO], 1u); break; } }
    }
    nloc = mine > 0u ? mine : 1u; nx = cnt > 0u ? cnt : 1u;
}

__device__ __forceinline__ void xcd_barrier(const XcdBarrier& b) {
    asm volatile("s_waitcnt vmcnt(0)" ::: "memory");
    __syncthreads();
    if (threadIdx.x == 0) {
        unsigned* bar = b.bar;
        __builtin_amdgcn_s_waitcnt(0);
        unsigned nloc = b.st[0], nx = b.st[1];
        if (nloc == 0u) { xcd_barrier_complete(bar, b.x, nloc, nx); b.st[0] = nloc; b.st[1] = nx; }
        const unsigned old = xb_add(&bar[XB_XSUB(b.x)], 1u);
        const unsigned gen = old / nloc;
        if (old + 1u == (gen + 1u) * nloc) {
            __builtin_amdgcn_fence(__ATOMIC_RELEASE, "agent");
            asm volatile("s_waitcnt vmcnt(0)" ::: "memory");
            const unsigned og = xb_add(&bar[XB_TOP], 1u);
            const unsigned tg = og / nx;
            if (og + 1u == (tg + 1u) * nx) xb_add(&bar[XB_TOPGEN], 1u);
            else XB_SPIN(xb_ld(&bar[XB_TOPGEN]) == tg, bar);
            __builtin_amdgcn_fence(__ATOMIC_ACQUIRE, "agent");
            xb_add(&bar[XB_XGEN(b.x)], 1u);
            asm volatile("s_waitcnt vmcnt(0)" ::: "memory");
        } else {
            XB_SPIN(xb_ld(&bar[XB_XGEN(b.x)]) == gen, bar);
            __builtin_amdgcn_fence(__ATOMIC_ACQUIRE, "agent");
            asm volatile("s_waitcnt vmcnt(0)" ::: "memory");
        }
    }
    __syncthreads();
}
constexpr size_t MiB = 1u << 20;
constexpr size_t WS_CTL = 0, CTL_ZERO_BYTES = 1 * MiB;
constexpr size_t WS_WTIN = 2 * MiB;
constexpr size_t WS_WTOUT = WS_WTIN + (size_t)DEPTH * NPAD * DM * 2;
constexpr size_t WS_WUVT = WS_WTOUT + (size_t)DEPTH * DM * DM * 2;
constexpr size_t WS_XB = WS_WUVT + 2 * MiB;
constexpr size_t WS_XF = WS_XB + (size_t)SEQ * DM * 2;
constexpr size_t WS_H = WS_XF + (size_t)SEQ * DM * 4;
constexpr size_t WS_O = WS_H + (size_t)SEQ * NPAD * 2;
constexpr size_t WS_CN = WS_O + (size_t)SEQ * DM * 2;
constexpr size_t WS_IKN = WS_CN + (size_t)SEQ * 256 * 2;
constexpr size_t WS_KDT = WS_IKN + (size_t)SEQ * 64 * 2;
constexpr size_t WS_DEC = WS_KDT + (size_t)NCHUNK * 1024 * 64 * 2;
constexpr size_t WS_VT = WS_DEC + (size_t)NCHUNK * 1024 * 4;
constexpr size_t WS_OA = WS_VT + (size_t)NCHUNK * 2048 * 64 * 2;
constexpr size_t WS_OD = WS_OA + (size_t)SEQ * 2048 * 4;
constexpr size_t WS_END = WS_OD + (size_t)SEQ * 2048 * 4;
constexpr int CW_TMO = 0;
constexpr int CW_BAR = 4096, BAR_STRIDE = 4096;
constexpr int CW_Q = 200000;
static_assert((CW_Q + 64 * 16 + 64) * 4 <= (int)CTL_ZERO_BYTES && CW_BAR + 32 * BAR_STRIDE <= CW_Q, "CTL map");
constexpr int NWAVES = 8;
constexpr int WREG = 18432;
constexpr int MISC_OFF = NWAVES * WREG;
constexpr int LDS_BYTES = MISC_OFF + 512;
static_assert(pg8::STAGE_BYTES <= MISC_OFF && dattn::LDS_BYTES <= MISC_OFF, "LDS map");

#define LDS_WAIT() asm volatile("s_waitcnt lgkmcnt(0)" ::: "memory")
#define VM_WAIT() asm volatile("s_waitcnt vmcnt(0)" ::: "memory")
typedef __bf16 bf16x2v __attribute__((ext_vector_type(2)));
typedef float f32x2 __attribute__((ext_vector_type(2)));
__device__ __forceinline__ unsigned cvtpk_c(float lo, float hi) { f32x2 v = {lo, hi}; bf16x2v b = __builtin_convertvector(v, bf16x2v); return __builtin_bit_cast(unsigned, b); }
__device__ __forceinline__ float bf2f(unsigned b) { return __uint_as_float(b << 16); }
__device__ __forceinline__ float bflo(unsigned w) { return __uint_as_float(w << 16); }
__device__ __forceinline__ float bfhi(unsigned w) { return __uint_as_float(w & 0xffff0000u); }
__device__ __forceinline__ bf16x8 pack8f(float a0, float a1, float a2, float a3, float a4, float a5, float a6, float a7) {
    u32x4 w = {cvtpk_c(a0, a1), cvtpk_c(a2, a3), cvtpk_c(a4, a5), cvtpk_c(a6, a7)}; return __builtin_bit_cast(bf16x8, w); }
__device__ __forceinline__ float bperm_f(int src_lane, float v) { return __int_as_float(__builtin_amdgcn_ds_bpermute(src_lane << 2, __float_as_int(v))); }
__device__ __forceinline__ float wave_sum(float v) {
    const int ln = hw_lane();
#pragma unroll
    for (int o = 1; o < 64; o <<= 1) v += bperm_f(ln ^ o, v);
    return v;
}
__device__ __forceinline__ float silu(float x) { return x / (1.f + __expf(-x)); }
#define MFMA16(a, b, c) __builtin_amdgcn_mfma_f32_16x16x32_bf16((a), (b), (c), 0, 0, 0)
#define MFMA32(a, b, c) __builtin_amdgcn_mfma_f32_32x32x16_bf16((a), (b), (c), 0, 0, 0)

struct Frame {
    LAS unsigned char* lds;
    volatile LAS unsigned* MISC;
    gu32* ctl;
    unsigned char* ws;
    int wave, vcu, G;
};
#define B_WTIN(F)  ((bf16_t*)((F).ws + WS_WTIN))
#define B_WTOUT(F) ((bf16_t*)((F).ws + WS_WTOUT))
#define B_WUVT(F)  ((bf16_t*)((F).ws + WS_WUVT))
#define B_XB(F)    ((bf16_t*)((F).ws + WS_XB))
#define B_XF(F)    ((float*)((F).ws + WS_XF))
#define B_H(F)     ((bf16_t*)((F).ws + WS_H))
#define B_O(F)     ((bf16_t*)((F).ws + WS_O))
#define B_CN(F)    ((bf16_t*)((F).ws + WS_CN))
#define B_IKN(F)   ((bf16_t*)((F).ws + WS_IKN))
#define B_KDT(F)   ((bf16_t*)((F).ws + WS_KDT))
#define B_DEC(F)   ((float*)((F).ws + WS_DEC))
#define B_VT(F)    ((bf16_t*)((F).ws + WS_VT))
#define B_OA(F)    ((float*)((F).ws + WS_OA))
#define B_OD(F)    ((float*)((F).ws + WS_OD))
__device__ __forceinline__ int grab(Frame& F, int qidx) {
    if ((F.wave * 64 + hw_lane()) == 0) F.MISC[2] = __hip_atomic_fetch_add((unsigned*)(F.ctl + CW_Q + 64 * qidx), 1u, __ATOMIC_RELAXED, __HIP_MEMORY_SCOPE_AGENT);
    __syncthreads(); const int v = (int)F.MISC[2]; __syncthreads(); return v;
}
template <bool REMAP>
__device__ __forceinline__ void tr_item(const float* W, int K, int ldw, bf16_t* WT, int nblk, LAS float* scr, int item, int lane) {
    const int kb = item / nblk, nb = item - kb * nblk, k0 = 64 * kb, n0 = 32 * nb;
    const int sc = REMAP ? srccol(n0 + (lane & 31)) : n0 + (lane & 31);
#pragma unroll 8
    for (int i = 0; i < 32; ++i) { const int kk = 2 * i + (lane >> 5); scr[kk * 33 + (lane & 31)] = sc >= 0 ? W[(size_t)(k0 + kk) * ldw + sc] : 0.f; }
    LDS_WAIT();
    const int c = lane & 7;
#pragma unroll
    for (int j = 0; j < 4; ++j) { const int nn = (lane >> 3) + 8 * j; const LAS float* s = scr + (8 * c) * 33 + nn;
        u32x4 o; o.x = cvtpk_c(s[0 * 33], s[1 * 33]); o.y = cvtpk_c(s[2 * 33], s[3 * 33]); o.z = cvtpk_c(s[4 * 33], s[5 * 33]); o.w = cvtpk_c(s[6 * 33], s[7 * 33]);
        *(u32x4*)(WT + (size_t)(n0 + nn) * K + k0 + 8 * c) = o; }
    LDS_WAIT();
}
__device__ __forceinline__ void p0_prologue(Frame& F, const float* x_in, const float* w_in, const float* w_out, const float* w_uv) {
    LAS float* scr = (LAS float*)(F.lds + F.wave * 16384);
    const int gw = F.vcu * NWAVES + F.wave, NGW = F.G * NWAVES;
    constexpr int I_IN = (DM / 64) * (NPAD / 32), I_OUT = (DM / 64) * (DM / 32), I_UV = (256 / 64) * (128 / 32);
    constexpr int N_IN = DEPTH * I_IN, N_OUT = DEPTH * I_OUT, N_UV = DEPTH * 8 * I_UV;
    for (int it = gw; it < N_IN + N_OUT + N_UV; it += NGW) {
        int r = it;
        if (r < N_IN) { const int l = r / I_IN; r -= l * I_IN;
            tr_item<true>(w_in + (size_t)l * DM * NIN, DM, NIN, B_WTIN(F) + (size_t)l * NPAD * DM, NPAD / 32, scr, r, hw_lane()); continue; }
        r -= N_IN;
        if (r < N_OUT) { const int l = r / I_OUT; r -= l * I_OUT;
            tr_item<false>(w_out + (size_t)l * DM * DM, DM, DM, B_WTOUT(F) + (size_t)l * DM * DM, DM / 32, scr, r, hw_lane()); continue; }
        r -= N_OUT;
        { const int lh = r / I_UV; r -= lh * I_UV;
          tr_item<false>(w_uv + (size_t)lh * 256 * 128, 256, 128, B_WUVT(F) + (size_t)lh * 128 * 256, 128 / 32, scr, r, hw_lane()); }
    }
    const f32x4* xs = (const f32x4*)x_in;
    for (size_t i = (size_t)gw * 64 + hw_lane(); i < (size_t)SEQ * DM / 8; i += (size_t)NGW * 64) {
        const f32x4 a = xs[2 * i], b = xs[2 * i + 1];
        u32x4 o = {cvtpk_c(a[0], a[1]), cvtpk_c(a[2], a[3]), cvtpk_c(b[0], b[1]), cvtpk_c(b[2], b[3])};
        *(u32x4*)(B_XB(F) + 8 * i) = o;
    }
}

__device__ __forceinline__ void prep_phase(Frame& F, int l, const float* w_gate2, const float* b_gate, const float* kv_g, const float* ik_g, const float* ik_b) {
    int lane_ = hw_lane(); asm volatile("" : "+v"(lane_));
    const int gw = F.vcu * NWAVES + F.wave, NGW = F.G * NWAVES, lane = lane_;
    const bf16_t* H = B_H(F);
    {
        const float* kvg = kv_g + l * 256; const float* ikg = ik_g + l * 64; const float* ikb = ik_b + l * 64;
        const f32x4 g4 = *(const f32x4*)(kvg + 4 * lane); const float g1 = ikg[lane], b1 = ikb[lane];
        for (int t = gw; t < SEQ; t += NGW) {
            const bf16_t* hr = H + (size_t)t * NPAD;
            const u32x2 raw = *(const u32x2*)(hr + C_CKV + 4 * lane);
            const float v0 = bflo(raw.x), v1 = bfhi(raw.x), v2 = bflo(raw.y), v3 = bfhi(raw.y);
            const float ss = wave_sum((v0 * v0 + v1 * v1) + (v2 * v2 + v3 * v3));
            const float rs = rsqrtf(ss * (1.f / 256.f) + 1e-6f);
            u32x2 o; o.x = cvtpk_c(v0 * rs * g4[0], v1 * rs * g4[1]); o.y = cvtpk_c(v2 * rs * g4[2], v3 * rs * g4[3]);
            *(u32x2*)(B_CN(F) + (size_t)t * 256 + 4 * lane) = o;
            const float x = bf2f(hr[C_CIK + lane]);
            const float mu = wave_sum(x) * (1.f / 64.f); const float d = x - mu;
            const float var = wave_sum(d * d) * (1.f / 64.f);
            const float y = d * rsqrtf(var + 1e-5f) * g1 + b1;
            B_IKN(F)[(size_t)t * 64 + lane] = (bf16_t)(cvtpk_c(y, 0.f) & 0xffffu);
        }
    }
    {
        LAS float* aas = (LAS float*)(F.lds + F.wave * 16384);
        const float* W2 = w_gate2 + (size_t)l * 16 * 1024; const float* BG = b_gate + (size_t)l * 1024;
        for (int u = gw; u < NCHUNK * 16; u += NGW) {
            const int c = u >> 4, dk = (u & 15) * 64 + lane;
            { const bf16_t* ap = H + (size_t)(64 * c + lane) * NPAD + C_AA;
              const bf16x8 a0 = *(const bf16x8*)ap, a1 = *(const bf16x8*)(ap + 8);
#pragma unroll
              for (int j = 0; j < 8; ++j) { aas[lane * 16 + j] = bf2f((unsigned short)a0[j]); aas[lane * 16 + 8 + j] = bf2f((unsigned short)a1[j]); } }
            float w2[16];
#pragma unroll
            for (int r = 0; r < 16; ++r) w2[r] = W2[r * 1024 + dk];
            const float bgv = BG[dk];
            LDS_WAIT();
            float total = 0.f;
            for (int t = 0; t < 64; ++t) {
                float z = bgv;
#pragma unroll
                for (int r = 0; r < 16; ++r) z += aas[t * 16 + r] * w2[r];
                total += (fminf(z, 0.f) - log1pf(expf(-fabsf(z)))) * (1.f / 16.f);
            }
            B_DEC(F)[(size_t)c * 1024 + dk] = expf(total);
            float run = 0.f;
            for (int t8 = 0; t8 < 8; ++t8) {
                float kd[8];
#pragma unroll
                for (int j = 0; j < 8; ++j) { const int t = 8 * t8 + j;
                    float z = bgv;
#pragma unroll
                    for (int r = 0; r < 16; ++r) z += aas[t * 16 + r] * w2[r];
                    run += (fminf(z, 0.f) - log1pf(expf(-fabsf(z)))) * (1.f / 16.f);
                    kd[j] = bf2f(H[(size_t)(64 * c + t) * NPAD + C_AK + dk]) * expf(total - run); }
                *(bf16x8*)(B_KDT(F) + ((size_t)c * 1024 + dk) * 64 + 8 * t8) = pack8f(kd[0], kd[1], kd[2], kd[3], kd[4], kd[5], kd[6], kd[7]);
            }
            LDS_WAIT();
        }
    }
    for (int u = gw; u < NCHUNK * 32; u += NGW) {
        const int c = u >> 5, dv = (u & 31) * 64 + lane;
#pragma unroll
        for (int t8 = 0; t8 < 8; ++t8) {
            unsigned short v[8];
#pragma unroll
            for (int j = 0; j < 8; ++j) v[j] = H[(size_t)(64 * c + 8 * t8 + j) * NPAD + C_AV + dv];
            u32x4 o = {(unsigned)v[0] | ((unsigned)v[1] << 16), (unsigned)v[2] | ((unsigned)v[3] << 16), (unsigned)v[4] | ((unsigned)v[5] << 16), (unsigned)v[6] | ((unsigned)v[7] << 16)};
            *(u32x4*)(B_VT(F) + ((size_t)c * 2048 + dv) * 64 + 8 * t8) = o;
        }
    }
}

__device__ __forceinline__ void post_phase(Frame& F, int l, float lam_init, const float* gla_g, const float* dlam, const float* diff_g) {
    int lane_ = hw_lane(); asm volatile("" : "+v"(lane_));
    const int gw = F.vcu * NWAVES + F.wave, NGW = F.G * NWAVES, lane = lane_;
    float lam;
    { const float* lp = dlam + (size_t)l * 512;
      const float p0 = lp[lane] * lp[128 + lane] + lp[64 + lane] * lp[192 + lane];
      const float p1 = lp[256 + lane] * lp[384 + lane] + lp[320 + lane] * lp[448 + lane];
      lam = expf(wave_sum(p0)) - expf(wave_sum(p1)) + lam_init; }
    { const float* g = gla_g + (size_t)l * 512;
      const f32x4 ga = *(const f32x4*)(g + 8 * lane), gb = *(const f32x4*)(g + 8 * lane + 4);
      for (int u = gw; u < SEQ * 4; u += NGW) {
          const int t = u >> 2, hd = u & 3;
          const float* src = B_OA(F) + (size_t)t * 2048 + hd * 512 + 8 * lane;
          const f32x4 a = *(const f32x4*)src, b = *(const f32x4*)(src + 4);
          const float ss = wave_sum((a[0] * a[0] + a[1] * a[1]) + (a[2] * a[2] + a[3] * a[3]) + (b[0] * b[0] + b[1] * b[1]) + (b[2] * b[2] + b[3] * b[3]));
          const float rs = rsqrtf(ss * (1.f / 512.f) + 1e-6f);
          const u32x4 gr = *(const u32x4*)(B_H(F) + (size_t)t * NPAD + C_AG + hd * 512 + 8 * lane);
          u32x4 o;
          o.x = cvtpk_c(a[0] * rs * ga[0] * silu(bflo(gr.x)), a[1] * rs * ga[1] * silu(bfhi(gr.x)));
          o.y = cvtpk_c(a[2] * rs * ga[2] * silu(bflo(gr.y)), a[3] * rs * ga[3] * silu(bfhi(gr.y)));
          o.z = cvtpk_c(b[0] * rs * gb[0] * silu(bflo(gr.z)), b[1] * rs * gb[1] * silu(bfhi(gr.z)));
          o.w = cvtpk_c(b[2] * rs * gb[2] * silu(bflo(gr.w)), b[3] * rs * gb[3] * silu(bfhi(gr.w)));
          *(u32x4*)(B_O(F) + (size_t)t * DM + hd * 512 + 8 * lane) = o;
      } }
    { const float* g = diff_g + (size_t)l * 256;
      const f32x4 g4 = *(const f32x4*)(g + 4 * lane); const float post = 1.f - lam_init;
      for (int u = gw; u < SEQ * 4; u += NGW) {
          const int t = u >> 2, hd = u & 3;
          const float* src = B_OD(F) + (size_t)t * 2048 + hd * 512 + 4 * lane;
          const f32x4 a0 = *(const f32x4*)src, a1 = *(const f32x4*)(src + 256);
          const f32x4 d = a0 - a1 * lam;
          const float ss = wave_sum((d[0] * d[0] + d[1] * d[1]) + (d[2] * d[2] + d[3] * d[3]));
          const float rs = rsqrtf(ss * (1.f / 256.f) + 1e-6f) * post;
          const u32x2 gr = *(const u32x2*)(B_H(F) + (size_t)t * NPAD + C_BG + hd * 256 + 4 * lane);
          u32x2 o;
          o.x = cvtpk_c(d[0] * rs * g4[0] * silu(bflo(gr.x)), d[1] * rs * g4[1] * silu(bfhi(gr.x)));
          o.y = cvtpk_c(d[2] * rs * g4[2] * silu(bflo(gr.y)), d[3] * rs * g4[3] * silu(bfhi(gr.y)));
          *(u32x2*)(B_O(F) + (size_t)t * DM + 2048 + hd * 256 + 4 * lane) = o;
      } }
}

__device__ __forceinline__ void ln_phase(Frame& F, int l, const float* ln_g, const float* ln_b, float* outp, bool dry) {
    int lane_ = hw_lane(); asm volatile("" : "+v"(lane_));
    const int gw = F.vcu * NWAVES + F.wave, NGW = F.G * NWAVES, lane = lane_;
    const float* g = ln_g + (size_t)l * DM; const float* b = ln_b + (size_t)l * DM;
    float* dst = dry ? B_OA(F) : ((l == DEPTH - 1) ? outp : B_XF(F));
    for (int t = gw; t < SEQ; t += NGW) {
        const f32x4* xr = (const f32x4*)(B_XF(F) + (size_t)t * DM) + lane;
        f32x4 v[16]; float s = 0.f;
#pragma unroll
        for (int j = 0; j < 16; ++j) { v[j] = xr[64 * j]; s += (v[j][0] + v[j][1]) + (v[j][2] + v[j][3]); }
        const float mean = wave_sum(s) * (1.f / DM); float s2 = 0.f;
#pragma unroll
        for (int j = 0; j < 16; ++j) { v[j] = v[j] - mean; s2 += (v[j][0] * v[j][0] + v[j][1] * v[j][1]) + (v[j][2] * v[j][2] + v[j][3] * v[j][3]); }
        const float rstd = rsqrtf(wave_sum(s2) * (1.f / DM) + 1e-5f);
        f32x4* orow = (f32x4*)(dst + (size_t)t * DM) + lane;
        u32x2* brow = (u32x2*)(B_XB(F) + (size_t)t * DM) + lane;
#pragma unroll
        for (int j = 0; j < 16; ++j) {
            const f32x4 gg = *((const f32x4*)g + lane + 64 * j), bb = *((const f32x4*)b + lane + 64 * j);
            const f32x4 y = v[j] * rstd * gg + bb;
            orow[64 * j] = y;
            u32x2 w; w.x = cvtpk_c(y[0], y[1]); w.y = cvtpk_c(y[2], y[3]); brow[64 * j] = w;
        }
    }
}
namespace gla {
constexpr int KD_ROW = 144, Q_ROW = 528, V_ROW = 144;
constexpr int L_KD = 0, L_Q = L_KD + 256 * KD_ROW, L_V = L_Q + 64 * Q_ROW, L_DEC = L_V + 128 * V_ROW, L_END = L_DEC + 1024;
}
static_assert(gla::L_END <= MISC_OFF, "GLA LDS map");
__device__ __forceinline__ void gla_unit(Frame& F, int unit) {
    using namespace gla;
    int tid_ = (F.wave * 64 + hw_lane()); asm volatile("" : "+v"(tid_));
    const int tid = tid_, lane = tid & 63, c16 = lane & 15, g = lane >> 4, wave = F.wave;
    const int head = unit >> 2, blk = unit & 3;
    const int dv0 = 128 * blk + 16 * wave;
    LAS unsigned char* lds = F.lds;
    f32x4 S[16];
#pragma unroll
    for (int T = 0; T < 16; ++T) S[T] = (f32x4){0.f, 0.f, 0.f, 0.f};
    const bf16_t* kd_g = B_KDT(F) + (size_t)head * 256 * 64 + (size_t)tid * 8;
    const bf16_t* q_g = B_H(F) + (size_t)(tid >> 5) * NPAD + C_AQ + head * 256 + (tid & 31) * 8;
    const bf16_t* v_g = B_VT(F) + ((size_t)head * 512 + 128 * blk) * 64 + (size_t)tid * 8;
    const float* d_g = B_DEC(F) + head * 256 + (tid & 63) * 4;
    const int kd_w = (tid >> 3) * KD_ROW + (tid & 7) * 16;
    const int q_w = (tid >> 5) * Q_ROW + (tid & 31) * 16;
    const int v_w = (tid >> 3) * V_ROW + (tid & 7) * 16;
    u32x4 skd[4], sq[4], sv[2]; f32x4 sd;
#define GLA_LOAD(c_) do { _Pragma("unroll") for (int i = 0; i < 4; ++i) skd[i] = *(const u32x4*)(kd_g + (size_t)(c_) * 1024 * 64 + i * 4096); \
        _Pragma("unroll") for (int i = 0; i < 4; ++i) sq[i] = *(const u32x4*)(q_g + (size_t)(64 * (c_) + 16 * i) * NPAD);                        \
        _Pragma("unroll") for (int i = 0; i < 2; ++i) sv[i] = *(const u32x4*)(v_g + (size_t)(c_) * 2048 * 64 + i * 4096);                        \
        if (tid < 64) sd = *(const f32x4*)(d_g + (size_t)(c_) * 1024); } while (0)
#define GLA_WRITE() do { _Pragma("unroll") for (int i = 0; i < 4; ++i) *(LAS u32x4*)(lds + L_KD + kd_w + i * 64 * KD_ROW) = skd[i];            \
        _Pragma("unroll") for (int i = 0; i < 4; ++i) *(LAS u32x4*)(lds + L_Q + q_w + i * 16 * Q_ROW) = sq[i];                                   \
        _Pragma("unroll") for (int i = 0; i < 2; ++i) *(LAS u32x4*)(lds + L_V + v_w + i * 64 * V_ROW) = sv[i];                                   \
        if (tid < 64) *(LAS f32x4*)(lds + L_DEC + tid * 16) = sd; } while (0)
    const int a_rd = L_KD + c16 * KD_ROW + 16 * g;
    const int b_rd = L_V + (16 * wave + c16) * V_ROW + 16 * g;
    const int q_rd = L_Q + c16 * Q_ROW + 8 * g;
    const int d_rd = L_DEC + 16 * g;
    float* o_l = B_OA(F) + (size_t)(4 * g) * 2048 + head * 512 + dv0 + c16;
    GLA_LOAD(0);
    __syncthreads();
    GLA_WRITE();
    for (int c = 0; c < NCHUNK; ++c) {
        __syncthreads();
        if (c + 1 < NCHUNK) GLA_LOAD(c + 1);
        const bf16x8 vb0 = *(const LAS bf16x8*)(lds + b_rd), vb1 = *(const LAS bf16x8*)(lds + b_rd + 64);
#pragma unroll
        for (int T4 = 0; T4 < 4; ++T4) {
            bf16x8 a[4][2]; f32x4 d4[4];
#pragma unroll
            for (int i = 0; i < 4; ++i) { const int T = 4 * T4 + i;
                a[i][0] = *(const LAS bf16x8*)(lds + a_rd + T * 16 * KD_ROW); a[i][1] = *(const LAS bf16x8*)(lds + a_rd + T * 16 * KD_ROW + 64);
                d4[i] = *(const LAS f32x4*)(lds + d_rd + 64 * T); }
#pragma unroll
            for (int i = 0; i < 4; ++i) { const int T = 4 * T4 + i;
                f32x4 acc = (f32x4){0.f, 0.f, 0.f, 0.f};
                acc = MFMA16(a[i][0], vb0, acc); acc = MFMA16(a[i][1], vb1, acc);
                S[T] = S[T] * d4[i] + acc; }
        }
        bf16x8 sb[8];
#pragma unroll
        for (int s = 0; s < 8; ++s) sb[s] = pack8f(S[2 * s][0], S[2 * s][1], S[2 * s][2], S[2 * s][3], S[2 * s + 1][0], S[2 * s + 1][1], S[2 * s + 1][2], S[2 * s + 1][3]);
#pragma unroll
        for (int tt = 0; tt < 4; ++tt) {
            u32x2 ql[8], qh[8];
#pragma unroll
            for (int s = 0; s < 8; ++s) { ql[s] = *(const LAS u32x2*)(lds + q_rd + tt * 16 * Q_ROW + 64 * s); qh[s] = *(const LAS u32x2*)(lds + q_rd + tt * 16 * Q_ROW + 64 * s + 32); }
            f32x4 acc = (f32x4){0.f, 0.f, 0.f, 0.f};
#pragma unroll
            for (int s = 0; s < 8; ++s) { const u32x4 aw = {ql[s].x, ql[s].y, qh[s].x, qh[s].y}; acc = MFMA16(__builtin_bit_cast(bf16x8, aw), sb[s], acc); }
            float* op = o_l + (size_t)(64 * c + 16 * tt) * 2048;
#pragma unroll
            for (int r = 0; r < 4; ++r) op[(size_t)r * 2048] = acc[r] * 0.0625f;
        }
        __syncthreads();
        if (c + 1 < NCHUNK) GLA_WRITE();
    }
#undef GLA_LOAD
#undef GLA_WRITE
}
__device__ __forceinline__ unsigned f2key(float s) { const unsigned b = __float_as_uint(s); return b ^ ((b >> 31) ? 0xFFFFFFFFu : 0x80000000u); }
__device__ __forceinline__ unsigned half_of(unsigned long long b, int hh) { return hh ? (unsigned)(b >> 32) : (unsigned)b; }
template <bool EXACT, int NB>
__device__ __forceinline__ void compact256(LAS unsigned* cv, LAS unsigned* ci, int& cnt, unsigned& thr, int lane32, int hh) {
    unsigned k[16], id[16];
#pragma unroll
    for (int i = 0; i < 16; ++i) { const int e = lane32 + 32 * i; const unsigned v = cv[e]; id[i] = ci[e]; k[i] = (e < cnt) ? v : 0u; }
    unsigned T = 0u;
    for (int b = 31; b >= 32 - NB; --b) {
        const unsigned cand = T | (1u << b); int clo = 0, chi = 0;
#pragma unroll
        for (int i = 0; i < 16; ++i) { const unsigned long long m = __ballot(k[i] >= cand); clo += __popc((unsigned)m); chi += __popc((unsigned)(m >> 32)); }
        if ((hh ? chi : clo) >= 256) T = cand;
    }
    int rties = 0;
    if (EXACT) { int glo = 0, ghi = 0;
#pragma unroll
        for (int i = 0; i < 16; ++i) { const unsigned long long m = __ballot(k[i] > T); glo += __popc((unsigned)m); ghi += __popc((unsigned)(m >> 32)); }
        rties = 256 - (hh ? ghi : glo); }
    const unsigned ltm = (1u << lane32) - 1u;
    int kept = 0, tieseen = 0;
#pragma unroll
    for (int i = 0; i < 16; ++i) {
        bool keep;
        if (EXACT) { const bool gt = k[i] > T, eq = (k[i] == T) && (T != 0u);
            const unsigned meq = half_of(__ballot(eq), hh);
            const int trank = tieseen + __popc(meq & ltm);
            keep = gt || (eq && trank < rties); tieseen += __popc(meq); }
        else keep = (k[i] >= T) && (k[i] != 0u);
        const unsigned mk = half_of(__ballot(keep), hh);
        const int pos = kept + __popc(mk & ltm);
        if (keep) { cv[pos] = k[i]; ci[pos] = id[i]; }
        kept += __popc(mk);
    }
    cnt = kept; thr = EXACT ? T : (T ? T - 1u : 0u);
}
__device__ __forceinline__ int goff(int row, int ch) { return 512 * row + 16 * ((ch & 16) | ((ch & 15) ^ (((row & 3) << 2) | ((row >> 2) & 3)))); }

#ifndef SP_REPF
#define SP_REPF 1
#endif
#ifndef SP_REPB
#define SP_REPB 1
#endif
#ifndef SP_REPK
#define SP_REPK 1
#endif
#ifndef SP_REPX
#define SP_REPX 1
#endif
constexpr int SP_CAND = 0, SP_OL = 65536, SP_SEL = 131072, SP_END = SP_SEL + 8192;
static_assert(SP_END <= MISC_OFF, "sparse LDS map");
__device__ __forceinline__ void sparse_unit(Frame& F, int l, int unit) {
    int tid_ = (F.wave * 64 + hw_lane()); asm volatile("" : "+v"(tid_));
    const int tid = tid_, lane = tid & 63, wave = F.wave, r32 = lane & 31, hh = lane >> 5, c16 = lane & 15, g = lane >> 4;
    const int t0 = 16 * unit, tq0 = t0 + 2 * wave;
    const int N = 64 * ((t0 >> 6) + 1), nkb = N >> 5, ntile = (nkb + 7) >> 3;
    LAS unsigned char* reg = F.lds + SP_CAND + wave * 8192;
    LAS unsigned* cv = (LAS unsigned*)(reg + hh * 2048);
    LAS unsigned* ci = (LAS unsigned*)(reg + 4096 + hh * 2048);
    LAS unsigned short* sel = (LAS unsigned short*)(F.lds + SP_SEL + wave * 1024);
    const bf16_t* H = B_H(F);
    int cnt = 0;
    {
        const int qq = (r32 >> 2) & 1, hd = (r32 & 3) + 4 * (r32 >> 3);
        bf16x8 A[4];
#pragma unroll
        for (int s = 0; s < 4; ++s) A[s] = *(const bf16x8*)(H + (size_t)(tq0 + qq) * NPAD + C_CIQ + hd * 64 + 16 * s + 8 * hh);
        float wv[16];
        { const bf16_t* wp = H + (size_t)(tq0 + hh) * NPAD + C_CIW;
          const bf16x8 w0 = *(const bf16x8*)wp, w1 = *(const bf16x8*)(wp + 8);
#pragma unroll
          for (int j = 0; j < 8; ++j) { wv[j] = bf2f((unsigned short)w0[j]) * 0.03125f; wv[8 + j] = bf2f((unsigned short)w1[j]) * 0.03125f; } }
        unsigned thr = 0u;
        const unsigned ltm = (1u << r32) - 1u;
        const bf16_t* kg = B_IKN(F) + (size_t)tid * 8;
        const int kw = SP_OL + (tid >> 3) * 128 + (((tid & 7) ^ ((tid >> 4) & 7)) * 16);
        int brd[4];
#pragma unroll
        for (int s = 0; s < 4; ++s) brd[s] = SP_OL + r32 * 128 + (((2 * s + hh) ^ ((r32 >> 1) & 7)) * 16);
        u32x4 stgA[4], stgB[4];
#define SP_KLOAD(st_, t_) do { _Pragma("unroll") for (int i = 0; i < 4; ++i) st_[i] = *(const u32x4*)(kg + (size_t)(t_) * 256 * 64 + i * 4096); } while (0)
#define SP_KWRITE(st_, b_) do { _Pragma("unroll") for (int i = 0; i < 4; ++i) *(LAS u32x4*)(F.lds + (b_) * 32768 + kw + i * 8192) = st_[i]; } while (0)
#define SP_TILE(tile_, b_) do {                                                                                                                  \
            { const bool full_ = __any(cnt > 384); if (lane == 0) F.MISC[16 + (b_) * 8 + wave] = full_ ? 1u : 0u; }                              \
            for (int rb_ = 0; rb_ < SP_REPB; ++rb_) __syncthreads();                                                                             \
            bool squeeze_ = __any(F.MISC[16 + (b_) * 8 + (lane & 7)] != 0u);                                                                     \
            const int nb_ = (nkb - 8 * (tile_)) < 8 ? (nkb - 8 * (tile_)) : 8;                                                                   \
            LAS unsigned char* tb_ = F.lds + (b_) * 32768;                                                                                       \
            for (int kb = 0; kb < nb_; kb += 2) {                                                                                                \
                if (squeeze_ || __any(cnt > 448)) { squeeze_ = false;                                                                            \
                    for (int rc_ = 0; rc_ < SP_REPK; ++rc_) compact256<false, 14>(cv, ci, cnt, thr, r32, hh);                                    \
                    if (__any(cnt > 400)) compact256<true, 32>(cv, ci, cnt, thr, r32, hh); }                                                     \
                float sc0 = 0.f, sc1 = 0.f;                                                                                                      \
                for (int rx_ = 0; rx_ < SP_REPX; ++rx_) {                                                                                        \
                bf16x8 B0[4], B1[4];                                                                                                             \
                _Pragma("unroll") for (int s = 0; s < 4; ++s) { B0[s] = *(const LAS bf16x8*)(tb_ + brd[s] + kb * 4096); B1[s] = *(const LAS bf16x8*)(tb_ + brd[s] + kb * 4096 + 4096); } \
                asm volatile("" : "+v"(B0[0]), "+v"(B0[1]), "+v"(B0[2]), "+v"(B0[3]), "+v"(B1[0]), "+v"(B1[1]), "+v"(B1[2]), "+v"(B1[3]));      \
                f32x16 acc0 = {}, acc1 = {};                                                                                                     \
                _Pragma("unroll") for (int s = 0; s < 4; ++s) { acc0 = MFMA32(A[s], B0[s], acc0); acc1 = MFMA32(A[s], B1[s], acc1); }            \
                { f32x2 s0_ = {0.f, 0.f}, s1_ = {0.f, 0.f};                                                                                      \
                _Pragma("unroll") for (int j = 0; j < 16; j += 2) { const int a0 = __float_as_int(acc0[j]), a1 = __float_as_int(acc0[j + 1]), b0 = __float_as_int(acc1[j]), b1 = __float_as_int(acc1[j + 1]); \
                    const f32x2 r0_ = {__int_as_float(a0 > 0 ? a0 : 0), __int_as_float(a1 > 0 ? a1 : 0)}, r1_ = {__int_as_float(b0 > 0 ? b0 : 0), __int_as_float(b1 > 0 ? b1 : 0)}; \
                    const f32x2 w_ = {wv[j], wv[j + 1]};                                                                                         \
                    s0_ = __builtin_elementwise_fma(r0_, w_, s0_); s1_ = __builtin_elementwise_fma(r1_, w_, s1_); }                               \
                sc0 = s0_[0] + s0_[1]; sc1 = s1_[0] + s1_[1]; }                                                                                  \
                asm volatile("" : "+v"(sc0), "+v"(sc1)); }                                                                                       \
                const unsigned key0 = f2key(sc0), key1 = f2key(sc1);                                                                             \
                const bool f0 = key0 > thr, f1 = key1 > thr;                                                                                     \
                const unsigned m0 = half_of(__ballot(f0), hh), m1 = half_of(__ballot(f1), hh);                                                   \
                const int pos0 = cnt + __popc(m0 & ltm), pos1 = cnt + __popc(m0) + __popc(m1 & ltm);                                             \
                if (f0) { cv[pos0] = key0; ci[pos0] = (unsigned)(256 * (tile_) + 32 * kb + r32); }                                               \
                if (f1) { cv[pos1] = key1; ci[pos1] = (unsigned)(256 * (tile_) + 32 * kb + 32 + r32); }                                          \
                cnt += __popc(m0) + __popc(m1);                                                                                                  \
            } } while (0)
        SP_KLOAD(stgA, 0);
        SP_KWRITE(stgA, 0);
        __builtin_amdgcn_s_waitcnt(0x0F70);
        if (ntile > 1) SP_KLOAD(stgB, 1);
        for (int tile = 0; tile < ntile; tile += 2) {
            if (tile + 2 < ntile) SP_KLOAD(stgA, tile + 2);
            SP_TILE(tile, 0);
            if (tile + 1 >= ntile) break;
            SP_KWRITE(stgB, 1);
            if (tile + 3 < ntile) SP_KLOAD(stgB, tile + 3);
            SP_TILE(tile + 1, 1);
            if (tile + 2 < ntile) SP_KWRITE(stgA, 0);
        }
#undef SP_TILE
#undef SP_KLOAD
#undef SP_KWRITE
        for (int rf_ = 0; rf_ < SP_REPF; ++rf_) if (rf_ || __any(cnt > 256)) compact256<true, 32>(cv, ci, cnt, thr, r32, hh);
#pragma unroll
        for (int i = 0; i < 8; ++i) { const int e = r32 + 32 * i; if (e < cnt) sel[hh * 256 + e] = (unsigned short)ci[e]; }
    }
    LDS_WAIT();
    __syncthreads();
    const int ns0 = __builtin_amdgcn_readlane(cnt, 0), ns1 = __builtin_amdgcn_readlane(cnt, 32);
    const int q4 = c16 >> 2, p4 = c16 & 3;
    const int trx = (q4 << 2) | g;
    const unsigned gb = (unsigned)(uintptr_t)reg;
    unsigned tra[8];
#pragma unroll
    for (int c = 0; c < 8; ++c) tra[c] = gb + 512 * (4 * g + q4) + 8 * (p4 & 1) + 16 * ((2 * c + (p4 >> 1)) ^ trx);
    LAS unsigned short* ol = (LAS unsigned short*)(F.lds + SP_OL + wave * 8192);
#pragma unroll 1
    for (int qi = 0; qi < 2; ++qi) {
        const int tq = tq0 + qi, ns = qi ? ns1 : ns0;
        bf16x8 qf[8];
#pragma unroll
        for (int s = 0; s < 8; ++s) { bf16x8 z = {}; qf[s] = (c16 < 8) ? *(const bf16x8*)(H + (size_t)tq * NPAD + C_CQ + c16 * 256 + 32 * s + 8 * g) : z; }
        f32x4 Z[16];
#pragma unroll
        for (int c = 0; c < 16; ++c) Z[c] = (f32x4){0.f, 0.f, 0.f, 0.f};
        float m = -1e30f, ls = 0.f;
        const int nsb = (ns + 15) >> 4;
        u32x4 datA[8], datB[8];
#define SP_GATHER(d_, j_) do { const int e_ = 16 * (j_) + c16; const int idx_ = (e_ < ns) ? (int)sel[qi * 256 + e_] : 0;                        \
            const bf16_t* rp_ = B_CN(F) + (size_t)idx_ * 256 + 8 * g;                                                                            \
            _Pragma("unroll") for (int i = 0; i < 8; ++i) d_[i] = *(const u32x4*)(rp_ + 32 * i); } while (0)
#define SP_GWRITE(d_) do { _Pragma("unroll") for (int i = 0; i < 8; ++i) *(LAS u32x4*)(reg + goff(c16, 4 * i + g)) = d_[i]; } while (0)
#define TRRD(dst, a, off) asm volatile("ds_read_b64_tr_b16 %0, %1 offset:%2" : "=&v"(dst) : "v"(a), "i"(off) : "memory")
#define SP_QK(d_) do { st = (f32x4){0.f, 0.f, 0.f, 0.f};                                                                                         \
            _Pragma("unroll") for (int s = 0; s < 8; ++s) st = MFMA16(__builtin_bit_cast(bf16x8, d_[s]), qf[s], st); } while (0)
#define SP_STEP(j_) do {                                                                                                                         \
            float mloc = -__builtin_inff();                                                                                                      \
            _Pragma("unroll") for (int r = 0; r < 4; ++r) { const int e = 16 * (j_) + 4 * g + r; const float v = (e < ns) ? st[r] * 0.0625f : -__builtin_inff(); st[r] = v; mloc = fmaxf(mloc, v); } \
            mloc = fmaxf(mloc, bperm_f(lane ^ 16, mloc)); mloc = fmaxf(mloc, bperm_f(lane ^ 32, mloc));                                                  \
            const float mn = fmaxf(m, mloc), alpha = __expf(m - mn);                                                                             \
            float ps = 0.f;                                                                                                                      \
            _Pragma("unroll") for (int r = 0; r < 4; ++r) { const float p = __expf(st[r] - mn); st[r] = p; ps += p; }                            \
            ps += bperm_f(lane ^ 16, ps); ps += bperm_f(lane ^ 32, ps);                                                                                  \
            ls = ls * alpha + ps; m = mn;                                                                                                        \
            const bf16x8 pa = pack8f(st[0], st[1], st[2], st[3], 0.f, 0.f, 0.f, 0.f);                                                            \
            if (__any(alpha < 1.f)) {                                                                                                            \
                float ar[4];                                                                                                                     \
                _Pragma("unroll") for (int r = 0; r < 4; ++r) ar[r] = bperm_f(4 * g + r, alpha);                                                  \
                _Pragma("unroll") for (int c = 0; c < 16; ++c) _Pragma("unroll") for (int r = 0; r < 4; ++r) Z[c][r] *= ar[r];                   \
            }                                                                                                                                    \
            _Pragma("unroll") for (int c = 0; c < 8; c += 2) {                                                                                   \
                s16x4 l0, l1, l2, l3;                                                                                                            \
                TRRD(l0, tra[c], 0); TRRD(l1, tra[c], 256); TRRD(l2, tra[c + 1], 0); TRRD(l3, tra[c + 1], 256);                                  \
                asm volatile("s_waitcnt lgkmcnt(0)" ::: "memory"); __builtin_amdgcn_sched_barrier(0);                                            \
                Z[c] = MFMA16(pa, ((bf16x8){l0[0], l0[1], l0[2], l0[3], 0, 0, 0, 0}), Z[c]);                                                     \
                Z[c + 8] = MFMA16(pa, ((bf16x8){l1[0], l1[1], l1[2], l1[3], 0, 0, 0, 0}), Z[c + 8]);                                             \
                Z[c + 1] = MFMA16(pa, ((bf16x8){l2[0], l2[1], l2[2], l2[3], 0, 0, 0, 0}), Z[c + 1]);                                             \
                Z[c + 9] = MFMA16(pa, ((bf16x8){l3[0], l3[1], l3[2], l3[3], 0, 0, 0, 0}), Z[c + 9]);                                             \
            } } while (0)
        f32x4 st;
        SP_GATHER(datA, 0);
        if (nsb > 1) SP_GATHER(datB, 1);
        for (int j = 0; j < nsb; j += 2) {
            SP_QK(datA); SP_GWRITE(datA);
            if (j + 2 < nsb) SP_GATHER(datA, j + 2);
            SP_STEP(j);
            if (j + 1 >= nsb) break;
            SP_QK(datB); SP_GWRITE(datB);
            if (j + 3 < nsb) SP_GATHER(datB, j + 3);
            SP_STEP(j + 1);
        }
#undef SP_QK
#undef SP_STEP
#undef TRRD
#undef SP_GATHER
#undef SP_GWRITE
        float inv[4];
#pragma unroll
        for (int r = 0; r < 4; ++r) inv[r] = 1.f / bperm_f(4 * g + r, ls);
        if (g < 2) {
#pragma unroll
            for (int c = 0; c < 16; ++c) {
                const int lat = 16 * c + c16;
#pragma unroll
                for (int r = 0; r < 4; ++r) ol[(qi * 8 + 4 * g + r) * 256 + lat] = (unsigned short)(cvtpk_c(Z[c][r] * inv[r], 0.f) & 0xffffu);
            }
        }
    }
    LDS_WAIT();
    __syncthreads();
    {
        const int hd = wave;
        bf16x8 A[8];
#pragma unroll
        for (int s = 0; s < 8; ++s) A[s] = *(const LAS bf16x8*)(F.lds + SP_OL + (c16 >> 1) * 8192 + (((c16 & 1) * 8 + hd) * 256 + 32 * s + 8 * g) * 2);
        const bf16_t* wb = B_WUVT(F) + ((size_t)(l * 8 + hd) * 128 + c16) * 256 + 8 * g;
#pragma unroll 1
        for (int n4 = 0; n4 < 2; ++n4) {
            bf16x8 b[4][8];
#pragma unroll
            for (int n = 0; n < 4; ++n)
#pragma unroll
                for (int s = 0; s < 8; ++s) b[n][s] = *(const bf16x8*)(wb + (size_t)(4 * n4 + n) * 16 * 256 + 32 * s);
#pragma unroll
            for (int n = 0; n < 4; ++n) {
                f32x4 acc = (f32x4){0.f, 0.f, 0.f, 0.f};
#pragma unroll
                for (int s = 0; s < 8; ++s) acc = MFMA16(A[s], b[n][s], acc);
#pragma unroll
                for (int r = 0; r < 4; ++r) { const int t = t0 + 4 * g + r; const int col = hd * 128 + 16 * (4 * n4 + n) + c16;
                    const float gt = bf2f(H[(size_t)t * NPAD + C_CG + col]);
                    B_O(F)[(size_t)t * DM + 3072 + col] = (bf16_t)(cvtpk_c(acc[r] * silu(gt), 0.f) & 0xffffu); }
            }
        }
    }
}
__device__ __forceinline__ dattn::BlockRef dattn_ref(const bf16_t* H, float* OD, int id) {
    dattn::BlockRef r; const int qb = 63 - (id >> 4), ph = id & 15, hd = ph >> 2, mp = (ph >> 1) & 1, e = ph & 1;
    r.Q = H + (size_t)(qb * 256) * NPAD + C_BQ + hd * 256 + mp * 128; r.K = H + C_BK + hd * 256 + mp * 128; r.V = H + C_BV + hd * 256 + e * 128;
    r.O = OD + (size_t)(qb * 256) * 2048 + hd * 512 + mp * 256 + e * 128; r.P0 = qb * 256; return r;
}
#ifndef REPA
#define REPA 1
#endif
#ifndef REPB
#define REPB 1
#endif
#ifndef REPC
#define REPC 1
#endif
#ifndef REPG1
#define REPG1 1
#endif
#ifndef REPS
#define REPS 1
#endif
#ifndef MIXMASK
#define MIXMASK 7
#endif
__device__ __forceinline__ void mix_phase(Frame& F, int l) {
    if (MIXMASK & 1) for (int rep = 0; rep < REPA; ++rep) { const int qx = rep * 16 + l * 4 + 0;
        for (int u = grab(F, qx); u < 16; u = grab(F, qx)) gla_unit(F, u); }
    if (MIXMASK & 2) for (int rep = 0; rep < REPB; ++rep) { const int qx = rep * 16 + l * 4 + 1;
        int cur = grab(F, qx);
        if (cur < 1024) {
            dattn::Seam S;
            dattn::BlockRef rc = dattn_ref(B_H(F), B_OD(F), cur);
            dattn::prime(rc, (char*)F.lds, S, F.wave);
            for (;;) {
                const int nx = grab(F, qx); const bool last = nx >= 1024;
                const dattn::BlockRef rn = last ? rc : dattn_ref(B_H(F), B_OD(F), nx);
                dattn::block(rc, rn, (char*)F.lds, S, F.wave);
                if (last) break;
                rc = rn;
            }
            VM_WAIT(); __syncthreads();
        }
    }
    if (MIXMASK & 4) for (int rep = 0; rep < REPC; ++rep) { const int qx = rep * 16 + l * 4 + 2;
        for (int u = grab(F, qx); u < SEQ / 16; u = grab(F, qx)) sparse_unit(F, l, SEQ / 16 - 1 - u); }
}

struct Args { const float* in[14]; float* out; unsigned char* ws; int ph_lo, ph_hi, li, pad; };
constexpr int NPHASE = 1 + 6 * DEPTH;
__global__ void __launch_bounds__(NWAVES * 64, 2) trunk_fwd(Args args) {
    extern __shared__ __attribute__((aligned(16))) unsigned char lds[];
    Frame F;
    F.lds = (LAS unsigned char*)lds;
    F.MISC = (volatile LAS unsigned*)(F.lds + MISC_OFF);
    F.wave = __builtin_amdgcn_readfirstlane((int)threadIdx.x >> 6);
    F.G = gridDim.x; { const int bx = blockIdx.x; F.vcu = (F.G % 8 == 0) ? (bx % 8) * (F.G / 8) + bx / 8 : bx; }
    F.ws = args.ws;
    F.ctl = (gu32*)(args.ws + WS_CTL);
    if (threadIdx.x < 128) ((LAS unsigned*)(F.lds + MISC_OFF))[threadIdx.x] = 0u;
    __syncthreads();
    XcdBarrier bar = xcd_barrier_post((unsigned*)(F.ctl + CW_BAR), F.MISC + 0);
#ifndef PMASK
#define PMASK 0x7f
#endif
#define IN(k) true
#define SEAM(k) do { if ((k) + 1 < NPHASE) { XcdBarrier b2_ = bar; unsigned xx_ = b2_.x; asm volatile("" : "+s"(xx_)); b2_.x = xx_; xcd_barrier(b2_); } } while (0)
    if ((PMASK & 1) && IN(0)) { p0_prologue(F, args.in[0], args.in[1], args.in[2], args.in[11]); SEAM(0); }
    for (int l = 0; l < DEPTH; ++l) {
        const int pb = 1 + 6 * l;
        const float lam_init = 0.8f - 0.6f * expf(-0.3f * (float)l);
        if ((PMASK & 2) && IN(pb + 0)) {
            pg8::Gemm g{B_XB(F), B_WTIN(F) + (size_t)l * NPAD * DM, SEQ, NPAD, DM}; pg8::StaticOrder S; S.init(SEQ, NPAD, F.G, (int)blockIdx.x);
            pg8::EpiBf16Plain E{B_H(F), NPAD};
            for (int rep = 0; rep < REPG1; ++rep) pg8::gemm_phase<pg8::EpiBf16Plain, pg8::StaticOrder, true, true>(F.lds, g, S, E, F.wave);
            SEAM(pb + 0);
        }
        if ((PMASK & 4) && IN(pb + 1)) { for (int rep = 0; rep < REPS; ++rep) prep_phase(F, l, args.in[3], args.in[4], args.in[8], args.in[9], args.in[10]); SEAM(pb + 1); }
        if ((PMASK & 8) && IN(pb + 2)) { mix_phase(F, l); SEAM(pb + 2); }
        if ((PMASK & 16) && IN(pb + 3)) { for (int rep = 0; rep < REPS; ++rep) post_phase(F, l, lam_init, args.in[5], args.in[6], args.in[7]); SEAM(pb + 3); }
        if ((PMASK & 32) && IN(pb + 4)) {
            pg8::Gemm g{B_O(F), B_WTOUT(F) + (size_t)l * DM * DM, SEQ, DM, DM}; pg8::StaticOrder S; S.init(SEQ, DM, F.G, (int)blockIdx.x);
            pg8::EpiResid E{l == 0 ? args.in[0] : B_XF(F), B_XF(F), DM, 1.6817928305074290f};
            pg8::gemm_phase<pg8::EpiResid, pg8::StaticOrder, true, true>(F.lds, g, S, E, F.wave);
            SEAM(pb + 4);
        }
        if ((PMASK & 64) && IN(pb + 5)) {
#if defined(REPLN)
            ln_phase(F, l, args.in[12], args.in[13], args.out, true);
#endif
            ln_phase(F, l, args.in[12], args.in[13], args.out, false); SEAM(pb + 5); }
    }
#undef IN
#undef SEAM
}

#ifndef MK_N_LAUNCHES
#define MK_N_LAUNCHES 1
#endif
extern "C" void kernel_launch(void* const* d_in, const int* in_sizes, int n_in, void* d_out, int out_size, void* d_ws, size_t ws_size, hipStream_t stream) {
    static int grid = 0;
    if (grid == 0) {
        if (n_in != 14 || in_sizes[0] != SEQ * DM || out_size != SEQ * DM || ws_size < WS_END) {
            fprintf(stderr, "kernel_launch: shape mismatch (n_in %d, in0 %d, out %d, ws %zu; need ws >= %zu)\n", n_in, n_in > 0 ? in_sizes[0] : -1, out_size, ws_size, (size_t)WS_END); grid = -1; return; }
        int dev = 0, cus = 0, per_cu = 0;
        if (hipGetDevice(&dev) != hipSuccess || hipDeviceGetAttribute(&cus, hipDeviceAttributeMultiprocessorCount, dev) != hipSuccess) { grid = -1; return; }
        if (hipFuncSetAttribute((const void*)trunk_fwd, hipFuncAttributeMaxDynamicSharedMemorySize, LDS_BYTES) != hipSuccess) { fprintf(stderr, "kernel_launch: hipFuncSetAttribute failed\n"); grid = -1; return; }
        if (hipOccupancyMaxActiveBlocksPerMultiprocessor(&per_cu, (const void*)trunk_fwd, NWAVES * 64, LDS_BYTES) != hipSuccess || per_cu < 1)
            fprintf(stderr, "kernel_launch: occupancy query reports %d workgroups per CU\n", per_cu);
        (void)hipGetLastError();
        grid = cus;
    }
    if (grid < 0) return;
    if (hipMemsetAsync((char*)d_ws + WS_CTL, 0, CTL_ZERO_BYTES, stream) != hipSuccess) return;
    Args a{};
    for (int i = 0; i < 14; ++i) a.in[i] = (const float*)d_in[i];
    a.out = (float*)d_out; a.ws = (unsigned char*)d_ws;
    a.ph_lo = 0; a.ph_hi = NPHASE; a.li = 0; a.pad = 0;
    hipLaunchKernelGGL(trunk_fwd, dim3(grid), dim3(NWAVES * 64), LDS_BYTES, stream, a);
    const hipError_t le = hipPeekAtLastError();
    if (le != hipSuccess) fprintf(stderr, "kernel_launch: launch failed: %s\n", hipGetErrorName(le));
}
```

```cpp
#include <hip/hip_runtime.h>
#include <cstdio>
#include <cstdint>

#define GAS __attribute__((address_space(1)))
#define LAS __attribute__((address_space(3)))
typedef unsigned short bf16_t;
typedef short s16x4 __attribute__((ext_vector_type(4)));
typedef float f32x16 __attribute__((ext_vector_type(16)));
typedef unsigned u32x2 __attribute__((ext_vector_type(2)));
typedef GAS unsigned gu32;

__device__ __forceinline__ int hw_lane() { int r; asm volatile("v_mbcnt_lo_u32_b32 %0, -1, 0\n\tv_mbcnt_hi_u32_b32 %0, -1, %0" : "=v"(r)); return r; }

constexpr int SEQ = 16384, DM = 4096, DEPTH = 4, NIN = 14688, NPAD = 14848;
constexpr int CHUNK = 64, NCHUNK = SEQ / CHUNK;
constexpr int C_AQ = 0, C_AK = 1024, C_AV = 2048, C_AG = 4096, C_BQ = 6144, C_BK = 7168, C_BV = 8192, C_BG = 9216, C_CQ = 10240,
              C_CKV = 12288, C_CIQ = 12544, C_CG = 13568, C_CIK = 14592, C_AA = 14656, C_CIW = 14672;
__host__ __device__ __forceinline__ int srccol(int n) {
    if (n < 4096) return n;
    if (n < 6144) return n + 16;
    if (n < 13568) return n + 16;
    if (n < 14592) return n + 96;
    if (n < 14656) return n - 1008;
    if (n < 14672) return n - 10560;
    if (n < 14688) return n - 1024;
    return -1;
}
namespace pg8 {
#define PG8_LAS __attribute__((address_space(3)))
typedef unsigned short bf16_t;
typedef short bf16x8 __attribute__((ext_vector_type(8)));
typedef float f32x4 __attribute__((ext_vector_type(4)));
typedef unsigned u32x4 __attribute__((ext_vector_type(4)));
constexpr int BM = 256, BK = 64, HALF = 128, HTB = HALF * BK * 2  , STAGE_BYTES = 8 * HTB, NXCD = 8, WGM = 8;

__host__ __device__ __forceinline__ int lds_byte(int r, int c) { const int st = (r >> 4) * 2 + (c >> 5), rr = r & 15, cc = c & 31, ob = rr * 64 + cc * 2; return st * 1024 + (ob ^ (((ob >> 9) & 1) << 5)); }
__host__ __device__ __forceinline__ void stage_rc(int b, int& R, int& C) { const int st = b / 1024, sb = b % 1024, swz = sb ^ (((sb >> 9) & 1) << 5); R = (st >> 1) * 16 + swz / 64; C = (st & 1) * 32 + (swz % 64) / 2; }
__host__ __device__ __forceinline__ int perm32(int rho) { const int n = rho >> 4, i = rho & 15; return 8 * (i >> 2) + 4 * n + (i & 3); }

struct Unit { int pm, pn; };
struct Gemm { const bf16_t* A; const bf16_t* Bt; int M, N, K; };

struct StaticOrder {
    int nM, nN, nwg, G, c;
    __host__ __device__ void init(int M, int N, int G_, int c_) { nM = M / BM; nN = N / BM; nwg = nM * nN; G = G_; c = c_; }
    __host__ __device__ bool next(int i, Unit& u) const {
        const long L = (long)i * G + c; if (L >= nwg) return false;
        int wgid = (int)L; { const int q = nwg / NXCD, r = nwg % NXCD, xcd = wgid % NXCD, off = wgid / NXCD; wgid = (xcd < r ? xcd * (q + 1) : r * (q + 1) + (xcd - r) * q) + off; }
        const int nig = WGM * nN, gid = wgid / nig, fm = gid * WGM, gsz = (nM - fm) < WGM ? (nM - fm) : WGM;
        u.pm = fm + ((wgid % nig) % gsz); u.pn = (wgid % nig) / gsz; return true;
    }
    __device__ __forceinline__ void a_ready(const Unit&) const {}
    __device__ __forceinline__ void done(const Unit&) const {}
};

__device__ __forceinline__ unsigned cvt_pk_bf16(float lo, float hi) { unsigned r; asm volatile("v_cvt_pk_bf16_f32 %0, %1, %2" : "=v"(r) : "v"(lo), "v"(hi)); return r; }
typedef float f32x2 __attribute__((ext_vector_type(2)));
struct EpiBf16Plain {
    static constexpr bool PERM = true, AFTER_DRAIN = false;
    bf16_t* O; int ldc;
    __device__ __forceinline__ void operator()(const f32x4 (&acc)[2][2][4][2], const Unit& u, int wr, int wc, int fr, int fq) const {
        const int row0 = u.pm * BM + wr * 64 + fr, col0 = u.pn * BM + wc * 32 + 8 * fq;
#pragma unroll
        for (int ai = 0; ai < 2; ++ai)
#pragma unroll
            for (int m = 0; m < 4; ++m) { bf16_t* rowp = O + (size_t)(row0 + ai * HALF + m * 16) * ldc + col0;
#pragma unroll
                for (int bj = 0; bj < 2; ++bj) { const f32x4 v0 = acc[ai][bj][m][0], v1 = acc[ai][bj][m][1];
                    u32x4 w; w.x = cvt_pk_bf16(v0[0], v0[1]); w.y = cvt_pk_bf16(v0[2], v0[3]); w.z = cvt_pk_bf16(v1[0], v1[1]); w.w = cvt_pk_bf16(v1[2], v1[3]);
                    *(u32x4*)(rowp + bj * HALF) = w; } }
    }
};
struct EpiResid {
    static constexpr bool PERM = false, AFTER_DRAIN = false;
    const float* Xin; float* Xout; int ldc; float alpha;
    __device__ __forceinline__ void operator()(const f32x4 (&acc)[2][2][4][2], const Unit& u, int wr, int wc, int fr, int fq) const {
        const int row0 = u.pm * BM + wr * 64 + fr, col0 = u.pn * BM + wc * 32 + 4 * fq;
#pragma unroll
        for (int ai = 0; ai < 2; ++ai)
#pragma unroll
            for (int m = 0; m < 4; ++m) { const size_t off = (size_t)(row0 + ai * HALF + m * 16) * ldc + col0;
#pragma unroll
                for (int bj = 0; bj < 2; ++bj)
#pragma unroll
                    for (int n = 0; n < 2; ++n) { const f32x4 xi = *(const f32x4*)(Xin + off + bj * HALF + n * 16);
                        *(f32x4*)(Xout + off + bj * HALF + n * 16) = xi * alpha + acc[ai][bj][m][n]; }
                asm volatile("" ::: "memory"); }
    }
};
struct EpiResidB {
    static constexpr bool PERM = false, AFTER_DRAIN = false;
    const bf16_t* Xin; float* Xout; int ldc; float alpha;
    __device__ __forceinline__ void operator()(const f32x4 (&acc)[2][2][4][2], const Unit& u, int wr, int wc, int fr, int fq) const {
        const int row0 = u.pm * BM + wr * 64 + fr, col0 = u.pn * BM + wc * 32 + 4 * fq;
#pragma unroll
        for (int ai = 0; ai < 2; ++ai)
#pragma unroll
            for (int m = 0; m < 4; ++m) { const size_t off = (size_t)(row0 + ai * HALF + m * 16) * ldc + col0;
#pragma unroll
                for (int bj = 0; bj < 2; ++bj)
#pragma unroll
                    for (int n = 0; n < 2; ++n) { const unsigned long long w = *(const unsigned long long*)(Xin + off + bj * HALF + n * 16);
                        const unsigned lo = (unsigned)w, hi = (unsigned)(w >> 32);
                        const f32x4 xi = {__uint_as_float(lo << 16), __uint_as_float(lo & 0xffff0000u), __uint_as_float(hi << 16), __uint_as_float(hi & 0xffff0000u)};
                        *(f32x4*)(Xout + off + bj * HALF + n * 16) = xi * alpha + acc[ai][bj][m][n]; }
                asm volatile("" ::: "memory"); }
    }
};
template <class Epi, class Sched, bool ALIGN_EPI = false, bool SP2 = false>
__device__ __forceinline__ void gemm_phase(PG8_LAS unsigned char* lds, const Gemm g, const Sched& S, const Epi& E, int wave_id) {
    int tid_ = wave_id * 64 + hw_lane(); asm volatile("" : "+v"(tid_));
    const int tid = tid_, wid = __builtin_amdgcn_readfirstlane(tid >> 6), lane = tid & 63, wr = wid >> 2, wc = wid & 3, fr = lane & 15, fq = lane >> 4;
    const int K = g.K, nt = K / BK;
    unsigned voffA[2], voffB[2];
#pragma unroll
    for (int i = 0; i < 2; ++i) { int R, C; stage_rc(tid * 16 + i * 8192, R, C); const int Rb = Epi::PERM ? ((R & ~31) + perm32(R & 31)) : R;
        voffA[i] = (unsigned)(R * K + C) * 2u; voffB[i] = (unsigned)(Rb * K + C) * 2u; }
    const size_t kstep = (size_t)(BK * 2);
    const size_t hstep = (size_t)HALF * K * 2;
    const size_t tstep = 2 * hstep;
    const unsigned ldsw = (unsigned)wid * 1024u;
    const int aoff = lds_byte(wr * 64 + fr, fq * 8), boff = lds_byte(wc * 32 + fr, fq * 8);
#define PG8_SA(b, h) (((b) * 2 + (h)) * HTB)
#define PG8_SB(b, h) ((4 + (b) * 2 + (h)) * HTB)
#define PG8_STAGE(bufoff, gbase, voff) do { _Pragma("unroll") for (int _i = 0; _i < 2; ++_i) \
        __builtin_amdgcn_global_load_lds((const unsigned*)((const char*)(gbase) + (voff)[_i]), (PG8_LAS unsigned*)(lds + (bufoff) + ldsw + _i * 8192), 16, 0, 0); } while (0)
#define PG8_LDA(dst, b, h) do { _Pragma("unroll") for (int m = 0; m < 4; ++m) _Pragma("unroll") for (int k = 0; k < 2; ++k) dst[m][k] = *(const PG8_LAS bf16x8*)(lds + PG8_SA(b, h) + aoff + m * 2048 + k * 1024); } while (0)
#define PG8_LDB(dst, b, h) do { _Pragma("unroll") for (int n = 0; n < 2; ++n) _Pragma("unroll") for (int k = 0; k < 2; ++k) dst[n][k] = *(const PG8_LAS bf16x8*)(lds + PG8_SB(b, h) + boff + n * 2048 + k * 1024); } while (0)
#define PG8_MMA(ai, bj, At, Bt) do { __builtin_amdgcn_s_setprio(1); _Pragma("unroll") for (int m = 0; m < 4; ++m) _Pragma("unroll") for (int n = 0; n < 2; ++n) _Pragma("unroll") for (int k = 0; k < 2; ++k) \
        acc[ai][bj][m][n] = __builtin_amdgcn_mfma_f32_16x16x32_bf16(Bt[n][k], At[m][k], acc[ai][bj][m][n], 0, 0, 0); __builtin_amdgcn_s_setprio(0); } while (0)
#define PG8_WAIT_V(n) asm volatile("s_waitcnt vmcnt(" #n ")" ::: "memory")
#define PG8_WAIT_L(n) asm volatile("s_waitcnt lgkmcnt(" #n ")" ::: "memory")
#define PG8_BAR __builtin_amdgcn_s_barrier()
#define PG8_SCHED __builtin_amdgcn_sched_barrier(0)
    Unit cur, nxt; int ui = 0;
    if (!S.next(0, cur)) return;
    f32x4 acc[2][2][4][2];
#pragma unroll
    for (int a = 0; a < 2; ++a)
#pragma unroll
        for (int b = 0; b < 2; ++b)
#pragma unroll
            for (int m = 0; m < 4; ++m)
#pragma unroll
                for (int n = 0; n < 2; ++n) acc[a][b][m][n] = (f32x4){0.f, 0.f, 0.f, 0.f};
    bf16x8 At[4][2], B0[2][2], B1[2][2];
    const char* cA = (const char*)g.A + (size_t)cur.pm * tstep; const char* cB = (const char*)g.Bt + (size_t)cur.pn * tstep;
    S.a_ready(cur);
    if constexpr (SP2) {
        PG8_STAGE(PG8_SB(0, 0), cB, voffB); PG8_STAGE(PG8_SB(0, 1), cB + hstep, voffB); PG8_STAGE(PG8_SA(0, 0), cA, voffA); PG8_STAGE(PG8_SA(0, 1), cA + hstep, voffA);
        if (wr == 1) PG8_BAR;
        PG8_WAIT_V(2); PG8_BAR;
        PG8_STAGE(PG8_SB(1, 0), cB + kstep, voffB); PG8_STAGE(PG8_SA(1, 0), cA + kstep, voffA); PG8_STAGE(PG8_SB(1, 1), cB + hstep + kstep, voffB);
        PG8_WAIT_V(6); PG8_BAR;
    } else {
        PG8_STAGE(PG8_SB(0, 0), cB, voffB); PG8_STAGE(PG8_SA(0, 0), cA, voffA); PG8_STAGE(PG8_SB(0, 1), cB + hstep, voffB); PG8_STAGE(PG8_SA(0, 1), cA + hstep, voffA);
        if (wr == 1) PG8_BAR;
        PG8_WAIT_V(4); PG8_BAR;
        PG8_STAGE(PG8_SB(1, 0), cB + kstep, voffB); PG8_STAGE(PG8_SA(1, 0), cA + kstep, voffA); PG8_STAGE(PG8_SB(1, 1), cB + hstep + kstep, voffB);
        PG8_WAIT_V(6); PG8_BAR;
    }
    for (;;) {
        const bool has_next = S.next(ui + 1, nxt);
        const char* nA = has_next ? (const char*)g.A + (size_t)nxt.pm * tstep : cA; const char* nB = has_next ? (const char*)g.Bt + (size_t)nxt.pn * tstep : cB;
        for (int t = 0; t < nt; t += 2) {
            const bool last = (t == nt - 2);
            const char* a1 = cA + (size_t)(t + 1) * kstep;
            const char* a2 = last ? nA : cA + (size_t)(t + 2) * kstep; const char* b2 = last ? nB : cB + (size_t)(t + 2) * kstep;
            const char* a3 = a2 + kstep; const char* b3 = b2 + kstep;
            if (last && has_next) S.a_ready(nxt);
            if constexpr (SP2) {
            PG8_LDB(B0, 0, 0); PG8_LDB(B1, 0, 1); PG8_SCHED; PG8_LDA(At, 0, 0); PG8_STAGE(PG8_SA(1, 1), a1 + hstep, voffA);
            PG8_WAIT_V(8); PG8_WAIT_L(0); PG8_BAR; PG8_MMA(0, 0, At, B0); PG8_MMA(0, 1, At, B1); PG8_BAR; PG8_SCHED;
            PG8_LDA(At, 0, 1); PG8_STAGE(PG8_SB(0, 0), b2, voffB); PG8_STAGE(PG8_SB(0, 1), b2 + hstep, voffB); PG8_STAGE(PG8_SA(0, 0), a2, voffA);
            PG8_WAIT_V(8); PG8_WAIT_L(0); PG8_BAR; PG8_MMA(1, 0, At, B0); PG8_MMA(1, 1, At, B1); PG8_BAR; PG8_SCHED;
            PG8_LDB(B0, 1, 0); PG8_LDB(B1, 1, 1); PG8_SCHED; PG8_LDA(At, 1, 0); PG8_STAGE(PG8_SA(0, 1), a2 + hstep, voffA);
            PG8_WAIT_V(8); PG8_WAIT_L(0); PG8_BAR; PG8_MMA(0, 0, At, B0); PG8_MMA(0, 1, At, B1); PG8_BAR; PG8_SCHED;
            PG8_LDA(At, 1, 1); PG8_STAGE(PG8_SB(1, 0), b3, voffB); PG8_STAGE(PG8_SB(1, 1), b3 + hstep, voffB); PG8_STAGE(PG8_SA(1, 0), a3, voffA);
            PG8_WAIT_V(8); PG8_WAIT_L(0); PG8_BAR; PG8_MMA(1, 0, At, B0); PG8_MMA(1, 1, At, B1); PG8_BAR; PG8_SCHED;
            } else {
            PG8_LDB(B0, 0, 0); PG8_SCHED; PG8_LDA(At, 0, 0); PG8_STAGE(PG8_SA(1, 1), a1 + hstep, voffA);
            PG8_WAIT_L(8); PG8_BAR; PG8_WAIT_L(0); PG8_MMA(0, 0, At, B0); PG8_BAR; PG8_SCHED;
            PG8_LDB(B1, 0, 1); PG8_STAGE(PG8_SB(0, 0), b2, voffB);
            PG8_BAR; PG8_WAIT_L(0); PG8_MMA(0, 1, At, B1); PG8_BAR;
            PG8_LDA(At, 0, 1); PG8_STAGE(PG8_SA(0, 0), a2, voffA);
            PG8_BAR; PG8_WAIT_L(0); PG8_MMA(1, 0, At, B0); PG8_BAR; PG8_SCHED;
            PG8_STAGE(PG8_SB(0, 1), b2 + hstep, voffB);
            PG8_WAIT_V(6); PG8_BAR; PG8_MMA(1, 1, At, B1); PG8_BAR;
            PG8_LDB(B0, 1, 0); PG8_SCHED; PG8_LDA(At, 1, 0); PG8_STAGE(PG8_SA(0, 1), a2 + hstep, voffA);
            PG8_WAIT_L(8); PG8_BAR; PG8_WAIT_L(0); PG8_MMA(0, 0, At, B0); PG8_BAR; PG8_SCHED;
            PG8_LDB(B1, 1, 1); PG8_STAGE(PG8_SB(1, 0), b3, voffB);
            PG8_BAR; PG8_WAIT_L(0); PG8_MMA(0, 1, At, B1); PG8_BAR;
            PG8_LDA(At, 1, 1); PG8_STAGE(PG8_SA(1, 0), a3, voffA);
            PG8_BAR; PG8_WAIT_L(0); PG8_MMA(1, 0, At, B0); PG8_BAR; PG8_SCHED;
            PG8_STAGE(PG8_SB(1, 1), b3 + hstep, voffB);
            PG8_WAIT_V(6); PG8_BAR; PG8_MMA(1, 1, At, B1); PG8_BAR;
            }
        }
        if constexpr (ALIGN_EPI) { if (wr == 0) PG8_BAR; }
        if constexpr (!Epi::AFTER_DRAIN) { E(acc, cur, wr, wc, fr, fq); S.done(cur); }
        if (!has_next) break;
#pragma unroll
        for (int a = 0; a < 2; ++a)
#pragma unroll
            for (int b = 0; b < 2; ++b)
#pragma unroll
                for (int m = 0; m < 4; ++m)
#pragma unroll
                    for (int n = 0; n < 2; ++n) acc[a][b][m][n] = (f32x4){0.f, 0.f, 0.f, 0.f};
        cur = nxt; cA = nA; cB = nB; ++ui;
        if constexpr (ALIGN_EPI) { if (wr == 1) PG8_BAR; }
    }
    PG8_WAIT_V(0);
    if constexpr (!ALIGN_EPI) { if (wr == 0) PG8_BAR; }
    PG8_BAR;
    if constexpr (Epi::AFTER_DRAIN) { E.fused(acc, cur, wr, wc, fr, fq, lds, wid, lane); S.done(cur); }
#undef PG8_SA
#undef PG8_SB
#undef PG8_STAGE
#undef PG8_LDA
#undef PG8_LDB
#undef PG8_MMA
#undef PG8_WAIT_V
#undef PG8_WAIT_L
#undef PG8_BAR
#undef PG8_SCHED
}
}
using pg8::bf16x8; using pg8::f32x4; using pg8::u32x4;
namespace dattn {
constexpr int D = 128, LDQ = NPAD, LDK = NPAD, LDO = 2048;
constexpr float SCALE = 0.08838834764831845f;
constexpr float THR = 8.f;
constexpr int NW = 8, QBLK = 32, KVBLK = 64, QB = NW * QBLK;
constexpr int SHM_V = KVBLK * D * 2, SHM_K = KVBLK * D * 2;
constexpr int LDS_BYTES = 2 * SHM_V + 2 * SHM_K + NW * 64 * 4;

#define KSWZ(row, colB) ((row) * 256 + ((colB) ^ (((row) & 7) << 4)))
#define SBAR() __builtin_amdgcn_sched_barrier(0)
__device__ __forceinline__ int v_st(int k, int c) { const int kk = (k & ~0xC) | ((k & 4) << 1) | ((k & 8) >> 1); return ((kk >> 3) * 4 + (c >> 5)) * 512 + ((kk & 7) * 32 + (c & 31)) * 2; }
__device__ __forceinline__ int v_rd_base(int lane) { return ((lane & 3) << 3) | (((lane >> 2) & 3) << 6) | (((lane >> 4) & 1) << 5) | (((lane >> 5) & 1) << 8); }
constexpr int v_rd_off(int d0, int ks, int half) { return d0 * 512 + ks * 4096 + half * 2048; }
__device__ __forceinline__ int crow(int r, int hi) { return (r & 3) + 8 * (r >> 2) + 4 * hi; }
__device__ __forceinline__ unsigned cvtpk(float lo, float hi) { unsigned r; asm volatile("v_cvt_pk_bf16_f32 %0, %1, %2" : "=v"(r) : "v"(lo), "v"(hi)); return r; }
__device__ __forceinline__ bf16x8 load8(const bf16_t* p) { return *reinterpret_cast<const bf16x8*>(p); }

__device__ __forceinline__ void partialSM(f32x16& p0, f32x16& p1, float& m_reg, float& mn, float& alpha) {
    float pmax = p0[0]; for (int r = 1; r < 16; ++r) pmax = fmaxf(pmax, p0[r]); for (int r = 0; r < 16; ++r) pmax = fmaxf(pmax, p1[r]);
    { auto rr = __builtin_amdgcn_permlane32_swap(__float_as_uint(pmax), __float_as_uint(pmax), false, false);
      pmax = fmaxf(__uint_as_float(rr[0]), __uint_as_float(rr[1])); }
    constexpr float C2 = 1.4426950408889634f * SCALE;
    if (__builtin_expect(__all((pmax - m_reg) * SCALE <= THR), 1)) { mn = m_reg; alpha = 1.f; }
    else { mn = fmaxf(m_reg, pmax); alpha = __builtin_amdgcn_exp2f((m_reg - mn) * C2); m_reg = mn; }
    const float mnL = -mn * C2;
    for (int r = 0; r < 16; ++r) p0[r] = fmaf(p0[r], C2, mnL); for (int r = 0; r < 16; ++r) p1[r] = fmaf(p1[r], C2, mnL);
    for (int r = 0; r < 16; ++r) p0[r] = __builtin_amdgcn_exp2f(p0[r]);
}
__device__ __forceinline__ void finishSM(f32x16& p0, f32x16& p1, float alpha, float& l_reg, bf16x8& pa0, bf16x8& pa1, bf16x8& pa2, bf16x8& pa3) {
    for (int r = 0; r < 16; ++r) p1[r] = __builtin_amdgcn_exp2f(p1[r]);
    float ps = 0; for (int r = 0; r < 16; ++r) ps += p0[r]; for (int r = 0; r < 16; ++r) ps += p1[r];
    { auto rr = __builtin_amdgcn_permlane32_swap(__float_as_uint(ps), __float_as_uint(ps), false, false);
      ps = __uint_as_float(rr[0]) + __uint_as_float(rr[1]); }
    l_reg = l_reg * alpha + ps;
#define PK4(P, B_, OUT) do { unsigned a0 = cvtpk(P[B_+0], P[B_+1]), a1 = cvtpk(P[B_+2], P[B_+3]);                          \
        unsigned b0 = cvtpk(P[B_+4], P[B_+5]), b1 = cvtpk(P[B_+6], P[B_+7]);                                             \
        auto r0 = __builtin_amdgcn_permlane32_swap(a0, b0, false, false); auto r1 = __builtin_amdgcn_permlane32_swap(a1, b1, false, false); \
        u32x4 w = {r0[0], r1[0], r0[1], r1[1]}; OUT = *reinterpret_cast<bf16x8*>(&w); } while (0)
    PK4(p0, 0, pa0); PK4(p0, 8, pa1); PK4(p1, 0, pa2); PK4(p1, 8, pa3);
#undef PK4
}
template <int KB>
__device__ __forceinline__ void qkt(f32x16& p0, f32x16& p1, const char* K_lds, int r32, int hi, const bf16x8* qr) {
    p0 = f32x16{}; p1 = f32x16{};
    const char* kb[4];
#pragma unroll
    for (int dd = 0; dd < 4; ++dd) kb[dd] = K_lds + KB * SHM_K + KSWZ(r32, (dd * 16 + hi * 8) * 2);
#pragma unroll
    for (int d0 = 0; d0 < 8; ++d0) { const char* a = kb[d0 & 3] + (d0 >> 2) * 128;
        bf16x8 b0 = *reinterpret_cast<const bf16x8*>(a);
        bf16x8 b1 = *reinterpret_cast<const bf16x8*>(a + 32 * 256);
        p0 = __builtin_amdgcn_mfma_f32_32x32x16_bf16(b0, qr[d0], p0, 0, 0, 0);
        p1 = __builtin_amdgcn_mfma_f32_32x32x16_bf16(b1, qr[d0], p1, 0, 0, 0); }
}
template <int VB>
__device__ __forceinline__ void pv_tile(f32x16* o, int vb0, bf16x8 pa0, bf16x8 pa1, bf16x8 pa2, bf16x8 pa3) {
#define TRRD(dst, off) asm volatile("ds_read_b64_tr_b16 %0, %1 offset:%2" : "=&v"(dst) : "v"(vb0), "i"(off) : "memory")
#define PV_D0(d0) do { s16x4 l0, l1, l2, l3, h0, h1, h2, h3; constexpr int b_ = VB * SHM_V + v_rd_off(d0, 0, 0);   \
        TRRD(l0, b_); TRRD(h0, b_ + 2048); TRRD(l1, b_ + 4096); TRRD(h1, b_ + 6144); TRRD(l2, b_ + 8192); TRRD(h2, b_ + 10240); TRRD(l3, b_ + 12288); TRRD(h3, b_ + 14336); \
        asm volatile("s_waitcnt lgkmcnt(0)" ::: "memory"); SBAR();                                                   \
        o[d0] = __builtin_amdgcn_mfma_f32_32x32x16_bf16(pa0, (bf16x8){l0[0], l0[1], l0[2], l0[3], h0[0], h0[1], h0[2], h0[3]}, o[d0], 0, 0, 0);   \
        o[d0] = __builtin_amdgcn_mfma_f32_32x32x16_bf16(pa1, (bf16x8){l1[0], l1[1], l1[2], l1[3], h1[0], h1[1], h1[2], h1[3]}, o[d0], 0, 0, 0);   \
        o[d0] = __builtin_amdgcn_mfma_f32_32x32x16_bf16(pa2, (bf16x8){l2[0], l2[1], l2[2], l2[3], h2[0], h2[1], h2[2], h2[3]}, o[d0], 0, 0, 0);   \
        o[d0] = __builtin_amdgcn_mfma_f32_32x32x16_bf16(pa3, (bf16x8){l3[0], l3[1], l3[2], l3[3], h3[0], h3[1], h3[2], h3[3]}, o[d0], 0, 0, 0); } while (0)
    PV_D0(0); PV_D0(1); PV_D0(2); PV_D0(3);
#undef PV_D0
#undef TRRD
}

struct BlockRef { const bf16_t* Q; const bf16_t* K; const bf16_t* V; float* O; int P0; };
struct Seam { bf16x8 qr[8]; bf16x8 st_v0, st_v1, st_k0, st_k1; };
#define ROW(p, k0, rr) ((p) + (size_t)((k0) + (rr)) * LDK + sc)
#define VMW() asm volatile("s_waitcnt vmcnt(0)" ::: "memory")
#define VMWN(n) asm volatile("s_waitcnt vmcnt(%0)" :: "i"(n) : "memory")
#define SLOAD_H(Kp, Vp, k0) do { S.st_v0 = load8(ROW(Vp, k0, sr)); S.st_v1 = load8(ROW(Vp, k0, 32 + sr));              \
                         S.st_k0 = load8(ROW(Kp, k0, sr)); S.st_k1 = load8(ROW(Kp, k0, 32 + sr)); } while (0)
#define SWRITE_HK(bf) do { *(bf16x8*)(K_lds + (bf) * SHM_K + kws) = S.st_k0; *(bf16x8*)(K_lds + (bf) * SHM_K + kws + 32 * 256) = S.st_k1; } while (0)
#define SWRITE_HV(bf) do { *(bf16x8*)(V_lds + (bf) * SHM_V + vst0) = S.st_v0; *(bf16x8*)(V_lds + (bf) * SHM_V + vst1) = S.st_v1; } while (0)
#define SWRITE_H(bf) do { SWRITE_HV(bf); SWRITE_HK(bf); } while (0)
__device__ __forceinline__ void prime(const BlockRef& cur, char* lds, Seam& S, int wave_id) {
    int tid_ = wave_id * 64 + hw_lane(); asm volatile("" : "+v"(tid_));
    const int tid = tid_, wid = __builtin_amdgcn_readfirstlane(tid >> 6), lane = tid & 63, r32 = lane & 31, hi = lane >> 5;
    const int sr = tid >> 4, sc = (tid & 15) * 8, kws = KSWZ(sr, sc * 2); char* K_lds = lds + 2 * SHM_V;
#pragma unroll
    for (int d0 = 0; d0 < 8; ++d0) S.qr[d0] = load8(cur.Q + (size_t)(wid * QBLK + r32) * LDQ + d0 * 16 + hi * 8);
    SLOAD_H(cur.K, cur.V, 0); VMW(); SWRITE_HK(0);
    __syncthreads();
}
__device__ __forceinline__ void block(const BlockRef& cur, const BlockRef& nxt, char* lds, Seam& S, int wave_id) {
    int tid_ = wave_id * 64 + hw_lane(); asm volatile("" : "+v"(tid_));
    const int tid = tid_, wid = __builtin_amdgcn_readfirstlane(tid >> 6), lane = tid & 63, r32 = lane & 31, hi = lane >> 5;
    const int NT = cur.P0 / KVBLK + 4;
    const int qlo = cur.P0 + wid * QBLK;
    const int qend = qlo | 63;
    char* V_lds = lds; char* K_lds = lds + 2 * SHM_V;
    float* ws = (float*)(lds + 2 * SHM_V + 2 * SHM_K) + wid * 64; float* li_l = ws, * al_l = ws + 32;
    float m_reg = -1e30f, l_reg = 0; f32x16 o[4] = {};
    const int sr = tid >> 4, sc = (tid & 15) * 8, vst0 = v_st(sr, sc), vst1 = v_st(32 + sr, sc), kws = KSWZ(sr, sc * 2);
    const int vb0 = (int)(uintptr_t)V_lds + v_rd_base(lane);
    const bf16_t* Kh = cur.K; const bf16_t* Vh = cur.V;
#define RESC(a) do { if (__any((a) < 1.f)) { if (hi == 0) al_l[r32] = (a); asm volatile("s_waitcnt lgkmcnt(0)" ::: "memory");              \
                     for (int d_ = 0; d_ < 4; ++d_) for (int r = 0; r < 16; ++r) o[d_][r] *= al_l[crow(r, hi)]; } } while (0)
#define KBASE(t) ((t) * KVBLK)
#define MASKT(P0_, P1_, t) do { if (KBASE(t) > qend) { const float NEG_ = -__builtin_inff(); _Pragma("unroll") for (int r_ = 0; r_ < 16; ++r_) { P0_[r_] = NEG_; P1_[r_] = NEG_; } } } while (0)
    constexpr int NQL = 8;
#define SEAM_K0() do { VMWN(NQL); SWRITE_HK(0); SBAR(); } while (0)
    f32x16 pA0, pA1, pB0, pB1; float mnA, mnB, alA, alB; bf16x8 pa0, pa1, pa2, pa3;
    SWRITE_HV(0); SBAR();
    if (NT > 1) { SLOAD_H(Kh, Vh, KBASE(1)); }
    SBAR(); qkt<0>(pA0, pA1, K_lds, r32, hi, S.qr);
    MASKT(pA0, pA1, 0); partialSM(pA0, pA1, m_reg, mnA, alA);
    if (NT > 1) { VMW(); SWRITE_H(1); }
    __syncthreads();
#define HALF_STEP(PX0, PX1, mnX, alX, PY0, PY1, alY, t, KB, VB, SB) do {                                                      \
        SBAR(); qkt<KB>(PX0, PX1, K_lds, r32, hi, S.qr);                                                                      \
        finishSM(PY0, PY1, alY, l_reg, pa0, pa1, pa2, pa3); SBAR();                                                           \
        if ((t) + 1 < NT) { SLOAD_H(Kh, Vh, KBASE((t) + 1)); SBAR(); }                                                        \
        pv_tile<VB>(o, vb0, pa0, pa1, pa2, pa3); MASKT(PX0, PX1, (t)); partialSM(PX0, PX1, m_reg, mnX, alX);                  \
        __syncthreads();                                                                                                      \
        if ((t) + 1 < NT) { VMW(); SWRITE_H(SB); }                                                                            \
        RESC(alX); __syncthreads(); } while (0)
    for (int t = 1; t + 1 < NT; t += 2) {
        HALF_STEP(pB0, pB1, mnB, alB, pA0, pA1, alA, t, 1, 0, 0);
        HALF_STEP(pA0, pA1, mnA, alA, pB0, pB1, alB, t + 1, 0, 1, 1);
    }
    SBAR(); qkt<1>(pB0, pB1, K_lds, r32, hi, S.qr); SBAR();
    SLOAD_H(nxt.K, nxt.V, 0); SBAR();
#pragma unroll
    for (int d0 = 0; d0 < 8; ++d0) S.qr[d0] = load8(nxt.Q + (size_t)(wid * QBLK + r32) * LDQ + d0 * 16 + hi * 8);
    SBAR();
    finishSM(pA0, pA1, alA, l_reg, pa0, pa1, pa2, pa3); SBAR();
    pv_tile<0>(o, vb0, pa0, pa1, pa2, pa3);
    MASKT(pB0, pB1, NT - 1); partialSM(pB0, pB1, m_reg, mnB, alB); __syncthreads(); RESC(alB);
    finishSM(pB0, pB1, alB, l_reg, pa0, pa1, pa2, pa3); SBAR(); pv_tile<1>(o, vb0, pa0, pa1, pa2, pa3);
    SBAR(); SEAM_K0();
    if (hi == 0) li_l[r32] = l_reg; asm volatile("s_waitcnt lgkmcnt(0)" ::: "memory");
    float rli[16];
#pragma unroll
    for (int r = 0; r < 16; ++r) rli[r] = __builtin_amdgcn_rcpf(li_l[crow(r, hi)]);
    float* Ow = cur.O + (size_t)(wid * QBLK) * LDO;
#pragma unroll
    for (int r = 0; r < 16; ++r) { const int orow = crow(r, hi);
#pragma unroll
        for (int d0 = 0; d0 < 4; ++d0) Ow[(size_t)orow * LDO + d0 * 32 + r32] = o[d0][r] * rli[r]; }
    __syncthreads();
#undef RESC
#undef KBASE
#undef MASKT
#undef SEAM_K0
#undef HALF_STEP
}
#undef ROW
#undef VMW
#undef VMWN
#undef SLOAD_H
#undef SWRITE_HK
#undef SWRITE_HV
#undef SWRITE_H
#undef KSWZ
#undef SBAR
}
#define XB_TMO      128
#define XB_XCNT(j)  (256  + 64 * (j))
#define XB_XSUB(j)  (1280 + 64 * (j))
#define XB_XGEN(j)  (2304 + 64 * (j))
#define XB_TOP      3328
#define XB_TOPGEN   3392
#define XCD_BAR_WORDS 3456
#define XB_SPIN_CAP (1u << 18)

__device__ __forceinline__ unsigned xb_ld(unsigned* p)              { return __hip_atomic_load(p, __ATOMIC_RELAXED, __HIP_MEMORY_SCOPE_AGENT); }
__device__ __forceinline__ unsigned xb_add(unsigned* p, unsigned v) { return __hip_atomic_fetch_add(p, v, __ATOMIC_RELAXED, __HIP_MEMORY_SCOPE_AGENT); }
__device__ __forceinline__ unsigned xb_xcc_id() { return (unsigned)__builtin_amdgcn_s_getreg((3 << 11) | 20) & 0xFu; }
#define XB_SPIN(cond, bar) do { unsigned _sp = 0; while (cond) { __builtin_amdgcn_s_sleep(1); \
    if ((++_sp & 255u) == 0u) { if (xb_ld(&(bar)[XB_TMO])) break; if (_sp > XB_SPIN_CAP) { atomicAdd(&(bar)[XB_TMO], 1u); break; } } } } while (0)

struct XcdBarrier {
    unsigned* bar; unsigned x;
    volatile LAS unsigned* st;
};

__device__ __forceinline__ XcdBarrier xcd_barrier_post(unsigned* bar, volatile LAS unsigned* st) {
    XcdBarrier b; b.bar = bar; b.x = xb_xcc_id(); b.st = st;
    if (threadIdx.x == 0) (void)xb_add(&bar[XB_XCNT(b.x)], 1u);
    return b;
}
__device__ __forceinline__ void xcd_barrier_complete(unsigned* bar, unsigned x, unsigned& nloc, unsigned& nx) {
    const unsigned G = gridDim.x * gridDim.y * gridDim.z;
    unsigned sum, cnt, mine, sp = 0u;
    for (;;) {
        sum = 0u; cnt = 0u; mine = 0u;
#pragma unroll
        for (unsigned j = 0; j < 16; ++j) { const unsigned c = xb_ld(&bar[XB_XCNT(j)]); sum += c; cnt += (c > 0u) ? 1u : 0u; mine = (j == x) ? c : mine; }
        if (sum == G) break;
        __builtin_amdgcn_s_sleep(1);
        if ((++sp & 255u) == 0u) { if (xb_ld(&bar[XB_TMO])) break; if (sp > XB_SPIN_CAP) { atomicAdd(&bar[XB_TMO], 1u); break; } }
    }
    nloc = mine > 0u ? mine : 1u; nx = cnt > 0u ? cnt : 1u;
}

__device__ __forceinline__ void xcd_barrier(const XcdBarrier& b) {
    asm volatile("s_waitcnt vmcnt(0)" ::: "memory");
    __syncthreads();
    if (threadIdx.x == 0) {
        unsigned* bar = b.bar;
        __builtin_amdgcn_s_waitcnt(0);
        unsigned nloc = b.st[0], nx = b.st[1];
        if (nloc == 0u) { xcd_barrier_complete(bar, b.x, nloc, nx); b.st[0] = nloc; b.st[1] = nx; }
        const unsigned old = xb_add(&bar[XB_XSUB(b.x)], 1u);
        const unsigned gen = old / nloc;
        if (old + 1u == (gen + 1u) * nloc) {
            __builtin_amdgcn_fence(__ATOMIC_RELEASE, "agent");
            asm volatile("s_waitcnt vmcnt(0)" ::: "memory");
            const unsigned og = xb_add(&bar[XB_TOP], 1u);
            const unsigned tg = og / nx;
            if (og + 1u == (tg + 1u) * nx) xb_add(&bar[XB_TOPGEN], 1u);
            else XB_SPIN(xb_ld(&bar[XB_TOPGEN]) == tg, bar);
            __builtin_amdgcn_fence(__ATOMIC_ACQUIRE, "agent");
            xb_add(&bar[XB_XGEN(b.x)], 1u);
            asm volatile("s_waitcnt vmcnt(0)" ::: "memory");
        } else {
            XB_SPIN(xb_ld(&bar[XB_XGEN(b.x)]) == gen, bar);
            __builtin_amdgcn_fence(__ATOMIC_ACQUIRE, "agent");
            asm volatile("s_waitcnt vmcnt(0)" ::: "memory");
        }
    }
    __syncthreads();
}
constexpr size_t MiB = 1u << 20;
constexpr size_t WS_CTL = 0, CTL_ZERO_BYTES = 1 * MiB;
constexpr size_t WS_WTIN = 2 * MiB;
constexpr size_t WS_WTOUT = WS_WTIN + (size_t)DEPTH * NPAD * DM * 2;
constexpr size_t WS_WUVT = WS_WTOUT + (size_t)DEPTH * DM * DM * 2;
constexpr size_t WS_XB = WS_WUVT + 2 * MiB;
constexpr size_t WS_XF = WS_XB + (size_t)SEQ * DM * 2;
constexpr size_t WS_H = WS_XF + (size_t)SEQ * DM * 4;
constexpr size_t WS_O = WS_H + (size_t)SEQ * NPAD * 2;
constexpr size_t WS_CN = WS_O + (size_t)SEQ * DM * 2;
constexpr size_t WS_IKN = WS_CN + (size_t)SEQ * 256 * 2;
constexpr size_t WS_KDT = WS_IKN + (size_t)SEQ * 64 * 2;
constexpr size_t WS_DEC = WS_KDT + (size_t)NCHUNK * 1024 * 64 * 2;
constexpr size_t WS_VT = WS_DEC + (size_t)NCHUNK * 1024 * 4;
constexpr size_t WS_OA = WS_VT + (size_t)NCHUNK * 2048 * 64 * 2;
constexpr size_t WS_OD = WS_OA + (size_t)SEQ * 2048 * 4;
constexpr size_t WS_END = WS_OD + (size_t)SEQ * 2048 * 4;
constexpr int CW_TMO = 0;
constexpr int CW_BAR = 4096, BAR_STRIDE = 4096;
constexpr int CW_Q = 200000;
static_assert((CW_Q + 64 * 16 + 64) * 4 <= (int)CTL_ZERO_BYTES && CW_BAR + 32 * BAR_STRIDE <= CW_Q, "CTL map");
constexpr int NWAVES = 8;
constexpr int WREG = 18432;
constexpr int MISC_OFF = NWAVES * WREG;
constexpr int LDS_BYTES = MISC_OFF + 512;
static_assert(pg8::STAGE_BYTES <= MISC_OFF && dattn::LDS_BYTES <= MISC_OFF, "LDS map");

#define LDS_WAIT() asm volatile("s_waitcnt lgkmcnt(0)" ::: "memory")
#define VM_WAIT() asm volatile("s_waitcnt vmcnt(0)" ::: "memory")
typedef __bf16 bf16x2v __attribute__((ext_vector_type(2)));
typedef float f32x2 __attribute__((ext_vector_type(2)));
__device__ __forceinline__ unsigned cvtpk_c(float lo, float hi) { f32x2 v = {lo, hi}; bf16x2v b = __builtin_convertvector(v, bf16x2v); return __builtin_bit_cast(unsigned, b); }
__device__ __forceinline__ float bf2f(unsigned b) { return __uint_as_float(b << 16); }
__device__ __forceinline__ float bflo(unsigned w) { return __uint_as_float(w << 16); }
__device__ __forceinline__ float bfhi(unsigned w) { return __uint_as_float(w & 0xffff0000u); }
__device__ __forceinline__ bf16x8 pack8f(float a0, float a1, float a2, float a3, float a4, float a5, float a6, float a7) {
    u32x4 w = {cvtpk_c(a0, a1), cvtpk_c(a2, a3), cvtpk_c(a4, a5), cvtpk_c(a6, a7)}; return __builtin_bit_cast(bf16x8, w); }
__device__ __forceinline__ float bperm_f(int src_lane, float v) { return __int_as_float(__builtin_amdgcn_ds_bpermute(src_lane << 2, __float_as_int(v))); }
__device__ __forceinline__ float wave_sum(float v) {
    const int ln = hw_lane();
#pragma unroll
    for (int o = 1; o < 64; o <<= 1) v += bperm_f(ln ^ o, v);
    return v;
}
__device__ __forceinline__ void wave_sum2(float& a, float& b) {
    const int ln = hw_lane();
#pragma unroll
    for (int o = 1; o < 64; o <<= 1) { const float ta = bperm_f(ln ^ o, a), tb = bperm_f(ln ^ o, b); a += ta; b += tb; }
}
__device__ __forceinline__ float silu(float x) { return x / (1.f + __expf(-x)); }
#define MFMA16(a, b, c) __builtin_amdgcn_mfma_f32_16x16x32_bf16((a), (b), (c), 0, 0, 0)
#define MFMA32(a, b, c) __builtin_amdgcn_mfma_f32_32x32x16_bf16((a), (b), (c), 0, 0, 0)

struct Frame {
    LAS unsigned char* lds;
    volatile LAS unsigned* MISC;
    gu32* ctl;
    unsigned char* ws;
    int wave, vcu, G;
};
#define B_WTIN(F)  ((bf16_t*)((F).ws + WS_WTIN))
#define B_WTOUT(F) ((bf16_t*)((F).ws + WS_WTOUT))
#define B_WUVT(F)  ((bf16_t*)((F).ws + WS_WUVT))
#define B_XB(F)    ((bf16_t*)((F).ws + WS_XB))
#define B_XF(F)    ((float*)((F).ws + WS_XF))
#define B_H(F)     ((bf16_t*)((F).ws + WS_H))
#define B_O(F)     ((bf16_t*)((F).ws + WS_O))
#define B_CN(F)    ((bf16_t*)((F).ws + WS_CN))
#define B_IKN(F)   ((bf16_t*)((F).ws + WS_IKN))
#define B_KDT(F)   ((bf16_t*)((F).ws + WS_KDT))
#define B_DEC(F)   ((float*)((F).ws + WS_DEC))
#define B_VT(F)    ((bf16_t*)((F).ws + WS_VT))
#define B_OA(F)    ((float*)((F).ws + WS_OA))
#define B_OD(F)    ((float*)((F).ws + WS_OD))
__device__ __forceinline__ int grab(Frame& F, int qidx) {
    if ((F.wave * 64 + hw_lane()) == 0) F.MISC[2] = __hip_atomic_fetch_add((unsigned*)(F.ctl + CW_Q + 64 * qidx), 1u, __ATOMIC_RELAXED, __HIP_MEMORY_SCOPE_AGENT);
    __syncthreads(); const int v = (int)F.MISC[2]; __syncthreads(); return v;
}
template <bool REMAP>
__device__ __forceinline__ void tr_item(const float* W, int K, int ldw, bf16_t* WT, int nblk, LAS float* scr, int item, int lane) {
    const int kb = item / nblk, nb = item - kb * nblk, k0 = 64 * kb, n0 = 32 * nb;
    const int sc = REMAP ? srccol(n0 + (lane & 31)) : n0 + (lane & 31);
#pragma unroll 8
    for (int i = 0; i < 32; ++i) { const int kk = 2 * i + (lane >> 5); scr[kk * 33 + (lane & 31)] = sc >= 0 ? W[(size_t)(k0 + kk) * ldw + sc] : 0.f; }
    LDS_WAIT();
    const int c = lane & 7;
#pragma unroll
    for (int j = 0; j < 4; ++j) { const int nn = (lane >> 3) + 8 * j; const LAS float* s = scr + (8 * c) * 33 + nn;
        u32x4 o; o.x = cvtpk_c(s[0 * 33], s[1 * 33]); o.y = cvtpk_c(s[2 * 33], s[3 * 33]); o.z = cvtpk_c(s[4 * 33], s[5 * 33]); o.w = cvtpk_c(s[6 * 33], s[7 * 33]);
        *(u32x4*)(WT + (size_t)(n0 + nn) * K + k0 + 8 * c) = o; }
    LDS_WAIT();
}
__device__ __forceinline__ void p0_prologue(Frame& F, const float* x_in, const float* w_in, const float* w_out, const float* w_uv) {
    LAS float* scr = (LAS float*)(F.lds + F.wave * 16384);
    const int gw = F.vcu * NWAVES + F.wave, NGW = F.G * NWAVES;
    constexpr int I_IN = (DM / 64) * (NPAD / 32), I_OUT = (DM / 64) * (DM / 32), I_UV = (256 / 64) * (128 / 32);
    constexpr int N_IN = DEPTH * I_IN, N_OUT = DEPTH * I_OUT, N_UV = DEPTH * 8 * I_UV;
    for (int it = gw; it < N_IN + N_OUT + N_UV; it += NGW) {
        int r = it;
        if (r < N_IN) { const int l = r / I_IN; r -= l * I_IN;
            tr_item<true>(w_in + (size_t)l * DM * NIN, DM, NIN, B_WTIN(F) + (size_t)l * NPAD * DM, NPAD / 32, scr, r, hw_lane()); continue; }
        r -= N_IN;
        if (r < N_OUT) { const int l = r / I_OUT; r -= l * I_OUT;
            tr_item<false>(w_out + (size_t)l * DM * DM, DM, DM, B_WTOUT(F) + (size_t)l * DM * DM, DM / 32, scr, r, hw_lane()); continue; }
        r -= N_OUT;
        { const int lh = r / I_UV; r -= lh * I_UV;
          tr_item<false>(w_uv + (size_t)lh * 256 * 128, 256, 128, B_WUVT(F) + (size_t)lh * 128 * 256, 128 / 32, scr, r, hw_lane()); }
    }
    const f32x4* xs = (const f32x4*)x_in;
    for (size_t i = (size_t)gw * 64 + hw_lane(); i < (size_t)SEQ * DM / 8; i += (size_t)NGW * 64) {
        const f32x4 a = xs[2 * i], b = xs[2 * i + 1];
        u32x4 o = {cvtpk_c(a[0], a[1]), cvtpk_c(a[2], a[3]), cvtpk_c(b[0], b[1]), cvtpk_c(b[2], b[3])};
        *(u32x4*)(B_XB(F) + 8 * i) = o;
    }
}

__device__ __forceinline__ void prep_phase(Frame& F, int l, const float* w_gate2, const float* b_gate, const float* kv_g, const float* ik_g, const float* ik_b) {
    int lane_ = hw_lane(); asm volatile("" : "+v"(lane_));
    const int gw = F.vcu * NWAVES + F.wave, NGW = F.G * NWAVES, lane = lane_;
    const bf16_t* H = B_H(F);
    {
        const float* kvg = kv_g + l * 256; const float* ikg = ik_g + l * 64; const float* ikb = ik_b + l * 64;
        const f32x4 g4 = *(const f32x4*)(kvg + 4 * lane); const float g1 = ikg[lane], b1 = ikb[lane];
        for (int t0 = gw; t0 < SEQ; t0 += 2 * NGW) {
            float v[2][4], x[2], ss[2];
#pragma unroll
            for (int k = 0; k < 2; ++k) { const bf16_t* hr = H + (size_t)(t0 + k * NGW) * NPAD;
                const u32x2 raw = *(const u32x2*)(hr + C_CKV + 4 * lane);
                v[k][0] = bflo(raw.x); v[k][1] = bfhi(raw.x); v[k][2] = bflo(raw.y); v[k][3] = bfhi(raw.y);
                x[k] = bf2f(hr[C_CIK + lane]);
                ss[k] = (v[k][0] * v[k][0] + v[k][1] * v[k][1]) + (v[k][2] * v[k][2] + v[k][3] * v[k][3]); }
            float mu[2] = {x[0], x[1]};
            wave_sum2(ss[0], ss[1]); wave_sum2(mu[0], mu[1]);
            float dv[2], var[2];
#pragma unroll
            for (int k = 0; k < 2; ++k) { dv[k] = x[k] - mu[k] * (1.f / 64.f); var[k] = dv[k] * dv[k]; }
            wave_sum2(var[0], var[1]);
#pragma unroll
            for (int k = 0; k < 2; ++k) { const int t = t0 + k * NGW;
                const float rs = rsqrtf(ss[k] * (1.f / 256.f) + 1e-6f);
                u32x2 o; o.x = cvtpk_c(v[k][0] * rs * g4[0], v[k][1] * rs * g4[1]); o.y = cvtpk_c(v[k][2] * rs * g4[2], v[k][3] * rs * g4[3]);
                *(u32x2*)(B_CN(F) + (size_t)t * 256 + 4 * lane) = o;
                const float y = dv[k] * rsqrtf(var[k] * (1.f / 64.f) + 1e-5f) * g1 + b1;
                B_IKN(F)[(size_t)t * 64 + lane] = (bf16_t)(cvtpk_c(y, 0.f) & 0xffffu); }
        }
    }
    {
        LAS float* aas = (LAS float*)(F.lds + F.wave * 16384);
        const float* W2 = w_gate2 + (size_t)l * 16 * 1024; const float* BG = b_gate + (size_t)l * 1024;
        for (int u = gw; u < NCHUNK * 16; u += NGW) {
            const int c = u >> 4, dk = (u & 15) * 64 + lane;
            { const bf16_t* ap = H + (size_t)(64 * c + lane) * NPAD + C_AA;
              const bf16x8 a0 = *(const bf16x8*)ap, a1 = *(const bf16x8*)(ap + 8);
#pragma unroll
              for (int j = 0; j < 8; ++j) { aas[lane * 16 + j] = bf2f((unsigned short)a0[j]); aas[lane * 16 + 8 + j] = bf2f((unsigned short)a1[j]); } }
            float w2[16];
#pragma unroll
            for (int r = 0; r < 16; ++r) w2[r] = W2[r * 1024 + dk];
            const float bgv = BG[dk];
            LDS_WAIT();
            float la[64]; float total = 0.f;
#pragma unroll
            for (int t = 0; t < 64; ++t) {
                float z = bgv;
#pragma unroll
                for (int r = 0; r < 16; ++r) z += aas[t * 16 + r] * w2[r];
                la[t] = (fminf(z, 0.f) - __logf(1.f + __expf(-fabsf(z)))) * (1.f / 16.f);
                total += la[t];
            }
            B_DEC(F)[(size_t)c * 1024 + dk] = __expf(total);
            float run = 0.f;
#pragma unroll
            for (int t8 = 0; t8 < 8; ++t8) {
                float kd[8];
#pragma unroll
                for (int j = 0; j < 8; ++j) { const int t = 8 * t8 + j;
                    run += la[t];
                    kd[j] = bf2f(H[(size_t)(64 * c + t) * NPAD + C_AK + dk]) * __expf(total - run); }
                *(bf16x8*)(B_KDT(F) + ((size_t)c * 1024 + dk) * 64 + 8 * t8) = pack8f(kd[0], kd[1], kd[2], kd[3], kd[4], kd[5], kd[6], kd[7]);
            }
            LDS_WAIT();
        }
    }
    for (int u = gw; u < NCHUNK * 16; u += NGW) {
        const int c = u >> 4, dv = (u & 15) * 128 + 2 * lane;
#pragma unroll
        for (int t8 = 0; t8 < 8; ++t8) {
            unsigned w[8];
#pragma unroll
            for (int j = 0; j < 8; ++j) w[j] = *(const unsigned*)(H + (size_t)(64 * c + 8 * t8 + j) * NPAD + C_AV + dv);
            u32x4 lo = {(w[0] & 0xffffu) | (w[1] << 16), (w[2] & 0xffffu) | (w[3] << 16), (w[4] & 0xffffu) | (w[5] << 16), (w[6] & 0xffffu) | (w[7] << 16)};
            u32x4 hi = {(w[0] >> 16) | (w[1] & 0xffff0000u), (w[2] >> 16) | (w[3] & 0xffff0000u), (w[4] >> 16) | (w[5] & 0xffff0000u), (w[6] >> 16) | (w[7] & 0xffff0000u)};
            *(u32x4*)(B_VT(F) + ((size_t)c * 2048 + dv) * 64 + 8 * t8) = lo;
            *(u32x4*)(B_VT(F) + ((size_t)c * 2048 + dv + 1) * 64 + 8 * t8) = hi;
        }
    }
}

__device__ __forceinline__ void post_phase(Frame& F, int l, float lam_init, const float* gla_g, const float* dlam, const float* diff_g) {
    int lane_ = hw_lane(); asm volatile("" : "+v"(lane_));
    const int gw = F.vcu * NWAVES + F.wave, NGW = F.G * NWAVES, lane = lane_;
    float lam;
    { const float* lp = dlam + (size_t)l * 512;
      const float p0 = lp[lane] * lp[128 + lane] + lp[64 + lane] * lp[192 + lane];
      const float p1 = lp[256 + lane] * lp[384 + lane] + lp[320 + lane] * lp[448 + lane];
      lam = expf(wave_sum(p0)) - expf(wave_sum(p1)) + lam_init; }
    { const float* g = gla_g + (size_t)l * 512;
      const f32x4 ga = *(const f32x4*)(g + 8 * lane), gb = *(const f32x4*)(g + 8 * lane + 4);
      for (int u0 = gw; u0 < SEQ * 4; u0 += 2 * NGW) {
          f32x4 a[2], b[2]; u32x4 gr[2]; float ss[2];
#pragma unroll
          for (int k = 0; k < 2; ++k) { const int u = u0 + k * NGW, t = u >> 2, hd = u & 3;
              const float* src = B_OA(F) + (size_t)t * 2048 + hd * 512 + 8 * lane;
              a[k] = *(const f32x4*)src; b[k] = *(const f32x4*)(src + 4);
              gr[k] = *(const u32x4*)(B_H(F) + (size_t)t * NPAD + C_AG + hd * 512 + 8 * lane);
              ss[k] = (a[k][0] * a[k][0] + a[k][1] * a[k][1]) + (a[k][2] * a[k][2] + a[k][3] * a[k][3]) + (b[k][0] * b[k][0] + b[k][1] * b[k][1]) + (b[k][2] * b[k][2] + b[k][3] * b[k][3]); }
          wave_sum2(ss[0], ss[1]);
#pragma unroll
          for (int k = 0; k < 2; ++k) { const int u = u0 + k * NGW, t = u >> 2, hd = u & 3;
              const float rs = rsqrtf(ss[k] * (1.f / 512.f) + 1e-6f);
              u32x4 o;
              o.x = cvtpk_c(a[k][0] * rs * ga[0] * silu(bflo(gr[k].x)), a[k][1] * rs * ga[1] * silu(bfhi(gr[k].x)));
              o.y = cvtpk_c(a[k][2] * rs * ga[2] * silu(bflo(gr[k].y)), a[k][3] * rs * ga[3] * silu(bfhi(gr[k].y)));
              o.z = cvtpk_c(b[k][0] * rs * gb[0] * silu(bflo(gr[k].z)), b[k][1] * rs * gb[1] * silu(bfhi(gr[k].z)));
              o.w = cvtpk_c(b[k][2] * rs * gb[2] * silu(bflo(gr[k].w)), b[k][3] * rs * gb[3] * silu(bfhi(gr[k].w)));
              *(u32x4*)(B_O(F) + (size_t)t * DM + hd * 512 + 8 * lane) = o; }
      } }
    { const float* g = diff_g + (size_t)l * 256;
      const f32x4 g4 = *(const f32x4*)(g + 4 * lane); const float post = 1.f - lam_init;
      for (int u0 = gw; u0 < SEQ * 4; u0 += 2 * NGW) {
          f32x4 d[2]; u32x2 gr[2]; float ss[2];
#pragma unroll
          for (int k = 0; k < 2; ++k) { const int u = u0 + k * NGW, t = u >> 2, hd = u & 3;
              const float* src = B_OD(F) + (size_t)t * 2048 + hd * 512 + 4 * lane;
              const f32x4 a0 = *(const f32x4*)src, a1 = *(const f32x4*)(src + 256);
              gr[k] = *(const u32x2*)(B_H(F) + (size_t)t * NPAD + C_BG + hd * 256 + 4 * lane);
              d[k] = a0 - a1 * lam;
              ss[k] = (d[k][0] * d[k][0] + d[k][1] * d[k][1]) + (d[k][2] * d[k][2] + d[k][3] * d[k][3]); }
          wave_sum2(ss[0], ss[1]);
#pragma unroll
          for (int k = 0; k < 2; ++k) { const int u = u0 + k * NGW, t = u >> 2, hd = u & 3;
              const float rs = rsqrtf(ss[k] * (1.f / 256.f) + 1e-6f) * post;
              u32x2 o;
              o.x = cvtpk_c(d[k][0] * rs * g4[0] * silu(bflo(gr[k].x)), d[k][1] * rs * g4[1] * silu(bfhi(gr[k].x)));
              o.y = cvtpk_c(d[k][2] * rs * g4[2] * silu(bflo(gr[k].y)), d[k][3] * rs * g4[3] * silu(bfhi(gr[k].y)));
              *(u32x2*)(B_O(F) + (size_t)t * DM + 2048 + hd * 256 + 4 * lane) = o; }
      } }
}

__device__ __forceinline__ void ln_phase(Frame& F, int l, const float* ln_g, const float* ln_b, float* outp, bool dry) {
    int lane_ = hw_lane(); asm volatile("" : "+v"(lane_));
    const int gw = F.vcu * NWAVES + F.wave, NGW = F.G * NWAVES, lane = lane_;
    const float* g = ln_g + (size_t)l * DM; const float* b = ln_b + (size_t)l * DM;
    float* dst = dry ? B_OA(F) : ((l == DEPTH - 1) ? outp : B_XF(F));
    for (int t = gw; t < SEQ; t += NGW) {
        const f32x4* xr = (const f32x4*)(B_XF(F) + (size_t)t * DM) + lane;
        f32x4 v[16]; float s = 0.f;
#pragma unroll
        for (int j = 0; j < 16; ++j) { v[j] = xr[64 * j]; s += (v[j][0] + v[j][1]) + (v[j][2] + v[j][3]); }
        const float mean = wave_sum(s) * (1.f / DM); float s2 = 0.f;
#pragma unroll
        for (int j = 0; j < 16; ++j) { v[j] = v[j] - mean; s2 += (v[j][0] * v[j][0] + v[j][1] * v[j][1]) + (v[j][2] * v[j][2] + v[j][3] * v[j][3]); }
        const float rstd = rsqrtf(wave_sum(s2) * (1.f / DM) + 1e-5f);
        f32x4* orow = (f32x4*)(dst + (size_t)t * DM) + lane;
        u32x2* brow = (u32x2*)(B_XB(F) + (size_t)t * DM) + lane;
#pragma unroll
        for (int j = 0; j < 16; ++j) {
            const f32x4 gg = *((const f32x4*)g + lane + 64 * j), bb = *((const f32x4*)b + lane + 64 * j);
            const f32x4 y = v[j] * rstd * gg + bb;
            orow[64 * j] = y;
            u32x2 w; w.x = cvtpk_c(y[0], y[1]); w.y = cvtpk_c(y[2], y[3]); brow[64 * j] = w;
        }
    }
}
namespace gla {
constexpr int KD_ROW = 144, Q_ROW = 528, V_ROW = 144;
constexpr int L_KD = 0, L_Q = L_KD + 256 * KD_ROW, L_V = L_Q + 64 * Q_ROW, L_DEC = L_V + 128 * V_ROW, L_END = L_DEC + 1024;
}
static_assert(gla::L_END <= MISC_OFF, "GLA LDS map");
__device__ __forceinline__ void gla_unit(Frame& F, int unit) {
    using namespace gla;
    int tid_ = (F.wave * 64 + hw_lane()); asm volatile("" : "+v"(tid_));
    const int tid = tid_, lane = tid & 63, c16 = lane & 15, g = lane >> 4, wave = F.wave;
    const int head = unit >> 2, blk = unit & 3;
    const int dv0 = 128 * blk + 16 * wave;
    LAS unsigned char* lds = F.lds;
    f32x4 S[16];
#pragma unroll
    for (int T = 0; T < 16; ++T) S[T] = (f32x4){0.f, 0.f, 0.f, 0.f};
    const bf16_t* kd_g = B_KDT(F) + (size_t)head * 256 * 64 + (size_t)tid * 8;
    const bf16_t* q_g = B_H(F) + (size_t)(tid >> 5) * NPAD + C_AQ + head * 256 + (tid & 31) * 8;
    const bf16_t* v_g = B_VT(F) + ((size_t)head * 512 + 128 * blk) * 64 + (size_t)tid * 8;
    const float* d_g = B_DEC(F) + head * 256 + (tid & 63) * 4;
    const int kd_w = (tid >> 3) * KD_ROW + (tid & 7) * 16;
    const int q_w = (tid >> 5) * Q_ROW + (tid & 31) * 16;
    const int v_w = (tid >> 3) * V_ROW + (tid & 7) * 16;
    u32x4 skd[4], sq[4], sv[2]; f32x4 sd;
#define GLA_LOAD(c_) do { _Pragma("unroll") for (int i = 0; i < 4; ++i) skd[i] = *(const u32x4*)(kd_g + (size_t)(c_) * 1024 * 64 + i * 4096); \
        _Pragma("unroll") for (int i = 0; i < 4; ++i) sq[i] = *(const u32x4*)(q_g + (size_t)(64 * (c_) + 16 * i) * NPAD);                        \
        _Pragma("unroll") for (int i = 0; i < 2; ++i) sv[i] = *(const u32x4*)(v_g + (size_t)(c_) * 2048 * 64 + i * 4096);                        \
        if (tid < 64) sd = *(const f32x4*)(d_g + (size_t)(c_) * 1024); } while (0)
#define GLA_WRITE() do { _Pragma("unroll") for (int i = 0; i < 4; ++i) *(LAS u32x4*)(lds + L_KD + kd_w + i * 64 * KD_ROW) = skd[i];            \
        _Pragma("unroll") for (int i = 0; i < 4; ++i) *(LAS u32x4*)(lds + L_Q + q_w + i * 16 * Q_ROW) = sq[i];                                   \
        _Pragma("unroll") for (int i = 0; i < 2; ++i) *(LAS u32x4*)(lds + L_V + v_w + i * 64 * V_ROW) = sv[i];                                   \
        if (tid < 64) *(LAS f32x4*)(lds + L_DEC + tid * 16) = sd; } while (0)
    const int a_rd = L_KD + c16 * KD_ROW + 16 * g;
    const int b_rd = L_V + (16 * wave + c16) * V_ROW + 16 * g;
    const int q_rd = L_Q + c16 * Q_ROW + 8 * g;
    const int d_rd = L_DEC + 16 * g;
    float* o_l = B_OA(F) + (size_t)(4 * g) * 2048 + head * 512 + dv0 + c16;
    GLA_LOAD(0);
    __syncthreads();
    GLA_WRITE();
    for (int c = 0; c < NCHUNK; ++c) {
        __syncthreads();
        if (c + 1 < NCHUNK) GLA_LOAD(c + 1);
        const bf16x8 vb0 = *(const LAS bf16x8*)(lds + b_rd), vb1 = *(const LAS bf16x8*)(lds + b_rd + 64);
#pragma unroll
        for (int T4 = 0; T4 < 4; ++T4) {
            bf16x8 a[4][2]; f32x4 d4[4];
#pragma unroll
            for (int i = 0; i < 4; ++i) { const int T = 4 * T4 + i;
                a[i][0] = *(const LAS bf16x8*)(lds + a_rd + T * 16 * KD_ROW); a[i][1] = *(const LAS bf16x8*)(lds + a_rd + T * 16 * KD_ROW + 64);
                d4[i] = *(const LAS f32x4*)(lds + d_rd + 64 * T); }
#pragma unroll
            for (int i = 0; i < 4; ++i) { const int T = 4 * T4 + i;
                f32x4 acc = (f32x4){0.f, 0.f, 0.f, 0.f};
                acc = MFMA16(a[i][0], vb0, acc); acc = MFMA16(a[i][1], vb1, acc);
                S[T] = S[T] * d4[i] + acc; }
        }
        bf16x8 sb[8];
#pragma unroll
        for (int s = 0; s < 8; ++s) sb[s] = pack8f(S[2 * s][0], S[2 * s][1], S[2 * s][2], S[2 * s][3], S[2 * s + 1][0], S[2 * s + 1][1], S[2 * s + 1][2], S[2 * s + 1][3]);
#pragma unroll
        for (int tt = 0; tt < 4; ++tt) {
            u32x2 ql[8], qh[8];
#pragma unroll
            for (int s = 0; s < 8; ++s) { ql[s] = *(const LAS u32x2*)(lds + q_rd + tt * 16 * Q_ROW + 64 * s); qh[s] = *(const LAS u32x2*)(lds + q_rd + tt * 16 * Q_ROW + 64 * s + 32); }
            f32x4 acc = (f32x4){0.f, 0.f, 0.f, 0.f};
#pragma unroll
            for (int s = 0; s < 8; ++s) { const u32x4 aw = {ql[s].x, ql[s].y, qh[s].x, qh[s].y}; acc = MFMA16(__builtin_bit_cast(bf16x8, aw), sb[s], acc); }
            float* op = o_l + (size_t)(64 * c + 16 * tt) * 2048;
#pragma unroll
            for (int r = 0; r < 4; ++r) op[(size_t)r * 2048] = acc[r] * 0.0625f;
        }
        __syncthreads();
        if (c + 1 < NCHUNK) GLA_WRITE();
    }
#undef GLA_LOAD
#undef GLA_WRITE
}
__device__ __forceinline__ unsigned f2key(float s) { const unsigned b = __float_as_uint(s); return b ^ ((b >> 31) ? 0xFFFFFFFFu : 0x80000000u); }
__device__ __forceinline__ unsigned half_of(unsigned long long b, int hh) { return hh ? (unsigned)(b >> 32) : (unsigned)b; }
template <int EPL, int NB>
__device__ __forceinline__ void compactK(LAS unsigned* cv, int& cnt, unsigned& thr, int lane32, int hh) {
    unsigned k[EPL];
#pragma unroll
    for (int i = 0; i < EPL; ++i) { const int e = lane32 + 32 * i; const unsigned v = cv[e]; k[i] = (e < cnt) ? v : 0u; }
    unsigned T = 0u;
    for (int b = 31; b >= 32 - NB; --b) {
        const unsigned cand = T | (1u << b); int clo = 0, chi = 0;
#pragma unroll
        for (int i = 0; i < EPL; ++i) { const unsigned long long m = __ballot(k[i] >= cand); clo += __popc((unsigned)m); chi += __popc((unsigned)(m >> 32)); }
        if ((hh ? chi : clo) >= 256) T = cand;
        if (NB == 32 && clo == 256 && chi == 256) break;
    }
    const unsigned ltm = (1u << lane32) - 1u;
    int kept = 0;
#pragma unroll
    for (int i = 0; i < EPL; ++i) {
        const bool keep = (k[i] >= T) && (k[i] != 0u);
        const unsigned mk = half_of(__ballot(keep), hh);
        const int pos = kept + __popc(mk & ltm);
        if (keep) cv[pos] = k[i];
        kept += __popc(mk);
    }
    cnt = kept; thr = (NB == 32) ? T : (T ? T - 1u : 0u);
}
__device__ __forceinline__ int goff(int row, int ch) { return 512 * row + 16 * ((ch & 16) | ((ch & 15) ^ (((row & 3) << 2) | ((row >> 2) & 3)))); }

#ifndef SP_REPF
#define SP_REPF 1
#endif
#ifndef SP_REPB
#define SP_REPB 1
#endif
#ifndef SP_REPK
#define SP_REPK 1
#endif
#ifndef SP_REPX
#define SP_REPX 1
#endif
constexpr int SP_CAND = 0, SP_OL = 65536, SP_SEL = 131072, SP_END = SP_SEL + 8192;
static_assert(SP_END <= MISC_OFF, "sparse LDS map");
__device__ __forceinline__ void sparse_unit(Frame& F, int l, int unit) {
    int tid_ = (F.wave * 64 + hw_lane()); asm volatile("" : "+v"(tid_));
    const int tid = tid_, lane = tid & 63, wave = F.wave, r32 = lane & 31, hh = lane >> 5, c16 = lane & 15, g = lane >> 4;
    const int t0 = 16 * unit, tq0 = t0 + 2 * wave;
    const int N = 64 * ((t0 >> 6) + 1), nkb = N >> 5, ntile = (nkb + 7) >> 3;
    LAS unsigned char* reg = F.lds + SP_CAND + wave * 8192;
    LAS unsigned* cv = (LAS unsigned*)(reg + hh * 4096);
    LAS unsigned short* sel = (LAS unsigned short*)(F.lds + SP_SEL + wave * 1024);
    const bf16_t* H = B_H(F);
    int cnt = 0;
    {
        const int qq = (r32 >> 2) & 1, hd = (r32 & 3) + 4 * (r32 >> 3);
        bf16x8 A[4];
#pragma unroll
        for (int s = 0; s < 4; ++s) A[s] = *(const bf16x8*)(H + (size_t)(tq0 + qq) * NPAD + C_CIQ + hd * 64 + 16 * s + 8 * hh);
        float wv[16];
        { const bf16_t* wp = H + (size_t)(tq0 + hh) * NPAD + C_CIW;
          const bf16x8 w0 = *(const bf16x8*)wp, w1 = *(const bf16x8*)(wp + 8);
#pragma unroll
          for (int j = 0; j < 8; ++j) { wv[j] = bf2f((unsigned short)w0[j]) * 0.03125f; wv[8 + j] = bf2f((unsigned short)w1[j]) * 0.03125f; } }
        unsigned thr = 0u;
        const unsigned ltm = (1u << r32) - 1u;
        const bf16_t* kg = B_IKN(F) + (size_t)tid * 8;
        const int kw = SP_OL + (tid >> 3) * 128 + (((tid & 7) ^ ((tid >> 4) & 7)) * 16);
        int brd[4];
#pragma unroll
        for (int s = 0; s < 4; ++s) brd[s] = SP_OL + r32 * 128 + (((2 * s + hh) ^ ((r32 >> 1) & 7)) * 16);
        u32x4 stgA[4], stgB[4];
#define SP_KLOAD(st_, t_) do { _Pragma("unroll") for (int i = 0; i < 4; ++i) st_[i] = *(const u32x4*)(kg + (size_t)(t_) * 256 * 64 + i * 4096); } while (0)
#define SP_KWRITE(st_, b_) do { _Pragma("unroll") for (int i = 0; i < 4; ++i) *(LAS u32x4*)(F.lds + (b_) * 32768 + kw + i * 8192) = st_[i]; } while (0)
#define SP_TILE(tile_, b_) do {                                                                                                                  \
            { const bool full_ = __any(cnt > 640); if (lane == 0) F.MISC[16 + (b_) * 8 + wave] = full_ ? 1u : 0u; }                              \
            for (int rb_ = 0; rb_ < SP_REPB; ++rb_) __syncthreads();                                                                             \
            bool squeeze_ = __any(F.MISC[16 + (b_) * 8 + (lane & 7)] != 0u);                                                                     \
            const int nb_ = (nkb - 8 * (tile_)) < 8 ? (nkb - 8 * (tile_)) : 8;                                                                   \
            LAS unsigned char* tb_ = F.lds + (b_) * 32768;                                                                                       \
            for (int kb = 0; kb < nb_; kb += 2) {                                                                                                \
                if (squeeze_ || __any(cnt > 960)) { squeeze_ = false;                                                                            \
                    for (int rc_ = 0; rc_ < SP_REPK; ++rc_) compactK<32, 14>(cv, cnt, thr, r32, hh);                                             \
                    if (__any(cnt > 800)) compactK<32, 32>(cv, cnt, thr, r32, hh); }                                                             \
                float sc0 = 0.f, sc1 = 0.f;                                                                                                      \
                for (int rx_ = 0; rx_ < SP_REPX; ++rx_) {                                                                                        \
                bf16x8 B0[4], B1[4];                                                                                                             \
                _Pragma("unroll") for (int s = 0; s < 4; ++s) { B0[s] = *(const LAS bf16x8*)(tb_ + brd[s] + kb * 4096); B1[s] = *(const LAS bf16x8*)(tb_ + brd[s] + kb * 4096 + 4096); } \
                asm volatile("" : "+v"(B0[0]), "+v"(B0[1]), "+v"(B0[2]), "+v"(B0[3]), "+v"(B1[0]), "+v"(B1[1]), "+v"(B1[2]), "+v"(B1[3]));      \
                f32x16 acc0 = {}, acc1 = {};                                                                                                     \
                _Pragma("unroll") for (int s = 0; s < 4; ++s) { acc0 = MFMA32(A[s], B0[s], acc0); acc1 = MFMA32(A[s], B1[s], acc1); }            \
                { f32x2 s0_ = {0.f, 0.f}, s1_ = {0.f, 0.f};                                                                                      \
                _Pragma("unroll") for (int j = 0; j < 16; j += 2) { const int a0 = __float_as_int(acc0[j]), a1 = __float_as_int(acc0[j + 1]), b0 = __float_as_int(acc1[j]), b1 = __float_as_int(acc1[j + 1]); \
                    const f32x2 r0_ = {__int_as_float(a0 > 0 ? a0 : 0), __int_as_float(a1 > 0 ? a1 : 0)}, r1_ = {__int_as_float(b0 > 0 ? b0 : 0), __int_as_float(b1 > 0 ? b1 : 0)}; \
                    const f32x2 w_ = {wv[j], wv[j + 1]};                                                                                         \
                    s0_ = __builtin_elementwise_fma(r0_, w_, s0_); s1_ = __builtin_elementwise_fma(r1_, w_, s1_); }                               \
                sc0 = s0_[0] + s0_[1]; sc1 = s1_[0] + s1_[1]; }                                                                                  \
                asm volatile("" : "+v"(sc0), "+v"(sc1)); }                                                                                       \
                const unsigned ib_ = 16383u - (unsigned)(256 * (tile_) + 32 * kb + r32);                                                         \
                const unsigned key0 = (f2key(sc0) & 0xFFFFC000u) | ib_, key1 = (f2key(sc1) & 0xFFFFC000u) | (ib_ - 32u);                         \
                const bool f0 = key0 > thr, f1 = key1 > thr;                                                                                     \
                const unsigned m0 = half_of(__ballot(f0), hh), m1 = half_of(__ballot(f1), hh);                                                   \
                const int pos0 = cnt + __popc(m0 & ltm), pos1 = cnt + __popc(m0) + __popc(m1 & ltm);                                             \
                if (f0) cv[pos0] = key0;                                                                                                         \
                if (f1) cv[pos1] = key1;                                                                                                         \
                cnt += __popc(m0) + __popc(m1);                                                                                                  \
            } } while (0)
        SP_KLOAD(stgA, 0);
        SP_KWRITE(stgA, 0);
        __builtin_amdgcn_s_waitcnt(0x0F70);
        if (ntile > 1) SP_KLOAD(stgB, 1);
        for (int tile = 0; tile < ntile; tile += 2) {
            if (tile + 2 < ntile) SP_KLOAD(stgA, tile + 2);
            SP_TILE(tile, 0);
            if (tile + 1 >= ntile) break;
            SP_KWRITE(stgB, 1);
            if (tile + 3 < ntile) SP_KLOAD(stgB, tile + 3);
            SP_TILE(tile + 1, 1);
            if (tile + 2 < ntile) SP_KWRITE(stgA, 0);
        }
#undef SP_TILE
#undef SP_KLOAD
#undef SP_KWRITE
        if (__any(cnt > 256)) {
            compactK<32, 14>(cv, cnt, thr, r32, hh);
            if (__any(cnt > 512)) compactK<32, 32>(cv, cnt, thr, r32, hh); else compactK<16, 32>(cv, cnt, thr, r32, hh);
        }
#pragma unroll
        for (int i = 0; i < 8; ++i) { const int e = r32 + 32 * i; if (e < cnt) sel[hh * 256 + e] = (unsigned short)(16383u - (cv[e] & 0x3FFFu)); }
    }
    LDS_WAIT();
    __syncthreads();
    const int ns0 = __builtin_amdgcn_readlane(cnt, 0), ns1 = __builtin_amdgcn_readlane(cnt, 32);
    const int q4 = c16 >> 2, p4 = c16 & 3;
    const int trx = (q4 << 2) | g;
    const unsigned gb = (unsigned)(uintptr_t)reg;
    unsigned tra[8];
#pragma unroll
    for (int c = 0; c < 8; ++c) tra[c] = gb + 512 * (4 * g + q4) + 8 * (p4 & 1) + 16 * ((2 * c + (p4 >> 1)) ^ trx);
    LAS unsigned short* ol = (LAS unsigned short*)(F.lds + SP_OL + wave * 8192);
#pragma unroll 1
    for (int qi = 0; qi < 2; ++qi) {
        const int tq = tq0 + qi, ns = qi ? ns1 : ns0;
        bf16x8 qf[8];
#pragma unroll
        for (int s = 0; s < 8; ++s) { bf16x8 z = {}; qf[s] = (c16 < 8) ? *(const bf16x8*)(H + (size_t)tq * NPAD + C_CQ + c16 * 256 + 32 * s + 8 * g) : z; }
        f32x4 Z[16];
#pragma unroll
        for (int c = 0; c < 16; ++c) Z[c] = (f32x4){0.f, 0.f, 0.f, 0.f};
        float m = -1e30f, ls = 0.f;
        const int nsb = (ns + 15) >> 4;
        u32x4 datA[8], datB[8];
#define SP_GATHER(d_, j_) do { const int e_ = 16 * (j_) + c16; const int idx_ = (e_ < ns) ? (int)sel[qi * 256 + e_] : 0;                        \
            const bf16_t* rp_ = B_CN(F) + (size_t)idx_ * 256 + 8 * g;                                                                            \
            _Pragma("unroll") for (int i = 0; i < 8; ++i) d_[i] = *(const u32x4*)(rp_ + 32 * i); } while (0)
#define SP_GWRITE(d_) do { _Pragma("unroll") for (int i = 0; i < 8; ++i) *(LAS u32x4*)(reg + goff(c16, 4 * i + g)) = d_[i]; } while (0)
#define TRRD(dst, a, off) asm volatile("ds_read_b64_tr_b16 %0, %1 offset:%2" : "=&v"(dst) : "v"(a), "i"(off) : "memory")
#define SP_QK(d_) do { st = (f32x4){0.f, 0.f, 0.f, 0.f};                                                                                         \
            _Pragma("unroll") for (int s = 0; s < 8; ++s) st = MFMA16(__builtin_bit_cast(bf16x8, d_[s]), qf[s], st); } while (0)
#define SP_STEP(j_) do {                                                                                                                         \
            float mloc = -__builtin_inff();                                                                                                      \
            _Pragma("unroll") for (int r = 0; r < 4; ++r) { const int e = 16 * (j_) + 4 * g + r; const float v = (e < ns) ? st[r] * 0.0625f : -__builtin_inff(); st[r] = v; mloc = fmaxf(mloc, v); } \
            mloc = fmaxf(mloc, bperm_f(lane ^ 16, mloc)); mloc = fmaxf(mloc, bperm_f(lane ^ 32, mloc));                                                  \
            const float mn = fmaxf(m, mloc), alpha = __expf(m - mn);                                                                             \
            float ps = 0.f;                                                                                                                      \
            _Pragma("unroll") for (int r = 0; r < 4; ++r) { const float p = __expf(st[r] - mn); st[r] = p; ps += p; }                            \
            ps += bperm_f(lane ^ 16, ps); ps += bperm_f(lane ^ 32, ps);                                                                                  \
            ls = ls * alpha + ps; m = mn;                                                                                                        \
            const bf16x8 pa = pack8f(st[0], st[1], st[2], st[3], 0.f, 0.f, 0.f, 0.f);                                                            \
            if (__any(alpha < 1.f)) {                                                                                                            \
                float ar[4];                                                                                                                     \
                _Pragma("unroll") for (int r = 0; r < 4; ++r) ar[r] = bperm_f(4 * g + r, alpha);                                                  \
                _Pragma("unroll") for (int c = 0; c < 16; ++c) _Pragma("unroll") for (int r = 0; r < 4; ++r) Z[c][r] *= ar[r];                   \
            }                                                                                                                                    \
            _Pragma("unroll") for (int c = 0; c < 8; c += 2) {                                                                                   \
                s16x4 l0, l1, l2, l3;                                                                                                            \
                TRRD(l0, tra[c], 0); TRRD(l1, tra[c], 256); TRRD(l2, tra[c + 1], 0); TRRD(l3, tra[c + 1], 256);                                  \
                asm volatile("s_waitcnt lgkmcnt(0)" ::: "memory"); __builtin_amdgcn_sched_barrier(0);                                            \
                Z[c] = MFMA16(pa, ((bf16x8){l0[0], l0[1], l0[2], l0[3], 0, 0, 0, 0}), Z[c]);                                                     \
                Z[c + 8] = MFMA16(pa, ((bf16x8){l1[0], l1[1], l1[2], l1[3], 0, 0, 0, 0}), Z[c + 8]);                                             \
                Z[c + 1] = MFMA16(pa, ((bf16x8){l2[0], l2[1], l2[2], l2[3], 0, 0, 0, 0}), Z[c + 1]);                                             \
                Z[c + 9] = MFMA16(pa, ((bf16x8){l3[0], l3[1], l3[2], l3[3], 0, 0, 0, 0}), Z[c + 9]);                                             \
            } } while (0)
        f32x4 st;
        SP_GATHER(datA, 0);
        if (nsb > 1) SP_GATHER(datB, 1);
        for (int j = 0; j < nsb; j += 2) {
            SP_QK(datA); SP_GWRITE(datA);
            if (j + 2 < nsb) SP_GATHER(datA, j + 2);
            SP_STEP(j);
            if (j + 1 >= nsb) break;
            SP_QK(datB); SP_GWRITE(datB);
            if (j + 3 < nsb) SP_GATHER(datB, j + 3);
            SP_STEP(j + 1);
        }
#undef SP_QK
#undef SP_STEP
#undef TRRD
#undef SP_GATHER
#undef SP_GWRITE
        float inv[4];
#pragma unroll
        for (int r = 0; r < 4; ++r) inv[r] = 1.f / bperm_f(4 * g + r, ls);
        if (g < 2) {
#pragma unroll
            for (int c = 0; c < 16; ++c) {
                const int lat = 16 * c + c16;
#pragma unroll
                for (int r = 0; r < 4; ++r) ol[(qi * 8 + 4 * g + r) * 256 + lat] = (unsigned short)(cvtpk_c(Z[c][r] * inv[r], 0.f) & 0xffffu);
            }
        }
    }
    LDS_WAIT();
    __syncthreads();
    {
        const int hd = wave;
        bf16x8 A[8];
#pragma unroll
        for (int s = 0; s < 8; ++s) A[s] = *(const LAS bf16x8*)(F.lds + SP_OL + (c16 >> 1) * 8192 + (((c16 & 1) * 8 + hd) * 256 + 32 * s + 8 * g) * 2);
        const bf16_t* wb = B_WUVT(F) + ((size_t)(l * 8 + hd) * 128 + c16) * 256 + 8 * g;
#pragma unroll 1
        for (int n4 = 0; n4 < 2; ++n4) {
            bf16x8 b[4][8];
#pragma unroll
            for (int n = 0; n < 4; ++n)
#pragma unroll
                for (int s = 0; s < 8; ++s) b[n][s] = *(const bf16x8*)(wb + (size_t)(4 * n4 + n) * 16 * 256 + 32 * s);
#pragma unroll
            for (int n = 0; n < 4; ++n) {
                f32x4 acc = (f32x4){0.f, 0.f, 0.f, 0.f};
#pragma unroll
                for (int s = 0; s < 8; ++s) acc = MFMA16(A[s], b[n][s], acc);
#pragma unroll
                for (int r = 0; r < 4; ++r) { const int t = t0 + 4 * g + r; const int col = hd * 128 + 16 * (4 * n4 + n) + c16;
                    const float gt = bf2f(H[(size_t)t * NPAD + C_CG + col]);
                    B_O(F)[(size_t)t * DM + 3072 + col] = (bf16_t)(cvtpk_c(acc[r] * silu(gt), 0.f) & 0xffffu); }
            }
        }
    }
}
__device__ __forceinline__ dattn::BlockRef dattn_ref(const bf16_t* H, float* OD, int id) {
    dattn::BlockRef r; const int qb = 63 - (id >> 4), ph = id & 15, hd = ph >> 2, mp = (ph >> 1) & 1, e = ph & 1;
    r.Q = H + (size_t)(qb * 256) * NPAD + C_BQ + hd * 256 + mp * 128; r.K = H + C_BK + hd * 256 + mp * 128; r.V = H + C_BV + hd * 256 + e * 128;
    r.O = OD + (size_t)(qb * 256) * 2048 + hd * 512 + mp * 256 + e * 128; r.P0 = qb * 256; return r;
}
#ifndef REPBAR
#define REPBAR 1
#endif
#ifndef REPA
#define REPA 1
#endif
#ifndef REPB
#define REPB 1
#endif
#ifndef REPC
#define REPC 1
#endif
#ifndef REPG1
#define REPG1 1
#endif
#ifndef REPS
#define REPS 1
#endif
#ifndef MIXMASK
#define MIXMASK 7
#endif
__device__ __forceinline__ void mix_phase(Frame& F, int l) {
    if (MIXMASK & 1) for (int rep = 0; rep < REPA; ++rep) { const int qx = rep * 16 + l * 4 + 0;
        for (int u = grab(F, qx); u < 16; u = grab(F, qx)) gla_unit(F, u); }
    if (MIXMASK & 2) for (int rep = 0; rep < REPB; ++rep) { const int qx = rep * 16 + l * 4 + 1;
        int cur = grab(F, qx);
        if (cur < 1024) {
            dattn::Seam S;
            dattn::BlockRef rc = dattn_ref(B_H(F), B_OD(F), cur);
            dattn::prime(rc, (char*)F.lds, S, F.wave);
            for (;;) {
                const int nx = grab(F, qx); const bool last = nx >= 1024;
                const dattn::BlockRef rn = last ? rc : dattn_ref(B_H(F), B_OD(F), nx);
                dattn::block(rc, rn, (char*)F.lds, S, F.wave);
                if (last) break;
                rc = rn;
            }
            VM_WAIT(); __syncthreads();
        }
    }
    if (MIXMASK & 4) for (int rep = 0; rep < REPC; ++rep) { const int qx = rep * 16 + l * 4 + 2;
        for (int u = grab(F, qx); u < SEQ / 16; u = grab(F, qx)) sparse_unit(F, l, SEQ / 16 - 1 - u); }
}

struct Args { const float* in[14]; float* out; unsigned char* ws; int ph_lo, ph_hi, li, pad; };
constexpr int NPHASE = 1 + 6 * DEPTH;
__global__ void __launch_bounds__(NWAVES * 64, 2) trunk_fwd(Args args) {
    extern __shared__ __attribute__((aligned(16))) unsigned char lds[];
    Frame F;
    F.lds = (LAS unsigned char*)lds;
    F.MISC = (volatile LAS unsigned*)(F.lds + MISC_OFF);
    F.wave = __builtin_amdgcn_readfirstlane((int)threadIdx.x >> 6);
    F.G = gridDim.x; { const int bx = blockIdx.x; F.vcu = (F.G % 8 == 0) ? (bx % 8) * (F.G / 8) + bx / 8 : bx; }
    F.ws = args.ws;
    F.ctl = (gu32*)(args.ws + WS_CTL);
    if (threadIdx.x < 128) ((LAS unsigned*)(F.lds + MISC_OFF))[threadIdx.x] = 0u;
    __syncthreads();
    XcdBarrier bar = xcd_barrier_post((unsigned*)(F.ctl + CW_BAR), F.MISC + 0);
#ifndef PMASK
#define PMASK 0x7f
#endif
#define IN(k) true
#define SEAM(k) do { if ((k) + 1 < NPHASE) { XcdBarrier b2_ = bar; unsigned xx_ = b2_.x; asm volatile("" : "+s"(xx_)); b2_.x = xx_; for (int rb_ = 0; rb_ < REPBAR; ++rb_) xcd_barrier(b2_); } } while (0)
    if ((PMASK & 1) && IN(0)) { p0_prologue(F, args.in[0], args.in[1], args.in[2], args.in[11]); SEAM(0); }
    for (int l = 0; l < DEPTH; ++l) {
        const int pb = 1 + 6 * l;
        const float lam_init = 0.8f - 0.6f * expf(-0.3f * (float)l);
        if ((PMASK & 2) && IN(pb + 0)) {
            pg8::Gemm g{B_XB(F), B_WTIN(F) + (size_t)l * NPAD * DM, SEQ, NPAD, DM}; pg8::StaticOrder S; S.init(SEQ, NPAD, F.G, (int)blockIdx.x);
            pg8::EpiBf16Plain E{B_H(F), NPAD};
            for (int rep = 0; rep < REPG1; ++rep) pg8::gemm_phase<pg8::EpiBf16Plain, pg8::StaticOrder, true, true>(F.lds, g, S, E, F.wave);
            SEAM(pb + 0);
        }
        if ((PMASK & 4) && IN(pb + 1)) { for (int rep = 0; rep < REPS; ++rep) prep_phase(F, l, args.in[3], args.in[4], args.in[8], args.in[9], args.in[10]); SEAM(pb + 1); }
        if ((PMASK & 8) && IN(pb + 2)) { mix_phase(F, l); SEAM(pb + 2); }
        if ((PMASK & 16) && IN(pb + 3)) { for (int rep = 0; rep < REPS; ++rep) post_phase(F, l, lam_init, args.in[5], args.in[6], args.in[7]); SEAM(pb + 3); }
        if ((PMASK & 32) && IN(pb + 4)) {
            pg8::Gemm g{B_O(F), B_WTOUT(F) + (size_t)l * DM * DM, SEQ, DM, DM}; pg8::StaticOrder S; S.init(SEQ, DM, F.G, (int)blockIdx.x);
            pg8::EpiResid E{l == 0 ? args.in[0] : B_XF(F), B_XF(F), DM, 1.6817928305074290f};
            pg8::gemm_phase<pg8::EpiResid, pg8::StaticOrder, true, true>(F.lds, g, S, E, F.wave);
            SEAM(pb + 4);
        }
        if ((PMASK & 64) && IN(pb + 5)) {
#if defined(REPLN)
            ln_phase(F, l, args.in[12], args.in[13], args.out, true);
#endif
            ln_phase(F, l, args.in[12], args.in[13], args.out, false); SEAM(pb + 5); }
    }
#undef IN
#undef SEAM
}

#ifndef MK_N_LAUNCHES
#define MK_N_LAUNCHES 1
#endif
extern "C" void kernel_launch(void* const* d_in, const int* in_sizes, int n_in, void* d_out, int out_size, void* d_ws, size_t ws_size, hipStream_t stream) {
    static int grid = 0;
    if (grid == 0) {
        if (n_in != 14 || in_sizes[0] != SEQ * DM || out_size != SEQ * DM || ws_size < WS_END) {
            fprintf(stderr, "kernel_launch: shape mismatch (n_in %d, in0 %d, out %d, ws %zu; need ws >= %zu)\n", n_in, n_in > 0 ? in_sizes[0] : -1, out_size, ws_size, (size_t)WS_END); grid = -1; return; }
        int dev = 0, cus = 0, per_cu = 0;
        if (hipGetDevice(&dev) != hipSuccess || hipDeviceGetAttribute(&cus, hipDeviceAttributeMultiprocessorCount, dev) != hipSuccess) { grid = -1; return; }
        if (hipFuncSetAttribute((const void*)trunk_fwd, hipFuncAttributeMaxDynamicSharedMemorySize, LDS_BYTES) != hipSuccess) { fprintf(stderr, "kernel_launch: hipFuncSetAttribute failed\n"); grid = -1; return; }
        if (hipOccupancyMaxActiveBlocksPerMultiprocessor(&per_cu, (const void*)trunk_fwd, NWAVES * 64, LDS_BYTES) != hipSuccess || per_cu < 1)
            fprintf(stderr, "kernel_launch: occupancy query reports %d workgroups per CU\n", per_cu);
        (void)hipGetLastError();
        grid = cus;
    }
    if (grid < 0) return;
    if (hipMemsetAsync((char*)d_ws + WS_CTL, 0, CTL_ZERO_BYTES, stream) != hipSuccess) return;
    Args a{};
    for (int i = 0; i < 14; ++i) a.in[i] = (const float*)d_in[i];
    a.out = (float*)d_out; a.ws = (unsigned char*)d_ws;
    a.ph_lo = 0; a.ph_hi = NPHASE; a.li = 0; a.pad = 0;
    hipLaunchKernelGGL(trunk_fwd, dim3(grid), dim3(NWAVES * 64), LDS_BYTES, stream, a);
    const hipError_t le = hipPeekAtLastError();
    if (le != hipSuccess) fprintf(stderr, "kernel_launch: launch failed: %s\n", hipGetErrorName(le));
}
```

```cpp
#include <hip/hip_runtime.h>
#include <cstdio>
#include <cstdint>

#define GAS __attribute__((address_space(1)))
#define LAS __attribute__((address_space(3)))
typedef unsigned short bf16_t;
typedef short s16x4 __attribute__((ext_vector_type(4)));
typedef float f32x16 __attribute__((ext_vector_type(16)));
typedef unsigned u32x2 __attribute__((ext_vector_type(2)));
typedef GAS unsigned gu32;

__device__ __forceinline__ int hw_lane() { int r; asm volatile("v_mbcnt_lo_u32_b32 %0, -1, 0\n\tv_mbcnt_hi_u32_b32 %0, -1, %0" : "=v"(r)); return r; }

constexpr int SEQ = 16384, DM = 4096, DEPTH = 4, NIN = 14688, NPAD = 14848;
constexpr int CHUNK = 64, NCHUNK = SEQ / CHUNK;
constexpr int C_AQ = 0, C_AK = 1024, C_AV = 2048, C_AG = 4096, C_BQ = 6144, C_BK = 7168, C_BV = 8192, C_BG = 9216, C_CQ = 10240,
              C_CKV = 12288, C_CIQ = 12544, C_CG = 13568, C_CIK = 14592, C_AA = 14656, C_CIW = 14672;
__host__ __device__ __forceinline__ int srccol(int n) {
    if (n < 4096) return n;
    if (n < 6144) return n + 16;
    if (n < 13568) return n + 16;
    if (n < 14592) return n + 96;
    if (n < 14656) return n - 1008;
    if (n < 14672) return n - 10560;
    if (n < 14688) return n - 1024;
    return -1;
}
namespace pg8 {
#define PG8_LAS __attribute__((address_space(3)))
typedef unsigned short bf16_t;
typedef short bf16x8 __attribute__((ext_vector_type(8)));
typedef float f32x4 __attribute__((ext_vector_type(4)));
typedef unsigned u32x4 __attribute__((ext_vector_type(4)));
constexpr int BM = 256, BK = 64, HALF = 128, HTB = HALF * BK * 2  , STAGE_BYTES = 8 * HTB, NXCD = 8, WGM = 8;

__host__ __device__ __forceinline__ int lds_byte(int r, int c) { const int st = (r >> 4) * 2 + (c >> 5), rr = r & 15, cc = c & 31, ob = rr * 64 + cc * 2; return st * 1024 + (ob ^ (((ob >> 9) & 1) << 5)); }
__host__ __device__ __forceinline__ void stage_rc(int b, int& R, int& C) { const int st = b / 1024, sb = b % 1024, swz = sb ^ (((sb >> 9) & 1) << 5); R = (st >> 1) * 16 + swz / 64; C = (st & 1) * 32 + (swz % 64) / 2; }
__host__ __device__ __forceinline__ int perm32(int rho) { const int n = rho >> 4, i = rho & 15; return 8 * (i >> 2) + 4 * n + (i & 3); }

struct Unit { int pm, pn; };
struct Gemm { const bf16_t* A; const bf16_t* Bt; int M, N, K; };

struct StaticOrder {
    int nM, nN, nwg, G, c;
    __host__ __device__ void init(int M, int N, int G_, int c_) { nM = M / BM; nN = N / BM; nwg = nM * nN; G = G_; c = c_; }
    __host__ __device__ bool next(int i, Unit& u) const {
        const long L = (long)i * G + c; if (L >= nwg) return false;
        int wgid = (int)L; { const int q = nwg / NXCD, r = nwg % NXCD, xcd = wgid % NXCD, off = wgid / NXCD; wgid = (xcd < r ? xcd * (q + 1) : r * (q + 1) + (xcd - r) * q) + off; }
        const int nig = WGM * nN, gid = wgid / nig, fm = gid * WGM, gsz = (nM - fm) < WGM ? (nM - fm) : WGM;
        u.pm = fm + ((wgid % nig) % gsz); u.pn = (wgid % nig) / gsz; return true;
    }
    __device__ __forceinline__ void a_ready(const Unit&) const {}
    __device__ __forceinline__ void done(const Unit&) const {}
};

__device__ __forceinline__ unsigned cvt_pk_bf16(float lo, float hi) { unsigned r; asm volatile("v_cvt_pk_bf16_f32 %0, %1, %2" : "=v"(r) : "v"(lo), "v"(hi)); return r; }
typedef float f32x2 __attribute__((ext_vector_type(2)));
struct EpiBf16Plain {
    static constexpr bool PERM = true, AFTER_DRAIN = false;
    bf16_t* O; int ldc;
    __device__ __forceinline__ void operator()(const f32x4 (&acc)[2][2][4][2], const Unit& u, int wr, int wc, int fr, int fq) const {
        const int row0 = u.pm * BM + wr * 64 + fr, col0 = u.pn * BM + wc * 32 + 8 * fq;
#pragma unroll
        for (int ai = 0; ai < 2; ++ai)
#pragma unroll
            for (int m = 0; m < 4; ++m) { bf16_t* rowp = O + (size_t)(row0 + ai * HALF + m * 16) * ldc + col0;
#pragma unroll
                for (int bj = 0; bj < 2; ++bj) { const f32x4 v0 = acc[ai][bj][m][0], v1 = acc[ai][bj][m][1];
                    u32x4 w; w.x = cvt_pk_bf16(v0[0], v0[1]); w.y = cvt_pk_bf16(v0[2], v0[3]); w.z = cvt_pk_bf16(v1[0], v1[1]); w.w = cvt_pk_bf16(v1[2], v1[3]);
                    *(u32x4*)(rowp + bj * HALF) = w; } }
    }
};
struct EpiResid {
    static constexpr bool PERM = false, AFTER_DRAIN = false;
    const float* Xin; float* Xout; int ldc; float alpha;
    __device__ __forceinline__ void operator()(const f32x4 (&acc)[2][2][4][2], const Unit& u, int wr, int wc, int fr, int fq) const {
        const int row0 = u.pm * BM + wr * 64 + fr, col0 = u.pn * BM + wc * 32 + 4 * fq;
#pragma unroll
        for (int ai = 0; ai < 2; ++ai)
#pragma unroll
            for (int m = 0; m < 4; ++m) { const size_t off = (size_t)(row0 + ai * HALF + m * 16) * ldc + col0;
#pragma unroll
                for (int bj = 0; bj < 2; ++bj)
#pragma unroll
                    for (int n = 0; n < 2; ++n) { const f32x4 xi = *(const f32x4*)(Xin + off + bj * HALF + n * 16);
                        *(f32x4*)(Xout + off + bj * HALF + n * 16) = xi * alpha + acc[ai][bj][m][n]; }
                asm volatile("" ::: "memory"); }
    }
};
struct EpiResidB {
    static constexpr bool PERM = false, AFTER_DRAIN = false;
    const bf16_t* Xin; float* Xout; int ldc; float alpha;
    __device__ __forceinline__ void operator()(const f32x4 (&acc)[2][2][4][2], const Unit& u, int wr, int wc, int fr, int fq) const {
        const int row0 = u.pm * BM + wr * 64 + fr, col0 = u.pn * BM + wc * 32 + 4 * fq;
#pragma unroll
        for (int ai = 0; ai < 2; ++ai)
#pragma unroll
            for (int m = 0; m < 4; ++m) { const size_t off = (size_t)(row0 + ai * HALF + m * 16) * ldc + col0;
#pragma unroll
                for (int bj = 0; bj < 2; ++bj)
#pragma unroll
                    for (int n = 0; n < 2; ++n) { const unsigned long long w = *(const unsigned long long*)(Xin + off + bj * HALF + n * 16);
                        const unsigned lo = (unsigned)w, hi = (unsigned)(w >> 32);
                        const f32x4 xi = {__uint_as_float(lo << 16), __uint_as_float(lo & 0xffff0000u), __uint_as_float(hi << 16), __uint_as_float(hi & 0xffff0000u)};
                        *(f32x4*)(Xout + off + bj * HALF + n * 16) = xi * alpha + acc[ai][bj][m][n]; }
                asm volatile("" ::: "memory"); }
    }
};
template <class Epi, class Sched, bool ALIGN_EPI = false, bool SP2 = false>
__device__ __forceinline__ void gemm_phase(PG8_LAS unsigned char* lds, const Gemm g, const Sched& S, const Epi& E, int wave_id) {
    int tid_ = wave_id * 64 + hw_lane(); asm volatile("" : "+v"(tid_));
    const int tid = tid_, wid = __builtin_amdgcn_readfirstlane(tid >> 6), lane = tid & 63, wr = wid >> 2, wc = wid & 3, fr = lane & 15, fq = lane >> 4;
    const int K = g.K, nt = K / BK;
    unsigned voffA[2], voffB[2];
#pragma unroll
    for (int i = 0; i < 2; ++i) { int R, C; stage_rc(tid * 16 + i * 8192, R, C); const int Rb = Epi::PERM ? ((R & ~31) + perm32(R & 31)) : R;
        voffA[i] = (unsigned)(R * K + C) * 2u; voffB[i] = (unsigned)(Rb * K + C) * 2u; }
    const size_t kstep = (size_t)(BK * 2);
    const size_t hstep = (size_t)HALF * K * 2;
    const size_t tstep = 2 * hstep;
    const unsigned ldsw = (unsigned)wid * 1024u;
    const int aoff = lds_byte(wr * 64 + fr, fq * 8), boff = lds_byte(wc * 32 + fr, fq * 8);
#define PG8_SA(b, h) (((b) * 2 + (h)) * HTB)
#define PG8_SB(b, h) ((4 + (b) * 2 + (h)) * HTB)
#define PG8_STAGE(bufoff, gbase, voff) do { _Pragma("unroll") for (int _i = 0; _i < 2; ++_i) \
        __builtin_amdgcn_global_load_lds((const unsigned*)((const char*)(gbase) + (voff)[_i]), (PG8_LAS unsigned*)(lds + (bufoff) + ldsw + _i * 8192), 16, 0, 0); } while (0)
#define PG8_LDA(dst, b, h) do { _Pragma("unroll") for (int m = 0; m < 4; ++m) _Pragma("unroll") for (int k = 0; k < 2; ++k) dst[m][k] = *(const PG8_LAS bf16x8*)(lds + PG8_SA(b, h) + aoff + m * 2048 + k * 1024); } while (0)
#define PG8_LDB(dst, b, h) do { _Pragma("unroll") for (int n = 0; n < 2; ++n) _Pragma("unroll") for (int k = 0; k < 2; ++k) dst[n][k] = *(const PG8_LAS bf16x8*)(lds + PG8_SB(b, h) + boff + n * 2048 + k * 1024); } while (0)
#define PG8_MMA(ai, bj, At, Bt) do { __builtin_amdgcn_s_setprio(1); _Pragma("unroll") for (int m = 0; m < 4; ++m) _Pragma("unroll") for (int n = 0; n < 2; ++n) _Pragma("unroll") for (int k = 0; k < 2; ++k) \
        acc[ai][bj][m][n] = __builtin_amdgcn_mfma_f32_16x16x32_bf16(Bt[n][k], At[m][k], acc[ai][bj][m][n], 0, 0, 0); __builtin_amdgcn_s_setprio(0); } while (0)
#define PG8_WAIT_V(n) asm volatile("s_waitcnt vmcnt(" #n ")" ::: "memory")
#define PG8_WAIT_L(n) asm volatile("s_waitcnt lgkmcnt(" #n ")" ::: "memory")
#define PG8_BAR __builtin_amdgcn_s_barrier()
#define PG8_SCHED __builtin_amdgcn_sched_barrier(0)
    Unit cur, nxt; int ui = 0;
    if (!S.next(0, cur)) return;
    f32x4 acc[2][2][4][2];
#pragma unroll
    for (int a = 0; a < 2; ++a)
#pragma unroll
        for (int b = 0; b < 2; ++b)
#pragma unroll
            for (int m = 0; m < 4; ++m)
#pragma unroll
                for (int n = 0; n < 2; ++n) acc[a][b][m][n] = (f32x4){0.f, 0.f, 0.f, 0.f};
    bf16x8 At[4][2], B0[2][2], B1[2][2];
    const char* cA = (const char*)g.A + (size_t)cur.pm * tstep; const char* cB = (const char*)g.Bt + (size_t)cur.pn * tstep;
    S.a_ready(cur);
    if constexpr (SP2) {
        PG8_STAGE(PG8_SB(0, 0), cB, voffB); PG8_STAGE(PG8_SB(0, 1), cB + hstep, voffB); PG8_STAGE(PG8_SA(0, 0), cA, voffA); PG8_STAGE(PG8_SA(0, 1), cA + hstep, voffA);
        if (wr == 1) PG8_BAR;
        PG8_WAIT_V(2); PG8_BAR;
        PG8_STAGE(PG8_SB(1, 0), cB + kstep, voffB); PG8_STAGE(PG8_SA(1, 0), cA + kstep, voffA); PG8_STAGE(PG8_SB(1, 1), cB + hstep + kstep, voffB);
        PG8_WAIT_V(6); PG8_BAR;
    } else {
        PG8_STAGE(PG8_SB(0, 0), cB, voffB); PG8_STAGE(PG8_SA(0, 0), cA, voffA); PG8_STAGE(PG8_SB(0, 1), cB + hstep, voffB); PG8_STAGE(PG8_SA(0, 1), cA + hstep, voffA);
        if (wr == 1) PG8_BAR;
        PG8_WAIT_V(4); PG8_BAR;
        PG8_STAGE(PG8_SB(1, 0), cB + kstep, voffB); PG8_STAGE(PG8_SA(1, 0), cA + kstep, voffA); PG8_STAGE(PG8_SB(1, 1), cB + hstep + kstep, voffB);
        PG8_WAIT_V(6); PG8_BAR;
    }
    for (;;) {
        const bool has_next = S.next(ui + 1, nxt);
        const char* nA = has_next ? (const char*)g.A + (size_t)nxt.pm * tstep : cA; const char* nB = has_next ? (const char*)g.Bt + (size_t)nxt.pn * tstep : cB;
        for (int t = 0; t < nt; t += 2) {
            const bool last = (t == nt - 2);
            const char* a1 = cA + (size_t)(t + 1) * kstep;
            const char* a2 = last ? nA : cA + (size_t)(t + 2) * kstep; const char* b2 = last ? nB : cB + (size_t)(t + 2) * kstep;
            const char* a3 = a2 + kstep; const char* b3 = b2 + kstep;
            if (last && has_next) S.a_ready(nxt);
            if constexpr (SP2) {
            PG8_LDB(B0, 0, 0); PG8_LDB(B1, 0, 1); PG8_SCHED; PG8_LDA(At, 0, 0); PG8_STAGE(PG8_SA(1, 1), a1 + hstep, voffA);
            PG8_WAIT_V(8); PG8_WAIT_L(0); PG8_BAR; PG8_MMA(0, 0, At, B0); PG8_MMA(0, 1, At, B1); PG8_BAR; PG8_SCHED;
            PG8_LDA(At, 0, 1); PG8_STAGE(PG8_SB(0, 0), b2, voffB); PG8_STAGE(PG8_SB(0, 1), b2 + hstep, voffB); PG8_STAGE(PG8_SA(0, 0), a2, voffA);
            PG8_WAIT_V(8); PG8_WAIT_L(0); PG8_BAR; PG8_MMA(1, 0, At, B0); PG8_MMA(1, 1, At, B1); PG8_BAR; PG8_SCHED;
            PG8_LDB(B0, 1, 0); PG8_LDB(B1, 1, 1); PG8_SCHED; PG8_LDA(At, 1, 0); PG8_STAGE(PG8_SA(0, 1), a2 + hstep, voffA);
            PG8_WAIT_V(8); PG8_WAIT_L(0); PG8_BAR; PG8_MMA(0, 0, At, B0); PG8_MMA(0, 1, At, B1); PG8_BAR; PG8_SCHED;
            PG8_LDA(At, 1, 1); PG8_STAGE(PG8_SB(1, 0), b3, voffB); PG8_STAGE(PG8_SB(1, 1), b3 + hstep, voffB); PG8_STAGE(PG8_SA(1, 0), a3, voffA);
            PG8_WAIT_V(8); PG8_WAIT_L(0); PG8_BAR; PG8_MMA(1, 0, At, B0); PG8_MMA(1, 1, At, B1); PG8_BAR; PG8_SCHED;
            } else {
            PG8_LDB(B0, 0, 0); PG8_SCHED; PG8_LDA(At, 0, 0); PG8_STAGE(PG8_SA(1, 1), a1 + hstep, voffA);
            PG8_WAIT_L(8); PG8_BAR; PG8_WAIT_L(0); PG8_MMA(0, 0, At, B0); PG8_BAR; PG8_SCHED;
            PG8_LDB(B1, 0, 1); PG8_STAGE(PG8_SB(0, 0), b2, voffB);
            PG8_BAR; PG8_WAIT_L(0); PG8_MMA(0, 1, At, B1); PG8_BAR;
            PG8_LDA(At, 0, 1); PG8_STAGE(PG8_SA(0, 0), a2, voffA);
            PG8_BAR; PG8_WAIT_L(0); PG8_MMA(1, 0, At, B0); PG8_BAR; PG8_SCHED;
            PG8_STAGE(PG8_SB(0, 1), b2 + hstep, voffB);
            PG8_WAIT_V(6); PG8_BAR; PG8_MMA(1, 1, At, B1); PG8_BAR;
            PG8_LDB(B0, 1, 0); PG8_SCHED; PG8_LDA(At, 1, 0); PG8_STAGE(PG8_SA(0, 1), a2 + hstep, voffA);
            PG8_WAIT_L(8); PG8_BAR; PG8_WAIT_L(0); PG8_MMA(0, 0, At, B0); PG8_BAR; PG8_SCHED;
            PG8_LDB(B1, 1, 1); PG8_STAGE(PG8_SB(1, 0), b3, voffB);
            PG8_BAR; PG8_WAIT_L(0); PG8_MMA(0, 1, At, B1); PG8_BAR;
            PG8_LDA(At, 1, 1); PG8_STAGE(PG8_SA(1, 0), a3, voffA);
            PG8_BAR; PG8_WAIT_L(0); PG8_MMA(1, 0, At, B0); PG8_BAR; PG8_SCHED;
            PG8_STAGE(PG8_SB(1, 1), b3 + hstep, voffB);
            PG8_WAIT_V(6); PG8_BAR; PG8_MMA(1, 1, At, B1); PG8_BAR;
            }
        }
        if constexpr (ALIGN_EPI) { if (wr == 0) PG8_BAR; }
        if constexpr (!Epi::AFTER_DRAIN) { E(acc, cur, wr, wc, fr, fq); S.done(cur); }
        if (!has_next) break;
#pragma unroll
        for (int a = 0; a < 2; ++a)
#pragma unroll
            for (int b = 0; b < 2; ++b)
#pragma unroll
                for (int m = 0; m < 4; ++m)
#pragma unroll
                    for (int n = 0; n < 2; ++n) acc[a][b][m][n] = (f32x4){0.f, 0.f, 0.f, 0.f};
        cur = nxt; cA = nA; cB = nB; ++ui;
        if constexpr (ALIGN_EPI) { if (wr == 1) PG8_BAR; }
    }
    PG8_WAIT_V(0);
    if constexpr (!ALIGN_EPI) { if (wr == 0) PG8_BAR; }
    PG8_BAR;
    if constexpr (Epi::AFTER_DRAIN) { E.fused(acc, cur, wr, wc, fr, fq, lds, wid, lane); S.done(cur); }
#undef PG8_SA
#undef PG8_SB
#undef PG8_STAGE
#undef PG8_LDA
#undef PG8_LDB
#undef PG8_MMA
#undef PG8_WAIT_V
#undef PG8_WAIT_L
#undef PG8_BAR
#undef PG8_SCHED
}
}
using pg8::bf16x8; using pg8::f32x4; using pg8::u32x4;
namespace dattn {
constexpr int D = 128, LDQ = NPAD, LDK = NPAD, LDO = 2048;
constexpr float SCALE = 0.08838834764831845f;
constexpr float THR = 8.f;
constexpr int NW = 8, QBLK = 32, KVBLK = 64, QB = NW * QBLK;
constexpr int SHM_V = KVBLK * D * 2, SHM_K = KVBLK * D * 2;
constexpr int LDS_BYTES = 2 * SHM_V + 2 * SHM_K + NW * 64 * 4;

#define KSWZ(row, colB) ((row) * 256 + ((colB) ^ (((row) & 7) << 4)))
#define SBAR() __builtin_amdgcn_sched_barrier(0)
__device__ __forceinline__ int v_st(int k, int c) { const int kk = (k & ~0xC) | ((k & 4) << 1) | ((k & 8) >> 1); return ((kk >> 3) * 4 + (c >> 5)) * 512 + ((kk & 7) * 32 + (c & 31)) * 2; }
__device__ __forceinline__ int v_rd_base(int lane) { return ((lane & 3) << 3) | (((lane >> 2) & 3) << 6) | (((lane >> 4) & 1) << 5) | (((lane >> 5) & 1) << 8); }
constexpr int v_rd_off(int d0, int ks, int half) { return d0 * 512 + ks * 4096 + half * 2048; }
__device__ __forceinline__ int crow(int r, int hi) { return (r & 3) + 8 * (r >> 2) + 4 * hi; }
__device__ __forceinline__ unsigned cvtpk(float lo, float hi) { unsigned r; asm volatile("v_cvt_pk_bf16_f32 %0, %1, %2" : "=v"(r) : "v"(lo), "v"(hi)); return r; }
__device__ __forceinline__ bf16x8 load8(const bf16_t* p) { return *reinterpret_cast<const bf16x8*>(p); }

__device__ __forceinline__ void partialSM(f32x16& p0, f32x16& p1, float& m_reg, float& mn, float& alpha) {
    float pmax = p0[0]; for (int r = 1; r < 16; ++r) pmax = fmaxf(pmax, p0[r]); for (int r = 0; r < 16; ++r) pmax = fmaxf(pmax, p1[r]);
    { auto rr = __builtin_amdgcn_permlane32_swap(__float_as_uint(pmax), __float_as_uint(pmax), false, false);
      pmax = fmaxf(__uint_as_float(rr[0]), __uint_as_float(rr[1])); }
    constexpr float C2 = 1.4426950408889634f * SCALE;
    if (__builtin_expect(__all((pmax - m_reg) * SCALE <= THR), 1)) { mn = m_reg; alpha = 1.f; }
    else { mn = fmaxf(m_reg, pmax); alpha = __builtin_amdgcn_exp2f((m_reg - mn) * C2); m_reg = mn; }
    const float mnL = -mn * C2;
    for (int r = 0; r < 16; ++r) p0[r] = fmaf(p0[r], C2, mnL); for (int r = 0; r < 16; ++r) p1[r] = fmaf(p1[r], C2, mnL);
    for (int r = 0; r < 16; ++r) p0[r] = __builtin_amdgcn_exp2f(p0[r]);
}
__device__ __forceinline__ void finishSM(f32x16& p0, f32x16& p1, float alpha, float& l_reg, bf16x8& pa0, bf16x8& pa1, bf16x8& pa2, bf16x8& pa3) {
    for (int r = 0; r < 16; ++r) p1[r] = __builtin_amdgcn_exp2f(p1[r]);
    float ps = 0; for (int r = 0; r < 16; ++r) ps += p0[r]; for (int r = 0; r < 16; ++r) ps += p1[r];
    { auto rr = __builtin_amdgcn_permlane32_swap(__float_as_uint(ps), __float_as_uint(ps), false, false);
      ps = __uint_as_float(rr[0]) + __uint_as_float(rr[1]); }
    l_reg = l_reg * alpha + ps;
#define PK4(P, B_, OUT) do { unsigned a0 = cvtpk(P[B_+0], P[B_+1]), a1 = cvtpk(P[B_+2], P[B_+3]);                          \
        unsigned b0 = cvtpk(P[B_+4], P[B_+5]), b1 = cvtpk(P[B_+6], P[B_+7]);                                             \
        auto r0 = __builtin_amdgcn_permlane32_swap(a0, b0, false, false); auto r1 = __builtin_amdgcn_permlane32_swap(a1, b1, false, false); \
        u32x4 w = {r0[0], r1[0], r0[1], r1[1]}; OUT = *reinterpret_cast<bf16x8*>(&w); } while (0)
    PK4(p0, 0, pa0); PK4(p0, 8, pa1); PK4(p1, 0, pa2); PK4(p1, 8, pa3);
#undef PK4
}
template <int KB>
__device__ __forceinline__ void qkt(f32x16& p0, f32x16& p1, const char* K_lds, int r32, int hi, const bf16x8* qr) {
    p0 = f32x16{}; p1 = f32x16{};
    const char* kb[4];
#pragma unroll
    for (int dd = 0; dd < 4; ++dd) kb[dd] = K_lds + KB * SHM_K + KSWZ(r32, (dd * 16 + hi * 8) * 2);
#pragma unroll
    for (int d0 = 0; d0 < 8; ++d0) { const char* a = kb[d0 & 3] + (d0 >> 2) * 128;
        bf16x8 b0 = *reinterpret_cast<const bf16x8*>(a);
        bf16x8 b1 = *reinterpret_cast<const bf16x8*>(a + 32 * 256);
        p0 = __builtin_amdgcn_mfma_f32_32x32x16_bf16(b0, qr[d0], p0, 0, 0, 0);
        p1 = __builtin_amdgcn_mfma_f32_32x32x16_bf16(b1, qr[d0], p1, 0, 0, 0); }
}
template <int VB>
__device__ __forceinline__ void pv_tile(f32x16* o, int vb0, bf16x8 pa0, bf16x8 pa1, bf16x8 pa2, bf16x8 pa3) {
#define TRRD(dst, off) asm volatile("ds_read_b64_tr_b16 %0, %1 offset:%2" : "=&v"(dst) : "v"(vb0), "i"(off) : "memory")
#define PV_D0(d0) do { s16x4 l0, l1, l2, l3, h0, h1, h2, h3; constexpr int b_ = VB * SHM_V + v_rd_off(d0, 0, 0);   \
        TRRD(l0, b_); TRRD(h0, b_ + 2048); TRRD(l1, b_ + 4096); TRRD(h1, b_ + 6144); TRRD(l2, b_ + 8192); TRRD(h2, b_ + 10240); TRRD(l3, b_ + 12288); TRRD(h3, b_ + 14336); \
        asm volatile("s_waitcnt lgkmcnt(0)" ::: "memory"); SBAR();                                                   \
        o[d0] = __builtin_amdgcn_mfma_f32_32x32x16_bf16(pa0, (bf16x8){l0[0], l0[1], l0[2], l0[3], h0[0], h0[1], h0[2], h0[3]}, o[d0], 0, 0, 0);   \
        o[d0] = __builtin_amdgcn_mfma_f32_32x32x16_bf16(pa1, (bf16x8){l1[0], l1[1], l1[2], l1[3], h1[0], h1[1], h1[2], h1[3]}, o[d0], 0, 0, 0);   \
        o[d0] = __builtin_amdgcn_mfma_f32_32x32x16_bf16(pa2, (bf16x8){l2[0], l2[1], l2[2], l2[3], h2[0], h2[1], h2[2], h2[3]}, o[d0], 0, 0, 0);   \
        o[d0] = __builtin_amdgcn_mfma_f32_32x32x16_bf16(pa3, (bf16x8){l3[0], l3[1], l3[2], l3[3], h3[0], h3[1], h3[2], h3[3]}, o[d0], 0, 0, 0); } while (0)
    PV_D0(0); PV_D0(1); PV_D0(2); PV_D0(3);
#undef PV_D0
#undef TRRD
}

struct BlockRef { const bf16_t* Q; const bf16_t* K; const bf16_t* V; float* O; int P0; };
struct Seam { bf16x8 qr[8]; bf16x8 st_v0, st_v1, st_k0, st_k1; };
#define ROW(p, k0, rr) ((p) + (size_t)((k0) + (rr)) * LDK + sc)
#define VMW() asm volatile("s_waitcnt vmcnt(0)" ::: "memory")
#define VMWN(n) asm volatile("s_waitcnt vmcnt(%0)" :: "i"(n) : "memory")
#define SLOAD_H(Kp, Vp, k0) do { S.st_v0 = load8(ROW(Vp, k0, sr)); S.st_v1 = load8(ROW(Vp, k0, 32 + sr));              \
                         S.st_k0 = load8(ROW(Kp, k0, sr)); S.st_k1 = load8(ROW(Kp, k0, 32 + sr)); } while (0)
#define SWRITE_HK(bf) do { *(bf16x8*)(K_lds + (bf) * SHM_K + kws) = S.st_k0; *(bf16x8*)(K_lds + (bf) * SHM_K + kws + 32 * 256) = S.st_k1; } while (0)
#define SWRITE_HV(bf) do { *(bf16x8*)(V_lds + (bf) * SHM_V + vst0) = S.st_v0; *(bf16x8*)(V_lds + (bf) * SHM_V + vst1) = S.st_v1; } while (0)
#define SWRITE_H(bf) do { SWRITE_HV(bf); SWRITE_HK(bf); } while (0)
__device__ __forceinline__ void prime(const BlockRef& cur, char* lds, Seam& S, int wave_id) {
    int tid_ = wave_id * 64 + hw_lane(); asm volatile("" : "+v"(tid_));
    const int tid = tid_, wid = __builtin_amdgcn_readfirstlane(tid >> 6), lane = tid & 63, r32 = lane & 31, hi = lane >> 5;
    const int sr = tid >> 4, sc = (tid & 15) * 8, kws = KSWZ(sr, sc * 2); char* K_lds = lds + 2 * SHM_V;
#pragma unroll
    for (int d0 = 0; d0 < 8; ++d0) S.qr[d0] = load8(cur.Q + (size_t)(wid * QBLK + r32) * LDQ + d0 * 16 + hi * 8);
    SLOAD_H(cur.K, cur.V, 0); VMW(); SWRITE_HK(0);
    __syncthreads();
}
__device__ __forceinline__ void block(const BlockRef& cur, const BlockRef& nxt, char* lds, Seam& S, int wave_id) {
    int tid_ = wave_id * 64 + hw_lane(); asm volatile("" : "+v"(tid_));
    const int tid = tid_, wid = __builtin_amdgcn_readfirstlane(tid >> 6), lane = tid & 63, r32 = lane & 31, hi = lane >> 5;
    const int NT = cur.P0 / KVBLK + 4;
    const int qlo = cur.P0 + wid * QBLK;
    const int qend = qlo | 63;
    char* V_lds = lds; char* K_lds = lds + 2 * SHM_V;
    float* ws = (float*)(lds + 2 * SHM_V + 2 * SHM_K) + wid * 64; float* li_l = ws, * al_l = ws + 32;
    float m_reg = -1e30f, l_reg = 0; f32x16 o[4] = {};
    const int sr = tid >> 4, sc = (tid & 15) * 8, vst0 = v_st(sr, sc), vst1 = v_st(32 + sr, sc), kws = KSWZ(sr, sc * 2);
    const int vb0 = (int)(uintptr_t)V_lds + v_rd_base(lane);
    const bf16_t* Kh = cur.K; const bf16_t* Vh = cur.V;
#define RESC(a) do { if (__any((a) < 1.f)) { if (hi == 0) al_l[r32] = (a); asm volatile("s_waitcnt lgkmcnt(0)" ::: "memory");              \
                     for (int d_ = 0; d_ < 4; ++d_) for (int r = 0; r < 16; ++r) o[d_][r] *= al_l[crow(r, hi)]; } } while (0)
#define KBASE(t) ((t) * KVBLK)
#define MASKT(P0_, P1_, t) do { if (KBASE(t) > qend) { const float NEG_ = -__builtin_inff(); _Pragma("unroll") for (int r_ = 0; r_ < 16; ++r_) { P0_[r_] = NEG_; P1_[r_] = NEG_; } } } while (0)
    constexpr int NQL = 8;
#define SEAM_K0() do { VMWN(NQL); SWRITE_HK(0); SBAR(); } while (0)
    f32x16 pA0, pA1, pB0, pB1; float mnA, mnB, alA, alB; bf16x8 pa0, pa1, pa2, pa3;
    SWRITE_HV(0); SBAR();
    if (NT > 1) { SLOAD_H(Kh, Vh, KBASE(1)); }
    SBAR(); qkt<0>(pA0, pA1, K_lds, r32, hi, S.qr);
    MASKT(pA0, pA1, 0); partialSM(pA0, pA1, m_reg, mnA, alA);
    if (NT > 1) { VMW(); SWRITE_H(1); }
    __syncthreads();
#define HALF_STEP(PX0, PX1, mnX, alX, PY0, PY1, alY, t, KB, VB, SB) do {                                                      \
        SBAR(); qkt<KB>(PX0, PX1, K_lds, r32, hi, S.qr);                                                                      \
        finishSM(PY0, PY1, alY, l_reg, pa0, pa1, pa2, pa3); SBAR();                                                           \
        if ((t) + 1 < NT) { SLOAD_H(Kh, Vh, KBASE((t) + 1)); SBAR(); }                                                        \
        pv_tile<VB>(o, vb0, pa0, pa1, pa2, pa3); MASKT(PX0, PX1, (t)); partialSM(PX0, PX1, m_reg, mnX, alX);                  \
        __syncthreads();                                                                                                      \
        if ((t) + 1 < NT) { VMW(); SWRITE_H(SB); }                                                                            \
        RESC(alX); __syncthreads(); } while (0)
    for (int t = 1; t + 1 < NT; t += 2) {
        HALF_STEP(pB0, pB1, mnB, alB, pA0, pA1, alA, t, 1, 0, 0);
        HALF_STEP(pA0, pA1, mnA, alA, pB0, pB1, alB, t + 1, 0, 1, 1);
    }
    SBAR(); qkt<1>(pB0, pB1, K_lds, r32, hi, S.qr); SBAR();
    SLOAD_H(nxt.K, nxt.V, 0); SBAR();
#pragma unroll
    for (int d0 = 0; d0 < 8; ++d0) S.qr[d0] = load8(nxt.Q + (size_t)(wid * QBLK + r32) * LDQ + d0 * 16 + hi * 8);
    SBAR();
    finishSM(pA0, pA1, alA, l_reg, pa0, pa1, pa2, pa3); SBAR();
    pv_tile<0>(o, vb0, pa0, pa1, pa2, pa3);
    MASKT(pB0, pB1, NT - 1); partialSM(pB0, pB1, m_reg, mnB, alB); __syncthreads(); RESC(alB);
    finishSM(pB0, pB1, alB, l_reg, pa0, pa1, pa2, pa3); SBAR(); pv_tile<1>(o, vb0, pa0, pa1, pa2, pa3);
    SBAR(); SEAM_K0();
    if (hi == 0) li_l[r32] = l_reg; asm volatile("s_waitcnt lgkmcnt(0)" ::: "memory");
    float rli[16];
#pragma unroll
    for (int r = 0; r < 16; ++r) rli[r] = __builtin_amdgcn_rcpf(li_l[crow(r, hi)]);
    float* Ow = cur.O + (size_t)(wid * QBLK) * LDO;
#pragma unroll
    for (int r = 0; r < 16; ++r) { const int orow = crow(r, hi);
#pragma unroll
        for (int d0 = 0; d0 < 4; ++d0) Ow[(size_t)orow * LDO + d0 * 32 + r32] = o[d0][r] * rli[r]; }
    __syncthreads();
#undef RESC
#undef KBASE
#undef MASKT
#undef SEAM_K0
#undef HALF_STEP
}
#undef ROW
#undef VMW
#undef VMWN
#undef SLOAD_H
#undef SWRITE_HK
#undef SWRITE_HV
#undef SWRITE_H
#undef KSWZ
#undef SBAR
}
#define XB_TMO      128
#define XB_XCNT(j)  (256  + 64 * (j))
#define XB_XSUB(j)  (1280 + 64 * (j))
#define XB_XGEN(j)  (2304 + 64 * (j))
#define XB_TOP      3328
#define XB_TOPGEN   3392
#define XCD_BAR_WORDS 3456
#define XB_SPIN_CAP (1u << 18)

__device__ __forceinline__ unsigned xb_ld(unsigned* p)              { return __hip_atomic_load(p, __ATOMIC_RELAXED, __HIP_MEMORY_SCOPE_AGENT); }
__device__ __forceinline__ unsigned xb_add(unsigned* p, unsigned v) { return __hip_atomic_fetch_add(p, v, __ATOMIC_RELAXED, __HIP_MEMORY_SCOPE_AGENT); }
__device__ __forceinline__ unsigned xb_xcc_id() { return (unsigned)__builtin_amdgcn_s_getreg((3 << 11) | 20) & 0xFu; }
#define XB_SPIN(cond, bar) do { unsigned _sp = 0; while (cond) { __builtin_amdgcn_s_sleep(1); \
    if ((++_sp & 255u) == 0u) { if (xb_ld(&(bar)[XB_TMO])) break; if (_sp > XB_SPIN_CAP) { atomicAdd(&(bar)[XB_TMO], 1u); break; } } } } while (0)

struct XcdBarrier {
    unsigned* bar; unsigned x;
    volatile LAS unsigned* st;
};

__device__ __forceinline__ XcdBarrier xcd_barrier_post(unsigned* bar, volatile LAS unsigned* st) {
    XcdBarrier b; b.bar = bar; b.x = xb_xcc_id(); b.st = st;
    if (threadIdx.x == 0) (void)xb_add(&bar[XB_XCNT(b.x)], 1u);
    return b;
}
__device__ __forceinline__ void xcd_barrier_complete(unsigned* bar, unsigned x, unsigned& nloc, unsigned& nx) {
    const unsigned G = gridDim.x * gridDim.y * gridDim.z;
    unsigned sum, cnt, mine, sp = 0u;
    for (;;) {
        sum = 0u; cnt = 0u; mine = 0u;
#pragma unroll
        for (unsigned j = 0; j < 16; ++j) { const unsigned c = xb_ld(&bar[XB_XCNT(j)]); sum += c; cnt += (c > 0u) ? 1u : 0u; mine = (j == x) ? c : mine; }
        if (sum == G) break;
        __builtin_amdgcn_s_sleep(1);
        if ((++sp & 255u) == 0u) { if (xb_ld(&bar[XB_TMO])) break; if (sp > XB_SPIN_CAP) { atomicAdd(&bar[XB_TMO], 1u); break; } }
    }
    nloc = mine > 0u ? mine : 1u; nx = cnt > 0u ? cnt : 1u;
}

__device__ __forceinline__ void xcd_barrier(const XcdBarrier& b) {
    asm volatile("s_waitcnt vmcnt(0)" ::: "memory");
    __syncthreads();
    if (threadIdx.x == 0) {
        unsigned* bar = b.bar;
        __builtin_amdgcn_s_waitcnt(0);
        unsigned nloc = b.st[0], nx = b.st[1];
        if (nloc == 0u) { xcd_barrier_complete(bar, b.x, nloc, nx); b.st[0] = nloc; b.st[1] = nx; }
        const unsigned old = xb_add(&bar[XB_XSUB(b.x)], 1u);
        const unsigned gen = old / nloc;
        if (old + 1u == (gen + 1u) * nloc) {
            __builtin_amdgcn_fence(__ATOMIC_RELEASE, "agent");
            asm volatile("s_waitcnt vmcnt(0)" ::: "memory");
            const unsigned og = xb_add(&bar[XB_TOP], 1u);
            const unsigned tg = og / nx;
            if (og + 1u == (tg + 1u) * nx) xb_add(&bar[XB_TOPGEN], 1u);
            else XB_SPIN(xb_ld(&bar[XB_TOPGEN]) == tg, bar);
            __builtin_amdgcn_fence(__ATOMIC_ACQUIRE, "agent");
            xb_add(&bar[XB_XGEN(b.x)], 1u);
            asm volatile("s_waitcnt vmcnt(0)" ::: "memory");
        } else {
            XB_SPIN(xb_ld(&bar[XB_XGEN(b.x)]) == gen, bar);
            __builtin_amdgcn_fence(__ATOMIC_ACQUIRE, "agent");
            asm volatile("s_waitcnt vmcnt(0)" ::: "memory");
        }
    }
    __syncthreads();
}
constexpr size_t MiB = 1u << 20;
constexpr size_t WS_CTL = 0, CTL_ZERO_BYTES = 1 * MiB;
constexpr size_t WS_WTIN = 2 * MiB;
constexpr size_t WS_WTOUT = WS_WTIN + (size_t)DEPTH * NPAD * DM * 2;
constexpr size_t WS_WUVT = WS_WTOUT + (size_t)DEPTH * DM * DM * 2;
constexpr size_t WS_XB = WS_WUVT + 2 * MiB;
constexpr size_t WS_XF = WS_XB + (size_t)SEQ * DM * 2;
constexpr size_t WS_H = WS_XF + (size_t)SEQ * DM * 4;
constexpr size_t WS_O = WS_H + (size_t)SEQ * NPAD * 2;
constexpr size_t WS_CN = WS_O + (size_t)SEQ * DM * 2;
constexpr size_t WS_IKN = WS_CN + (size_t)SEQ * 256 * 2;
constexpr size_t WS_KDT = WS_IKN + (size_t)SEQ * 64 * 2;
constexpr size_t WS_DEC = WS_KDT + (size_t)NCHUNK * 1024 * 64 * 2;
constexpr size_t WS_VT = WS_DEC + (size_t)NCHUNK * 1024 * 4;
constexpr size_t WS_OA = WS_VT + (size_t)NCHUNK * 2048 * 64 * 2;
constexpr size_t WS_OD = WS_OA + (size_t)SEQ * 2048 * 4;
constexpr size_t WS_END = WS_OD + (size_t)SEQ * 2048 * 4;
constexpr int CW_TMO = 0;
constexpr int CW_BAR = 4096, BAR_STRIDE = 4096;
constexpr int CW_Q = 200000;
static_assert((CW_Q + 64 * 16 + 64) * 4 <= (int)CTL_ZERO_BYTES && CW_BAR + 32 * BAR_STRIDE <= CW_Q, "CTL map");
constexpr int NWAVES = 8;
constexpr int WREG = 18432;
constexpr int MISC_OFF = NWAVES * WREG;
constexpr int LDS_BYTES = MISC_OFF + 512;
static_assert(pg8::STAGE_BYTES <= MISC_OFF && dattn::LDS_BYTES <= MISC_OFF, "LDS map");

#define LDS_WAIT() asm volatile("s_waitcnt lgkmcnt(0)" ::: "memory")
#define VM_WAIT() asm volatile("s_waitcnt vmcnt(0)" ::: "memory")
typedef __bf16 bf16x2v __attribute__((ext_vector_type(2)));
typedef float f32x2 __attribute__((ext_vector_type(2)));
__device__ __forceinline__ unsigned cvtpk_c(float lo, float hi) { f32x2 v = {lo, hi}; bf16x2v b = __builtin_convertvector(v, bf16x2v); return __builtin_bit_cast(unsigned, b); }
__device__ __forceinline__ float bf2f(unsigned b) { return __uint_as_float(b << 16); }
__device__ __forceinline__ float bflo(unsigned w) { return __uint_as_float(w << 16); }
__device__ __forceinline__ float bfhi(unsigned w) { return __uint_as_float(w & 0xffff0000u); }
__device__ __forceinline__ bf16x8 pack8f(float a0, float a1, float a2, float a3, float a4, float a5, float a6, float a7) {
    u32x4 w = {cvtpk_c(a0, a1), cvtpk_c(a2, a3), cvtpk_c(a4, a5), cvtpk_c(a6, a7)}; return __builtin_bit_cast(bf16x8, w); }
__device__ __forceinline__ float bperm_f(int src_lane, float v) { return __int_as_float(__builtin_amdgcn_ds_bpermute(src_lane << 2, __float_as_int(v))); }
__device__ __forceinline__ float wave_sum(float v) {
    const int ln = hw_lane();
#pragma unroll
    for (int o = 1; o < 64; o <<= 1) v += bperm_f(ln ^ o, v);
    return v;
}
__device__ __forceinline__ void wave_sum2(float& a, float& b) {
    const int ln = hw_lane();
#pragma unroll
    for (int o = 1; o < 64; o <<= 1) { const float ta = bperm_f(ln ^ o, a), tb = bperm_f(ln ^ o, b); a += ta; b += tb; }
}
__device__ __forceinline__ float silu(float x) { return x / (1.f + __expf(-x)); }
#define MFMA16(a, b, c) __builtin_amdgcn_mfma_f32_16x16x32_bf16((a), (b), (c), 0, 0, 0)
#define MFMA32(a, b, c) __builtin_amdgcn_mfma_f32_32x32x16_bf16((a), (b), (c), 0, 0, 0)

struct Frame {
    LAS unsigned char* lds;
    volatile LAS unsigned* MISC;
    gu32* ctl;
    unsigned char* ws;
    int wave, vcu, G;
};
#define B_WTIN(F)  ((bf16_t*)((F).ws + WS_WTIN))
#define B_WTOUT(F) ((bf16_t*)((F).ws + WS_WTOUT))
#define B_WUVT(F)  ((bf16_t*)((F).ws + WS_WUVT))
#define B_XB(F)    ((bf16_t*)((F).ws + WS_XB))
#define B_XF(F)    ((float*)((F).ws + WS_XF))
#define B_H(F)     ((bf16_t*)((F).ws + WS_H))
#define B_O(F)     ((bf16_t*)((F).ws + WS_O))
#define B_CN(F)    ((bf16_t*)((F).ws + WS_CN))
#define B_IKN(F)   ((bf16_t*)((F).ws + WS_IKN))
#define B_KDT(F)   ((bf16_t*)((F).ws + WS_KDT))
#define B_DEC(F)   ((float*)((F).ws + WS_DEC))
#define B_VT(F)    ((bf16_t*)((F).ws + WS_VT))
#define B_OA(F)    ((float*)((F).ws + WS_OA))
#define B_OD(F)    ((float*)((F).ws + WS_OD))
__device__ __forceinline__ int grab(Frame& F, int qidx) {
    if ((F.wave * 64 + hw_lane()) == 0) F.MISC[2] = __hip_atomic_fetch_add((unsigned*)(F.ctl + CW_Q + 64 * qidx), 1u, __ATOMIC_RELAXED, __HIP_MEMORY_SCOPE_AGENT);
    __syncthreads(); const int v = (int)F.MISC[2]; __syncthreads(); return v;
}
template <bool REMAP>
__device__ __forceinline__ void tr_item(const float* W, int K, int ldw, bf16_t* WT, int nblk, LAS float* scr, int item, int lane) {
    const int kb = item / nblk, nb = item - kb * nblk, k0 = 64 * kb, n0 = 32 * nb;
    const int sc = REMAP ? srccol(n0 + (lane & 31)) : n0 + (lane & 31);
#pragma unroll 8
    for (int i = 0; i < 32; ++i) { const int kk = 2 * i + (lane >> 5); scr[kk * 33 + (lane & 31)] = sc >= 0 ? W[(size_t)(k0 + kk) * ldw + sc] : 0.f; }
    LDS_WAIT();
    const int c = lane & 7;
#pragma unroll
    for (int j = 0; j < 4; ++j) { const int nn = (lane >> 3) + 8 * j; const LAS float* s = scr + (8 * c) * 33 + nn;
        u32x4 o; o.x = cvtpk_c(s[0 * 33], s[1 * 33]); o.y = cvtpk_c(s[2 * 33], s[3 * 33]); o.z = cvtpk_c(s[4 * 33], s[5 * 33]); o.w = cvtpk_c(s[6 * 33], s[7 * 33]);
        *(u32x4*)(WT + (size_t)(n0 + nn) * K + k0 + 8 * c) = o; }
    LDS_WAIT();
}
__device__ __forceinline__ void p0_prologue(Frame& F, const float* x_in, const float* w_in, const float* w_out, const float* w_uv) {
    LAS float* scr = (LAS float*)(F.lds + F.wave * 16384);
    const int gw = F.vcu * NWAVES + F.wave, NGW = F.G * NWAVES;
    constexpr int I_IN = (DM / 64) * (NPAD / 32), I_OUT = (DM / 64) * (DM / 32), I_UV = (256 / 64) * (128 / 32);
    constexpr int N_IN = DEPTH * I_IN, N_OUT = DEPTH * I_OUT, N_UV = DEPTH * 8 * I_UV;
    for (int it = gw; it < N_IN + N_OUT + N_UV; it += NGW) {
        int r = it;
        if (r < N_IN) { const int l = r / I_IN; r -= l * I_IN;
            tr_item<true>(w_in + (size_t)l * DM * NIN, DM, NIN, B_WTIN(F) + (size_t)l * NPAD * DM, NPAD / 32, scr, r, hw_lane()); continue; }
        r -= N_IN;
        if (r < N_OUT) { const int l = r / I_OUT; r -= l * I_OUT;
            tr_item<false>(w_out + (size_t)l * DM * DM, DM, DM, B_WTOUT(F) + (size_t)l * DM * DM, DM / 32, scr, r, hw_lane()); continue; }
        r -= N_OUT;
        { const int lh = r / I_UV; r -= lh * I_UV;
          tr_item<false>(w_uv + (size_t)lh * 256 * 128, 256, 128, B_WUVT(F) + (size_t)lh * 128 * 256, 128 / 32, scr, r, hw_lane()); }
    }
    const f32x4* xs = (const f32x4*)x_in;
    for (size_t i = (size_t)gw * 64 + hw_lane(); i < (size_t)SEQ * DM / 8; i += (size_t)NGW * 64) {
        const f32x4 a = xs[2 * i], b = xs[2 * i + 1];
        u32x4 o = {cvtpk_c(a[0], a[1]), cvtpk_c(a[2], a[3]), cvtpk_c(b[0], b[1]), cvtpk_c(b[2], b[3])};
        *(u32x4*)(B_XB(F) + 8 * i) = o;
    }
}

__device__ __forceinline__ void prep_phase(Frame& F, int l, const float* w_gate2, const float* b_gate, const float* kv_g, const float* ik_g, const float* ik_b) {
    int lane_ = hw_lane(); asm volatile("" : "+v"(lane_));
    const int gw = F.vcu * NWAVES + F.wave, NGW = F.G * NWAVES, lane = lane_;
    const bf16_t* H = B_H(F);
    {
        const float* kvg = kv_g + l * 256; const float* ikg = ik_g + l * 64; const float* ikb = ik_b + l * 64;
        const f32x4 g4 = *(const f32x4*)(kvg + 4 * lane); const float g1 = ikg[lane], b1 = ikb[lane];
        for (int t0 = gw; t0 < SEQ; t0 += 2 * NGW) {
            float v[2][4], x[2], ss[2];
#pragma unroll
            for (int k = 0; k < 2; ++k) { const bf16_t* hr = H + (size_t)(t0 + k * NGW) * NPAD;
                const u32x2 raw = *(const u32x2*)(hr + C_CKV + 4 * lane);
                v[k][0] = bflo(raw.x); v[k][1] = bfhi(raw.x); v[k][2] = bflo(raw.y); v[k][3] = bfhi(raw.y);
                x[k] = bf2f(hr[C_CIK + lane]);
                ss[k] = (v[k][0] * v[k][0] + v[k][1] * v[k][1]) + (v[k][2] * v[k][2] + v[k][3] * v[k][3]); }
            float mu[2] = {x[0], x[1]};
            wave_sum2(ss[0], ss[1]); wave_sum2(mu[0], mu[1]);
            float dv[2], var[2];
#pragma unroll
            for (int k = 0; k < 2; ++k) { dv[k] = x[k] - mu[k] * (1.f / 64.f); var[k] = dv[k] * dv[k]; }
            wave_sum2(var[0], var[1]);
#pragma unroll
            for (int k = 0; k < 2; ++k) { const int t = t0 + k * NGW;
                const float rs = rsqrtf(ss[k] * (1.f / 256.f) + 1e-6f);
                u32x2 o; o.x = cvtpk_c(v[k][0] * rs * g4[0], v[k][1] * rs * g4[1]); o.y = cvtpk_c(v[k][2] * rs * g4[2], v[k][3] * rs * g4[3]);
                *(u32x2*)(B_CN(F) + (size_t)t * 256 + 4 * lane) = o;
                const float y = dv[k] * rsqrtf(var[k] * (1.f / 64.f) + 1e-5f) * g1 + b1;
                B_IKN(F)[(size_t)t * 64 + lane] = (bf16_t)(cvtpk_c(y, 0.f) & 0xffffu); }
        }
    }
    {
        LAS float* aas = (LAS float*)(F.lds + F.wave * 16384);
        const float* W2 = w_gate2 + (size_t)l * 16 * 1024; const float* BG = b_gate + (size_t)l * 1024;
        for (int u = gw; u < NCHUNK * 16; u += NGW) {
            const int c = u >> 4, dk = (u & 15) * 64 + lane;
            { const bf16_t* ap = H + (size_t)(64 * c + lane) * NPAD + C_AA;
              const bf16x8 a0 = *(const bf16x8*)ap, a1 = *(const bf16x8*)(ap + 8);
#pragma unroll
              for (int j = 0; j < 8; ++j) { aas[lane * 16 + j] = bf2f((unsigned short)a0[j]); aas[lane * 16 + 8 + j] = bf2f((unsigned short)a1[j]); } }
            float w2[16];
#pragma unroll
            for (int r = 0; r < 16; ++r) w2[r] = W2[r * 1024 + dk];
            const float bgv = BG[dk];
            LDS_WAIT();
            float la[64]; float total = 0.f;
#pragma unroll
            for (int t = 0; t < 64; ++t) {
                float z = bgv;
#pragma unroll
                for (int r = 0; r < 16; ++r) z += aas[t * 16 + r] * w2[r];
                la[t] = (fminf(z, 0.f) - __logf(1.f + __expf(-fabsf(z)))) * (1.f / 16.f);
                total += la[t];
            }
            B_DEC(F)[(size_t)c * 1024 + dk] = __expf(total);
            float run = 0.f;
#pragma unroll
            for (int t8 = 0; t8 < 8; ++t8) {
                float kd[8];
#pragma unroll
                for (int j = 0; j < 8; ++j) { const int t = 8 * t8 + j;
                    run += la[t];
                    kd[j] = bf2f(H[(size_t)(64 * c + t) * NPAD + C_AK + dk]) * __expf(total - run); }
                *(bf16x8*)(B_KDT(F) + ((size_t)c * 1024 + dk) * 64 + 8 * t8) = pack8f(kd[0], kd[1], kd[2], kd[3], kd[4], kd[5], kd[6], kd[7]);
            }
            LDS_WAIT();
        }
    }
    for (int u = gw; u < NCHUNK * 16; u += NGW) {
        const int c = u >> 4, dv = (u & 15) * 128 + 2 * lane;
#pragma unroll
        for (int t8 = 0; t8 < 8; ++t8) {
            unsigned w[8];
#pragma unroll
            for (int j = 0; j < 8; ++j) w[j] = *(const unsigned*)(H + (size_t)(64 * c + 8 * t8 + j) * NPAD + C_AV + dv);
            u32x4 lo = {(w[0] & 0xffffu) | (w[1] << 16), (w[2] & 0xffffu) | (w[3] << 16), (w[4] & 0xffffu) | (w[5] << 16), (w[6] & 0xffffu) | (w[7] << 16)};
            u32x4 hi = {(w[0] >> 16) | (w[1] & 0xffff0000u), (w[2] >> 16) | (w[3] & 0xffff0000u), (w[4] >> 16) | (w[5] & 0xffff0000u), (w[6] >> 16) | (w[7] & 0xffff0000u)};
            *(u32x4*)(B_VT(F) + ((size_t)c * 2048 + dv) * 64 + 8 * t8) = lo;
            *(u32x4*)(B_VT(F) + ((size_t)c * 2048 + dv + 1) * 64 + 8 * t8) = hi;
        }
    }
}

__device__ __forceinline__ void post_phase(Frame& F, int l, float lam_init, const float* gla_g, const float* dlam, const float* diff_g) {
    int lane_ = hw_lane(); asm volatile("" : "+v"(lane_));
    const int gw = F.vcu * NWAVES + F.wave, NGW = F.G * NWAVES, lane = lane_;
    float lam;
    { const float* lp = dlam + (size_t)l * 512;
      const float p0 = lp[lane] * lp[128 + lane] + lp[64 + lane] * lp[192 + lane];
      const float p1 = lp[256 + lane] * lp[384 + lane] + lp[320 + lane] * lp[448 + lane];
      lam = expf(wave_sum(p0)) - expf(wave_sum(p1)) + lam_init; }
    { const float* g = gla_g + (size_t)l * 512;
      const f32x4 ga = *(const f32x4*)(g + 8 * lane), gb = *(const f32x4*)(g + 8 * lane + 4);
      for (int u0 = gw; u0 < SEQ * 4; u0 += 2 * NGW) {
          f32x4 a[2], b[2]; u32x4 gr[2]; float ss[2];
#pragma unroll
          for (int k = 0; k < 2; ++k) { const int u = u0 + k * NGW, t = u >> 2, hd = u & 3;
              const float* src = B_OA(F) + (size_t)t * 2048 + hd * 512 + 8 * lane;
              a[k] = *(const f32x4*)src; b[k] = *(const f32x4*)(src + 4);
              gr[k] = *(const u32x4*)(B_H(F) + (size_t)t * NPAD + C_AG + hd * 512 + 8 * lane);
              ss[k] = (a[k][0] * a[k][0] + a[k][1] * a[k][1]) + (a[k][2] * a[k][2] + a[k][3] * a[k][3]) + (b[k][0] * b[k][0] + b[k][1] * b[k][1]) + (b[k][2] * b[k][2] + b[k][3] * b[k][3]); }
          wave_sum2(ss[0], ss[1]);
#pragma unroll
          for (int k = 0; k < 2; ++k) { const int u = u0 + k * NGW, t = u >> 2, hd = u & 3;
              const float rs = rsqrtf(ss[k] * (1.f / 512.f) + 1e-6f);
              u32x4 o;
              o.x = cvtpk_c(a[k][0] * rs * ga[0] * silu(bflo(gr[k].x)), a[k][1] * rs * ga[1] * silu(bfhi(gr[k].x)));
              o.y = cvtpk_c(a[k][2] * rs * ga[2] * silu(bflo(gr[k].y)), a[k][3] * rs * ga[3] * silu(bfhi(gr[k].y)));
              o.z = cvtpk_c(b[k][0] * rs * gb[0] * silu(bflo(gr[k].z)), b[k][1] * rs * gb[1] * silu(bfhi(gr[k].z)));
              o.w = cvtpk_c(b[k][2] * rs * gb[2] * silu(bflo(gr[k].w)), b[k][3] * rs * gb[3] * silu(bfhi(gr[k].w)));
              *(u32x4*)(B_O(F) + (size_t)t * DM + hd * 512 + 8 * lane) = o; }
      } }
    { const float* g = diff_g + (size_t)l * 256;
      const f32x4 g4 = *(const f32x4*)(g + 4 * lane); const float post = 1.f - lam_init;
      for (int u0 = gw; u0 < SEQ * 4; u0 += 2 * NGW) {
          f32x4 d[2]; u32x2 gr[2]; float ss[2];
#pragma unroll
          for (int k = 0; k < 2; ++k) { const int u = u0 + k * NGW, t = u >> 2, hd = u & 3;
              const float* src = B_OD(F) + (size_t)t * 2048 + hd * 512 + 4 * lane;
              const f32x4 a0 = *(const f32x4*)src, a1 = *(const f32x4*)(src + 256);
              gr[k] = *(const u32x2*)(B_H(F) + (size_t)t * NPAD + C_BG + hd * 256 + 4 * lane);
              d[k] = a0 - a1 * lam;
              ss[k] = (d[k][0] * d[k][0] + d[k][1] * d[k][1]) + (d[k][2] * d[k][2] + d[k][3] * d[k][3]); }
          wave_sum2(ss[0], ss[1]);
#pragma unroll
          for (int k = 0; k < 2; ++k) { const int u = u0 + k * NGW, t = u >> 2, hd = u & 3;
              const float rs = rsqrtf(ss[k] * (1.f / 256.f) + 1e-6f) * post;
              u32x2 o;
              o.x = cvtpk_c(d[k][0] * rs * g4[0] * silu(bflo(gr[k].x)), d[k][1] * rs * g4[1] * silu(bfhi(gr[k].x)));
              o.y = cvtpk_c(d[k][2] * rs * g4[2] * silu(bflo(gr[k].y)), d[k][3] * rs * g4[3] * silu(bfhi(gr[k].y)));
              *(u32x2*)(B_O(F) + (size_t)t * DM + 2048 + hd * 256 + 4 * lane) = o; }
      } }
}

__device__ __forceinline__ void ln_phase(Frame& F, int l, const float* ln_g, const float* ln_b, float* outp, bool dry) {
    int lane_ = hw_lane(); asm volatile("" : "+v"(lane_));
    const int gw = F.vcu * NWAVES + F.wave, NGW = F.G * NWAVES, lane = lane_;
    const float* g = ln_g + (size_t)l * DM; const float* b = ln_b + (size_t)l * DM;
    float* dst = dry ? B_OA(F) : ((l == DEPTH - 1) ? outp : B_XF(F));
    for (int t = gw; t < SEQ; t += NGW) {
        const f32x4* xr = (const f32x4*)(B_XF(F) + (size_t)t * DM) + lane;
        f32x4 v[16]; float s = 0.f;
#pragma unroll
        for (int j = 0; j < 16; ++j) { v[j] = xr[64 * j]; s += (v[j][0] + v[j][1]) + (v[j][2] + v[j][3]); }
        const float mean = wave_sum(s) * (1.f / DM); float s2 = 0.f;
#pragma unroll
        for (int j = 0; j < 16; ++j) { v[j] = v[j] - mean; s2 += (v[j][0] * v[j][0] + v[j][1] * v[j][1]) + (v[j][2] * v[j][2] + v[j][3] * v[j][3]); }
        const float rstd = rsqrtf(wave_sum(s2) * (1.f / DM) + 1e-5f);
        f32x4* orow = (f32x4*)(dst + (size_t)t * DM) + lane;
        u32x2* brow = (u32x2*)(B_XB(F) + (size_t)t * DM) + lane;
#pragma unroll
        for (int j = 0; j < 16; ++j) {
            const f32x4 gg = *((const f32x4*)g + lane + 64 * j), bb = *((const f32x4*)b + lane + 64 * j);
            const f32x4 y = v[j] * rstd * gg + bb;
            orow[64 * j] = y;
            u32x2 w; w.x = cvtpk_c(y[0], y[1]); w.y = cvtpk_c(y[2], y[3]); brow[64 * j] = w;
        }
    }
}
namespace gla {
constexpr int KD_ROW = 144, Q_ROW = 528, V_ROW = 144;
constexpr int L_KD = 0, L_Q = L_KD + 256 * KD_ROW, L_V = L_Q + 64 * Q_ROW, L_DEC = L_V + 128 * V_ROW, L_END = L_DEC + 1024;
}
static_assert(gla::L_END <= MISC_OFF, "GLA LDS map");
__device__ __forceinline__ void gla_unit(Frame& F, int unit) {
    using namespace gla;
    int tid_ = (F.wave * 64 + hw_lane()); asm volatile("" : "+v"(tid_));
    const int tid = tid_, lane = tid & 63, c16 = lane & 15, g = lane >> 4, wave = F.wave;
    const int head = unit >> 2, blk = unit & 3;
    const int dv0 = 128 * blk + 16 * wave;
    LAS unsigned char* lds = F.lds;
    f32x4 S[16];
#pragma unroll
    for (int T = 0; T < 16; ++T) S[T] = (f32x4){0.f, 0.f, 0.f, 0.f};
    const bf16_t* kd_g = B_KDT(F) + (size_t)head * 256 * 64 + (size_t)tid * 8;
    const bf16_t* q_g = B_H(F) + (size_t)(tid >> 5) * NPAD + C_AQ + head * 256 + (tid & 31) * 8;
    const bf16_t* v_g = B_VT(F) + ((size_t)head * 512 + 128 * blk) * 64 + (size_t)tid * 8;
    const float* d_g = B_DEC(F) + head * 256 + (tid & 63) * 4;
    const int kd_w = (tid >> 3) * KD_ROW + (tid & 7) * 16;
    const int q_w = (tid >> 5) * Q_ROW + (tid & 31) * 16;
    const int v_w = (tid >> 3) * V_ROW + (tid & 7) * 16;
    u32x4 skd[4], sq[4], sv[2]; f32x4 sd;
#define GLA_LOAD(c_) do { _Pragma("unroll") for (int i = 0; i < 4; ++i) skd[i] = *(const u32x4*)(kd_g + (size_t)(c_) * 1024 * 64 + i * 4096); \
        _Pragma("unroll") for (int i = 0; i < 4; ++i) sq[i] = *(const u32x4*)(q_g + (size_t)(64 * (c_) + 16 * i) * NPAD);                        \
        _Pragma("unroll") for (int i = 0; i < 2; ++i) sv[i] = *(const u32x4*)(v_g + (size_t)(c_) * 2048 * 64 + i * 4096);                        \
        if (tid < 64) sd = *(const f32x4*)(d_g + (size_t)(c_) * 1024); } while (0)
#define GLA_WRITE() do { _Pragma("unroll") for (int i = 0; i < 4; ++i) *(LAS u32x4*)(lds + L_KD + kd_w + i * 64 * KD_ROW) = skd[i];            \
        _Pragma("unroll") for (int i = 0; i < 4; ++i) *(LAS u32x4*)(lds + L_Q + q_w + i * 16 * Q_ROW) = sq[i];                                   \
        _Pragma("unroll") for (int i = 0; i < 2; ++i) *(LAS u32x4*)(lds + L_V + v_w + i * 64 * V_ROW) = sv[i];                                   \
        if (tid < 64) *(LAS f32x4*)(lds + L_DEC + tid * 16) = sd; } while (0)
    const int a_rd = L_KD + c16 * KD_ROW + 16 * g;
    const int b_rd = L_V + (16 * wave + c16) * V_ROW + 16 * g;
    const int q_rd = L_Q + c16 * Q_ROW + 8 * g;
    const int d_rd = L_DEC + 16 * g;
    float* o_l = B_OA(F) + (size_t)(4 * g) * 2048 + head * 512 + dv0 + c16;
    GLA_LOAD(0);
    __syncthreads();
    GLA_WRITE();
    for (int c = 0; c < NCHUNK; ++c) {
        __syncthreads();
        if (c + 1 < NCHUNK) GLA_LOAD(c + 1);
        const bf16x8 vb0 = *(const LAS bf16x8*)(lds + b_rd), vb1 = *(const LAS bf16x8*)(lds + b_rd + 64);
#pragma unroll
        for (int T4 = 0; T4 < 4; ++T4) {
            bf16x8 a[4][2]; f32x4 d4[4];
#pragma unroll
            for (int i = 0; i < 4; ++i) { const int T = 4 * T4 + i;
                a[i][0] = *(const LAS bf16x8*)(lds + a_rd + T * 16 * KD_ROW); a[i][1] = *(const LAS bf16x8*)(lds + a_rd + T * 16 * KD_ROW + 64);
                d4[i] = *(const LAS f32x4*)(lds + d_rd + 64 * T); }
#pragma unroll
            for (int i = 0; i < 4; ++i) { const int T = 4 * T4 + i;
                f32x4 acc = (f32x4){0.f, 0.f, 0.f, 0.f};
                acc = MFMA16(a[i][0], vb0, acc); acc = MFMA16(a[i][1], vb1, acc);
                S[T] = S[T] * d4[i] + acc; }
        }
        bf16x8 sb[8];
#pragma unroll
        for (int s = 0; s < 8; ++s) sb[s] = pack8f(S[2 * s][0], S[2 * s][1], S[2 * s][2], S[2 * s][3], S[2 * s + 1][0], S[2 * s + 1][1], S[2 * s + 1][2], S[2 * s + 1][3]);
#pragma unroll
        for (int tt = 0; tt < 4; ++tt) {
            u32x2 ql[8], qh[8];
#pragma unroll
            for (int s = 0; s < 8; ++s) { ql[s] = *(const LAS u32x2*)(lds + q_rd + tt * 16 * Q_ROW + 64 * s); qh[s] = *(const LAS u32x2*)(lds + q_rd + tt * 16 * Q_ROW + 64 * s + 32); }
            f32x4 acc = (f32x4){0.f, 0.f, 0.f, 0.f};
#pragma unroll
            for (int s = 0; s < 8; ++s) { const u32x4 aw = {ql[s].x, ql[s].y, qh[s].x, qh[s].y}; acc = MFMA16(__builtin_bit_cast(bf16x8, aw), sb[s], acc); }
            float* op = o_l + (size_t)(64 * c + 16 * tt) * 2048;
#pragma unroll
            for (int r = 0; r < 4; ++r) op[(size_t)r * 2048] = acc[r] * 0.0625f;
        }
        __syncthreads();
        if (c + 1 < NCHUNK) GLA_WRITE();
    }
#undef GLA_LOAD
#undef GLA_WRITE
}
__device__ __forceinline__ unsigned f2key(float s) { const unsigned b = __float_as_uint(s); return b ^ ((b >> 31) ? 0xFFFFFFFFu : 0x80000000u); }
__device__ __forceinline__ unsigned half_of(unsigned long long b, int hh) { return hh ? (unsigned)(b >> 32) : (unsigned)b; }
template <int EPL, int NB>
__device__ __forceinline__ void compactK(LAS unsigned* cv, int& cnt, unsigned& thr, int lane32, int hh) {
    unsigned k[EPL];
#pragma unroll
    for (int i = 0; i < EPL; ++i) { const int e = lane32 + 32 * i; const unsigned v = cv[e]; k[i] = (e < cnt) ? v : 0u; }
    unsigned T = 0u;
    for (int b = 31; b >= 32 - NB; --b) {
        const unsigned cand = T | (1u << b); int clo = 0, chi = 0;
#pragma unroll
        for (int i = 0; i < EPL; ++i) { const unsigned long long m = __ballot(k[i] >= cand); clo += __popc((unsigned)m); chi += __popc((unsigned)(m >> 32)); }
        if ((hh ? chi : clo) >= 256) T = cand;
        if (NB == 32 && clo == 256 && chi == 256) break;
    }
    const unsigned ltm = (1u << lane32) - 1u;
    int kept = 0;
#pragma unroll
    for (int i = 0; i < EPL; ++i) {
        const bool keep = (k[i] >= T) && (k[i] != 0u);
        const unsigned mk = half_of(__ballot(keep), hh);
        const int pos = kept + __popc(mk & ltm);
        if (keep) cv[pos] = k[i];
        kept += __popc(mk);
    }
    cnt = kept; thr = (NB == 32) ? T : (T ? T - 1u : 0u);
}
__device__ __forceinline__ int goff(int row, int ch) { return 512 * row + 16 * ((ch & 16) | ((ch & 15) ^ (((row & 3) << 2) | (((row >> 2) & 1) << 1)))); }

#ifndef SP_REPF
#define SP_REPF 1
#endif
#ifndef SP_REPB
#define SP_REPB 1
#endif
#ifndef SP_REPK
#define SP_REPK 1
#endif
#ifndef SP_REPX
#define SP_REPX 1
#endif
constexpr int SP_CAND = 0, SP_OL = 65536, SP_SEL = 131072, SP_END = SP_SEL + 8192;
static_assert(SP_END <= MISC_OFF, "sparse LDS map");
__device__ __forceinline__ void sparse_unit(Frame& F, int l, int unit) {
    int tid_ = (F.wave * 64 + hw_lane()); asm volatile("" : "+v"(tid_));
    const int tid = tid_, lane = tid & 63, wave = F.wave, r32 = lane & 31, hh = lane >> 5, c16 = lane & 15, g = lane >> 4;
    const int t0 = 16 * unit, tq0 = t0 + 2 * wave;
    const int N = 64 * ((t0 >> 6) + 1), nkb = N >> 5, ntile = (nkb + 7) >> 3;
    LAS unsigned char* reg = F.lds + SP_CAND + wave * 8192;
    LAS unsigned* cv = (LAS unsigned*)(reg + hh * 4096);
    LAS unsigned short* sel = (LAS unsigned short*)(F.lds + SP_SEL + wave * 1024);
    const bf16_t* H = B_H(F);
    int cnt = 0;
    {
        const int qq = (r32 >> 2) & 1, hd = (r32 & 3) + 4 * (r32 >> 3);
        bf16x8 A[4];
#pragma unroll
        for (int s = 0; s < 4; ++s) A[s] = *(const bf16x8*)(H + (size_t)(tq0 + qq) * NPAD + C_CIQ + hd * 64 + 16 * s + 8 * hh);
        float wv[16];
        { const bf16_t* wp = H + (size_t)(tq0 + hh) * NPAD + C_CIW;
          const bf16x8 w0 = *(const bf16x8*)wp, w1 = *(const bf16x8*)(wp + 8);
#pragma unroll
          for (int j = 0; j < 8; ++j) { wv[j] = bf2f((unsigned short)w0[j]) * 0.03125f; wv[8 + j] = bf2f((unsigned short)w1[j]) * 0.03125f; } }
        unsigned thr = 0u;
        const unsigned ltm = (1u << r32) - 1u;
        const bf16_t* kg = B_IKN(F) + (size_t)tid * 8;
        const int kw = SP_OL + (tid >> 3) * 128 + (((tid & 7) ^ ((tid >> 4) & 7)) * 16);
        int brd[4];
#pragma unroll
        for (int s = 0; s < 4; ++s) brd[s] = SP_OL + r32 * 128 + (((2 * s + hh) ^ ((r32 >> 1) & 7)) * 16);
        u32x4 stgA[4], stgB[4];
#define SP_KLOAD(st_, t_) do { _Pragma("unroll") for (int i = 0; i < 4; ++i) st_[i] = *(const u32x4*)(kg + (size_t)(t_) * 256 * 64 + i * 4096); } while (0)
#define SP_KWRITE(st_, b_) do { _Pragma("unroll") for (int i = 0; i < 4; ++i) *(LAS u32x4*)(F.lds + (b_) * 32768 + kw + i * 8192) = st_[i]; } while (0)
#define SP_TILE(tile_, b_) do {                                                                                                                  \
            { const bool full_ = __any(cnt > 640); if (lane == 0) F.MISC[16 + (b_) * 8 + wave] = full_ ? 1u : 0u; }                              \
            for (int rb_ = 0; rb_ < SP_REPB; ++rb_) __syncthreads();                                                                             \
            bool squeeze_ = __any(F.MISC[16 + (b_) * 8 + (lane & 7)] != 0u);                                                                     \
            const int nb_ = (nkb - 8 * (tile_)) < 8 ? (nkb - 8 * (tile_)) : 8;                                                                   \
            LAS unsigned char* tb_ = F.lds + (b_) * 32768;                                                                                       \
            for (int kb = 0; kb < nb_; kb += 2) {                                                                                                \
                if (squeeze_ || __any(cnt > 960)) { squeeze_ = false;                                                                            \
                    for (int rc_ = 0; rc_ < SP_REPK; ++rc_) compactK<32, 14>(cv, cnt, thr, r32, hh);                                             \
                    if (__any(cnt > 800)) compactK<32, 32>(cv, cnt, thr, r32, hh); }                                                             \
                float sc0 = 0.f, sc1 = 0.f;                                                                                                      \
                for (int rx_ = 0; rx_ < SP_REPX; ++rx_) {                                                                                        \
                bf16x8 B0[4], B1[4];                                                                                                             \
                _Pragma("unroll") for (int s = 0; s < 4; ++s) { B0[s] = *(const LAS bf16x8*)(tb_ + brd[s] + kb * 4096); B1[s] = *(const LAS bf16x8*)(tb_ + brd[s] + kb * 4096 + 4096); } \
                asm volatile("" : "+v"(B0[0]), "+v"(B0[1]), "+v"(B0[2]), "+v"(B0[3]), "+v"(B1[0]), "+v"(B1[1]), "+v"(B1[2]), "+v"(B1[3]));      \
                f32x16 acc0 = {}, acc1 = {};                                                                                                     \
                _Pragma("unroll") for (int s = 0; s < 4; ++s) { acc0 = MFMA32(A[s], B0[s], acc0); acc1 = MFMA32(A[s], B1[s], acc1); }            \
                { f32x2 s0_ = {0.f, 0.f}, s1_ = {0.f, 0.f};                                                                                      \
                _Pragma("unroll") for (int j = 0; j < 16; j += 2) { const int a0 = __float_as_int(acc0[j]), a1 = __float_as_int(acc0[j + 1]), b0 = __float_as_int(acc1[j]), b1 = __float_as_int(acc1[j + 1]); \
                    const f32x2 r0_ = {__int_as_float(a0 > 0 ? a0 : 0), __int_as_float(a1 > 0 ? a1 : 0)}, r1_ = {__int_as_float(b0 > 0 ? b0 : 0), __int_as_float(b1 > 0 ? b1 : 0)}; \
                    const f32x2 w_ = {wv[j], wv[j + 1]};                                                                                         \
                    s0_ = __builtin_elementwise_fma(r0_, w_, s0_); s1_ = __builtin_elementwise_fma(r1_, w_, s1_); }                               \
                sc0 = s0_[0] + s0_[1]; sc1 = s1_[0] + s1_[1]; }                                                                                  \
                asm volatile("" : "+v"(sc0), "+v"(sc1)); }                                                                                       \
                const unsigned ib_ = 16383u - (unsigned)(256 * (tile_) + 32 * kb + r32);                                                         \
                const unsigned key0 = (f2key(sc0) & 0xFFFFC000u) | ib_, key1 = (f2key(sc1) & 0xFFFFC000u) | (ib_ - 32u);                         \
                const bool f0 = key0 > thr, f1 = key1 > thr;                                                                                     \
                const unsigned m0 = half_of(__ballot(f0), hh), m1 = half_of(__ballot(f1), hh);                                                   \
                const int pos0 = cnt + __popc(m0 & ltm), pos1 = cnt + __popc(m0) + __popc(m1 & ltm);                                             \
                if (f0) cv[pos0] = key0;                                                                                                         \
                if (f1) cv[pos1] = key1;                                                                                                         \
                cnt += __popc(m0) + __popc(m1);                                                                                                  \
            } } while (0)
        SP_KLOAD(stgA, 0);
        SP_KWRITE(stgA, 0);
        __builtin_amdgcn_s_waitcnt(0x0F70);
        if (ntile > 1) SP_KLOAD(stgB, 1);
        for (int tile = 0; tile < ntile; tile += 2) {
            if (tile + 2 < ntile) SP_KLOAD(stgA, tile + 2);
            SP_TILE(tile, 0);
            if (tile + 1 >= ntile) break;
            SP_KWRITE(stgB, 1);
            if (tile + 3 < ntile) SP_KLOAD(stgB, tile + 3);
            SP_TILE(tile + 1, 1);
            if (tile + 2 < ntile) SP_KWRITE(stgA, 0);
        }
#undef SP_TILE
#undef SP_KLOAD
#undef SP_KWRITE
        if (__any(cnt > 256)) {
            compactK<32, 14>(cv, cnt, thr, r32, hh);
            if (__any(cnt > 512)) compactK<32, 32>(cv, cnt, thr, r32, hh); else compactK<16, 32>(cv, cnt, thr, r32, hh);
        }
#pragma unroll
        for (int i = 0; i < 8; ++i) { const int e = r32 + 32 * i; if (e < cnt) sel[hh * 256 + e] = (unsigned short)(16383u - (cv[e] & 0x3FFFu)); }
    }
    LDS_WAIT();
    __syncthreads();
    const int ns0 = __builtin_amdgcn_readlane(cnt, 0), ns1 = __builtin_amdgcn_readlane(cnt, 32);
    const int q4 = c16 >> 2, p4 = c16 & 3;
    const int trx = (q4 << 2) | ((g & 1) << 1);
    const unsigned gb = (unsigned)(uintptr_t)reg;
    unsigned tra[8];
#pragma unroll
    for (int c = 0; c < 8; ++c) tra[c] = gb + 512 * (4 * g + q4) + 8 * (p4 & 1) + 16 * ((2 * c + (p4 >> 1)) ^ trx);
    LAS unsigned short* ol = (LAS unsigned short*)(F.lds + SP_OL + wave * 8192);
#pragma unroll 1
    for (int qi = 0; qi < 2; ++qi) {
        const int tq = tq0 + qi, ns = qi ? ns1 : ns0;
        bf16x8 qf[8];
#pragma unroll
        for (int s = 0; s < 8; ++s) { bf16x8 z = {}; qf[s] = (c16 < 8) ? *(const bf16x8*)(H + (size_t)tq * NPAD + C_CQ + c16 * 256 + 32 * s + 8 * g) : z; }
        f32x4 Z[16];
#pragma unroll
        for (int c = 0; c < 16; ++c) Z[c] = (f32x4){0.f, 0.f, 0.f, 0.f};
        float m = -1e30f, ls = 0.f;
        const int nsb = (ns + 15) >> 4;
        u32x4 datA[8], datB[8];
#define SP_GATHER(d_, j_) do { const int e_ = 16 * (j_) + c16; const int idx_ = (e_ < ns) ? (int)sel[qi * 256 + e_] : 0;                        \
            const bf16_t* rp_ = B_CN(F) + (size_t)idx_ * 256 + 8 * g;                                                                            \
            _Pragma("unroll") for (int i = 0; i < 8; ++i) d_[i] = *(const u32x4*)(rp_ + 32 * i); } while (0)
#define SP_GWRITE(d_) do { _Pragma("unroll") for (int i = 0; i < 8; ++i) *(LAS u32x4*)(reg + goff(c16, 4 * i + g)) = d_[i]; } while (0)
#define TRRD(dst, a, off) asm volatile("ds_read_b64_tr_b16 %0, %1 offset:%2" : "=&v"(dst) : "v"(a), "i"(off) : "memory")
#define SP_QK(d_) do { st = (f32x4){0.f, 0.f, 0.f, 0.f};                                                                                         \
            _Pragma("unroll") for (int s = 0; s < 8; ++s) st = MFMA16(__builtin_bit_cast(bf16x8, d_[s]), qf[s], st); } while (0)
#define SP_STEP(j_) do {                                                                                                                         \
            float mloc = -__builtin_inff();                                                                                                      \
            _Pragma("unroll") for (int r = 0; r < 4; ++r) { const int e = 16 * (j_) + 4 * g + r; const float v = (e < ns) ? st[r] * 0.0625f : -__builtin_inff(); st[r] = v; mloc = fmaxf(mloc, v); } \
            mloc = fmaxf(mloc, bperm_f(lane ^ 16, mloc)); mloc = fmaxf(mloc, bperm_f(lane ^ 32, mloc));                                                  \
            const float mn = fmaxf(m, mloc), alpha = __expf(m - mn);                                                                             \
            float ps = 0.f;                                                                                                                      \
            _Pragma("unroll") for (int r = 0; r < 4; ++r) { const float p = __expf(st[r] - mn); st[r] = p; ps += p; }                            \
            ps += bperm_f(lane ^ 16, ps); ps += bperm_f(lane ^ 32, ps);                                                                                  \
            ls = ls * alpha + ps; m = mn;                                                                                                        \
            const bf16x8 pa = pack8f(st[0], st[1], st[2], st[3], 0.f, 0.f, 0.f, 0.f);                                                            \
            if (__any(alpha < 1.f)) {                                                                                                            \
                float ar[4];                                                                                                                     \
                _Pragma("unroll") for (int r = 0; r < 4; ++r) ar[r] = bperm_f(4 * g + r, alpha);                                                  \
                _Pragma("unroll") for (int c = 0; c < 16; ++c) _Pragma("unroll") for (int r = 0; r < 4; ++r) Z[c][r] *= ar[r];                   \
            }                                                                                                                                    \
            _Pragma("unroll") for (int c = 0; c < 8; c += 2) {                                                                                   \
                s16x4 l0, l1, l2, l3;                                                                                                            \
                TRRD(l0, tra[c], 0); TRRD(l1, tra[c], 256); TRRD(l2, tra[c + 1], 0); TRRD(l3, tra[c + 1], 256);                                  \
                asm volatile("s_waitcnt lgkmcnt(0)" ::: "memory"); __builtin_amdgcn_sched_barrier(0);                                            \
                Z[c] = MFMA16(pa, ((bf16x8){l0[0], l0[1], l0[2], l0[3], 0, 0, 0, 0}), Z[c]);                                                     \
                Z[c + 8] = MFMA16(pa, ((bf16x8){l1[0], l1[1], l1[2], l1[3], 0, 0, 0, 0}), Z[c + 8]);                                             \
                Z[c + 1] = MFMA16(pa, ((bf16x8){l2[0], l2[1], l2[2], l2[3], 0, 0, 0, 0}), Z[c + 1]);                                             \
                Z[c + 9] = MFMA16(pa, ((bf16x8){l3[0], l3[1], l3[2], l3[3], 0, 0, 0, 0}), Z[c + 9]);                                             \
            } } while (0)
        f32x4 st;
        SP_GATHER(datA, 0);
        if (nsb > 1) SP_GATHER(datB, 1);
        for (int j = 0; j < nsb; j += 2) {
            SP_QK(datA); SP_GWRITE(datA);
            if (j + 2 < nsb) SP_GATHER(datA, j + 2);
            SP_STEP(j);
            if (j + 1 >= nsb) break;
            SP_QK(datB); SP_GWRITE(datB);
            if (j + 3 < nsb) SP_GATHER(datB, j + 3);
            SP_STEP(j + 1);
        }
#undef SP_QK
#undef SP_STEP
#undef TRRD
#undef SP_GATHER
#undef SP_GWRITE
        float inv[4];
#pragma unroll
        for (int r = 0; r < 4; ++r) inv[r] = 1.f / bperm_f(4 * g + r, ls);
        if (g < 2) {
#pragma unroll
            for (int c = 0; c < 16; ++c) {
                const int lat = 16 * c + c16;
#pragma unroll
                for (int r = 0; r < 4; ++r) ol[(qi * 8 + 4 * g + r) * 256 + lat] = (unsigned short)(cvtpk_c(Z[c][r] * inv[r], 0.f) & 0xffffu);
            }
        }
    }
    LDS_WAIT();
    __syncthreads();
    {
        const int hd = wave;
        bf16x8 A[8];
#pragma unroll
        for (int s = 0; s < 8; ++s) A[s] = *(const LAS bf16x8*)(F.lds + SP_OL + (c16 >> 1) * 8192 + (((c16 & 1) * 8 + hd) * 256 + 32 * s + 8 * g) * 2);
        const bf16_t* wb = B_WUVT(F) + ((size_t)(l * 8 + hd) * 128 + c16) * 256 + 8 * g;
#pragma unroll 1
        for (int n4 = 0; n4 < 2; ++n4) {
            bf16x8 b[4][8];
#pragma unroll
            for (int n = 0; n < 4; ++n)
#pragma unroll
                for (int s = 0; s < 8; ++s) b[n][s] = *(const bf16x8*)(wb + (size_t)(4 * n4 + n) * 16 * 256 + 32 * s);
#pragma unroll
            for (int n = 0; n < 4; ++n) {
                f32x4 acc = (f32x4){0.f, 0.f, 0.f, 0.f};
#pragma unroll
                for (int s = 0; s < 8; ++s) acc = MFMA16(A[s], b[n][s], acc);
#pragma unroll
                for (int r = 0; r < 4; ++r) { const int t = t0 + 4 * g + r; const int col = hd * 128 + 16 * (4 * n4 + n) + c16;
                    const float gt = bf2f(H[(size_t)t * NPAD + C_CG + col]);
                    B_O(F)[(size_t)t * DM + 3072 + col] = (bf16_t)(cvtpk_c(acc[r] * silu(gt), 0.f) & 0xffffu); }
            }
        }
    }
}
namespace da2 {
constexpr int VB = 32768, KB0 = 98304, KBS = 16384;
constexpr float C2 = 0.08838834764831845f * 1.4426950408889634f;
static_assert(KB0 + 3 * KBS <= MISC_OFF, "da2 LDS map");
__device__ __forceinline__ void block(Frame& F, int id) {
    int tid_ = F.wave * 64 + hw_lane(); asm volatile("" : "+v"(tid_));
    const int tid = tid_, lane = tid & 63, c16 = lane & 15, g = lane >> 4, wave = F.wave;
    const int qb = 127 - (id >> 3), hm = id & 7, hd = hm >> 1, mp = hm & 1;
    const int P0 = 128 * qb, NT = 2 * qb + 2;
    const int cw = (P0 + 16 * wave) >> 6;
    const bf16_t* H = B_H(F);
    LAS unsigned char* lds = F.lds;
    bf16x8 qf[4];
#pragma unroll
    for (int s = 0; s < 4; ++s) qf[s] = *(const bf16x8*)(H + (size_t)(P0 + 16 * wave + c16) * NPAD + C_BQ + hd * 256 + mp * 128 + 32 * s + 8 * g);
    const bf16_t* Kb = H + C_BK + hd * 256 + mp * 128;
    const bf16_t* Vb = H + C_BV + hd * 256;
    int kofs[2], vofs[4];
#pragma unroll
    for (int i = 0; i < 2; ++i) { const int row = 8 * wave + 4 * i + (lane >> 4); kofs[i] = row * NPAD + 8 * ((lane & 15) ^ (row & 15)); }
#pragma unroll
    for (int i = 0; i < 4; ++i) { const int row = 8 * wave + 2 * i + (lane >> 5), sl = lane & 31; vofs[i] = row * NPAD + 8 * ((sl & 16) | ((sl & 15) ^ (((row & 3) << 2) | (((row >> 2) & 1) << 1)))); }
    int ksw[4];
#pragma unroll
    for (int s = 0; s < 4; ++s) ksw[s] = KB0 + c16 * 256 + (((4 * s + g) ^ c16) * 16);
    const int q4 = c16 >> 2, p4 = c16 & 3, trx = (q4 << 2) | ((g & 1) << 1);
    const unsigned lb = (unsigned)(uintptr_t)lds;
    unsigned tra[8];
#pragma unroll
    for (int c = 0; c < 8; ++c) { tra[c] = lb + 512 * (4 * g + q4) + 8 * (p4 & 1) + 16 * ((2 * c + (p4 >> 1)) ^ trx); }
    f32x4 O[16];
#pragma unroll
    for (int c = 0; c < 16; ++c) O[c] = (f32x4){0.f, 0.f, 0.f, 0.f};
    float m = -1e30f, l = 0.f;
    f32x4 st[4], sn[4];
#define DA_DMAK(t_, slot_) do { const int tt_ = (t_) < NT ? (t_) : NT - 1; _Pragma("unroll") for (int i = 0; i < 2; ++i)                                \
        __builtin_amdgcn_global_load_lds((const unsigned*)(Kb + (size_t)(64 * tt_) * NPAD + kofs[i]), (LAS unsigned*)(lds + KB0 + (slot_) * KBS + (2 * wave + i) * 1024), 16, 0, 0); } while (0)
#define DA_DMAV(t_, buf_) do { const int tt_ = (t_) < NT ? (t_) : NT - 1; _Pragma("unroll") for (int i = 0; i < 4; ++i)                                 \
        __builtin_amdgcn_global_load_lds((const unsigned*)(Vb + (size_t)(64 * tt_) * NPAD + vofs[i]), (LAS unsigned*)(lds + (buf_) * VB + (4 * wave + i) * 1024), 16, 0, 0); } while (0)
#define DA_TR(dst, a, off) asm volatile("ds_read_b64_tr_b16 %0, %1 offset:%2" : "=&v"(dst) : "v"(a), "i"(off) : "memory")
#define DA_TR8(A_, c_, o_, L0, H0, L1, H1, L2, H2, L3, H3) do { const unsigned ta_ = tra[c_] + (A_);                                             \
        DA_TR(L0, ta_, (o_) + 0); DA_TR(H0, ta_, (o_) + 8192); DA_TR(L1, ta_, (o_) + 256); DA_TR(H1, ta_, (o_) + 8448);                           \
        DA_TR(L2, ta_, (o_) + 16384); DA_TR(H2, ta_, (o_) + 24576); DA_TR(L3, ta_, (o_) + 16640); DA_TR(H3, ta_, (o_) + 24832); } while (0)
#define DA_MM4(c_, L0, H0, L1, H1, L2, H2, L3, H3) do {                                                                                          \
        O[c_] = MFMA16(pa0, ((bf16x8){L0[0], L0[1], L0[2], L0[3], H0[0], H0[1], H0[2], H0[3]}), O[c_]);                                          \
        O[c_ + 8] = MFMA16(pa0, ((bf16x8){L1[0], L1[1], L1[2], L1[3], H1[0], H1[1], H1[2], H1[3]}), O[c_ + 8]);                                  \
        O[c_] = MFMA16(pa1, ((bf16x8){L2[0], L2[1], L2[2], L2[3], H2[0], H2[1], H2[2], H2[3]}), O[c_]);                                          \
        O[c_ + 8] = MFMA16(pa1, ((bf16x8){L3[0], L3[1], L3[2], L3[3], H3[0], H3[1], H3[2], H3[3]}), O[c_ + 8]); } while (0)
#define DA_WAITL(n_) do { asm volatile("s_waitcnt lgkmcnt(" #n_ ")" ::: "memory"); __builtin_amdgcn_sched_barrier(0); } while (0)
#define DA_QK(dst_, koff_) do {                                                                                                                  \
        _Pragma("unroll") for (int T = 0; T < 4; ++T) { bf16x8 a_[4];                                                                            \
            _Pragma("unroll") for (int s = 0; s < 4; ++s) a_[s] = *(const LAS bf16x8*)(lds + (koff_) + ksw[s] + T * 4096);                       \
            asm volatile("" : "+v"(a_[0]), "+v"(a_[1]), "+v"(a_[2]), "+v"(a_[3]));                                                               \
            dst_[T] = (f32x4){0.f, 0.f, 0.f, 0.f};                                                                                               \
            _Pragma("unroll") for (int s = 0; s < 4; ++s) dst_[T] = MFMA16(a_[s], qf[s], dst_[T]); } } while (0)
#define DA_SM() \
        float mloc = st[0][0];                                                                                                                   \
        _Pragma("unroll") for (int T = 0; T < 4; ++T) _Pragma("unroll") for (int r = 0; r < 4; ++r) mloc = fmaxf(mloc, st[T][r]);                \
        mloc = fmaxf(mloc, bperm_f(lane ^ 16, mloc)); mloc = fmaxf(mloc, bperm_f(lane ^ 32, mloc));                                              \
        const float mn = fmaxf(m, mloc), alpha = __builtin_amdgcn_exp2f((m - mn) * C2), mnL = -mn * C2;                                         \
        float ps = 0.f;                                                                                                                          \
        _Pragma("unroll") for (int T = 0; T < 4; ++T) _Pragma("unroll") for (int r = 0; r < 4; ++r) { const float p = __builtin_amdgcn_exp2f(fmaf(st[T][r], C2, mnL)); st[T][r] = p; ps += p; } \
        ps += bperm_f(lane ^ 16, ps); ps += bperm_f(lane ^ 32, ps);                                                                              \
        l = l * alpha + ps; m = mn;                                                                                                              \
        const bf16x8 pa0 = pack8f(st[0][0], st[0][1], st[0][2], st[0][3], st[1][0], st[1][1], st[1][2], st[1][3]);                               \
        const bf16x8 pa1 = pack8f(st[2][0], st[2][1], st[2][2], st[2][3], st[3][0], st[3][1], st[3][2], st[3][3]);
#define DA_RESC() do { if (__any(alpha < 1.f)) { float ar[4];                                                                                    \
            _Pragma("unroll") for (int r = 0; r < 4; ++r) ar[r] = bperm_f(4 * g + r, alpha);                                                     \
            _Pragma("unroll") for (int c = 0; c < 16; ++c) _Pragma("unroll") for (int r = 0; r < 4; ++r) O[c][r] *= ar[r]; } } while (0)
#define DA_PV(A_, o_) do { s16x4 xl0, xh0, xl1, xh1, xl2, xh2, xl3, xh3, yl0, yh0, yl1, yh1, yl2, yh2, yl3, yh3;                                 \
          LDS_WAIT();                                                                                                                            \
          DA_TR8(A_, 0, o_, xl0, xh0, xl1, xh1, xl2, xh2, xl3, xh3);                                                                             \
          DA_TR8(A_, 1, o_, yl0, yh0, yl1, yh1, yl2, yh2, yl3, yh3); DA_WAITL(8); DA_MM4(0, xl0, xh0, xl1, xh1, xl2, xh2, xl3, xh3);             \
          DA_TR8(A_, 2, o_, xl0, xh0, xl1, xh1, xl2, xh2, xl3, xh3); DA_WAITL(8); DA_MM4(1, yl0, yh0, yl1, yh1, yl2, yh2, yl3, yh3);             \
          DA_TR8(A_, 3, o_, yl0, yh0, yl1, yh1, yl2, yh2, yl3, yh3); DA_WAITL(8); DA_MM4(2, xl0, xh0, xl1, xh1, xl2, xh2, xl3, xh3);             \
          DA_TR8(A_, 4, o_, xl0, xh0, xl1, xh1, xl2, xh2, xl3, xh3); DA_WAITL(8); DA_MM4(3, yl0, yh0, yl1, yh1, yl2, yh2, yl3, yh3);             \
          DA_TR8(A_, 5, o_, yl0, yh0, yl1, yh1, yl2, yh2, yl3, yh3); DA_WAITL(8); DA_MM4(4, xl0, xh0, xl1, xh1, xl2, xh2, xl3, xh3);             \
          DA_TR8(A_, 6, o_, xl0, xh0, xl1, xh1, xl2, xh2, xl3, xh3); DA_WAITL(8); DA_MM4(5, yl0, yh0, yl1, yh1, yl2, yh2, yl3, yh3);             \
          DA_TR8(A_, 7, o_, yl0, yh0, yl1, yh1, yl2, yh2, yl3, yh3); DA_WAITL(8); DA_MM4(6, xl0, xh0, xl1, xh1, xl2, xh2, xl3, xh3);             \
          DA_WAITL(0); DA_MM4(7, yl0, yh0, yl1, yh1, yl2, yh2, yl3, yh3); } while (0)
#define DA_ITER(t_, p_, A_, o_) do {                                                                                                             \
        asm volatile("s_waitcnt vmcnt(6)" ::: "memory"); __builtin_amdgcn_s_barrier(); asm volatile("" ::: "memory");                            \
        DA_DMAK((t_) + 3, (p_)); DA_DMAV((t_) + 2, ((p_) + 2) % 3);                                                                              \
        const bool nxt_ = ((t_) + 1 < NT) && ((t_) + 1 <= cw);                                                                                   \
          \
        if (nxt_) DA_QK(sn, (((p_) + 1) % 3) * KBS);                                                                                             \
        if ((t_) <= cw) { DA_SM() DA_RESC(); DA_PV(A_, o_); }                                                                                    \
        if (nxt_) { _Pragma("unroll") for (int T = 0; T < 4; ++T) st[T] = sn[T]; } } while (0)
    asm volatile("s_waitcnt vmcnt(0)" ::: "memory");
    __syncthreads();
    DA_DMAK(0, 0); DA_DMAV(0, 0); DA_DMAK(1, 1);
    DA_DMAK(2, 2); DA_DMAV(1, 1);
    asm volatile("s_waitcnt vmcnt(6)" ::: "memory"); __builtin_amdgcn_s_barrier(); asm volatile("" ::: "memory");
    DA_QK(st, 0);
    for (int t = 0; t < NT; t += 3) {
        DA_ITER(t, 0, 0u, 0);
        if (t + 1 >= NT) break;
        DA_ITER(t + 1, 1, 0u, 32768);
        if (t + 2 >= NT) break;
        DA_ITER(t + 2, 2, 65536u, 0);
    }
    asm volatile("s_waitcnt vmcnt(0)" ::: "memory");
#undef DA_ITER
#undef DA_PV
#undef DA_RESC
#undef DA_SM
#undef DA_QK
#undef DA_TR8
#undef DA_MM4
#undef DA_WAITL
#undef DA_TR
#undef DA_DMAK
#undef DA_DMAV
    float inv[4];
#pragma unroll
    for (int r = 0; r < 4; ++r) inv[r] = 1.f / bperm_f(4 * g + r, l);
    float* Op = B_OD(F) + (size_t)(P0 + 16 * wave + 4 * g) * 2048 + hd * 512 + mp * 256 + c16;
#pragma unroll
    for (int c = 0; c < 16; ++c)
#pragma unroll
        for (int r = 0; r < 4; ++r) Op[(size_t)r * 2048 + 16 * c] = O[c][r] * inv[r];
}
}
__device__ __forceinline__ dattn::BlockRef dattn_ref(const bf16_t* H, float* OD, int id) {
    dattn::BlockRef r; const int qb = 63 - (id >> 4), ph = id & 15, hd = ph >> 2, mp = (ph >> 1) & 1, e = ph & 1;
    r.Q = H + (size_t)(qb * 256) * NPAD + C_BQ + hd * 256 + mp * 128; r.K = H + C_BK + hd * 256 + mp * 128; r.V = H + C_BV + hd * 256 + e * 128;
    r.O = OD + (size_t)(qb * 256) * 2048 + hd * 512 + mp * 256 + e * 128; r.P0 = qb * 256; return r;
}
#ifndef REPBAR
#define REPBAR 1
#endif
#ifndef REPA
#define REPA 1
#endif
#ifndef REPB
#define REPB 1
#endif
#ifndef REPC
#define REPC 1
#endif
#ifndef REPG1
#define REPG1 1
#endif
#ifndef REPS
#define REPS 1
#endif
#ifndef MIXMASK
#define MIXMASK 7
#endif
__device__ __forceinline__ void mix_phase(Frame& F, int l) {
    if (MIXMASK & 1) for (int rep = 0; rep < REPA; ++rep) { const int qx = rep * 16 + l * 4 + 0;
        for (int u = grab(F, qx); u < 16; u = grab(F, qx)) gla_unit(F, u); }
#ifndef USE_DA2
#define USE_DA2 1
#endif
#if USE_DA2
    if (MIXMASK & 2) for (int rep = 0; rep < REPB; ++rep) { const int qx = rep * 16 + l * 4 + 1;
        for (int u = grab(F, qx); u < 1024; u = grab(F, qx)) da2::block(F, u);
        __syncthreads();
    }
#else
    if (MIXMASK & 2) for (int rep = 0; rep < REPB; ++rep) { const int qx = rep * 16 + l * 4 + 1;
        int cur = grab(F, qx);
        if (cur < 1024) {
            dattn::Seam S;
            dattn::BlockRef rc = dattn_ref(B_H(F), B_OD(F), cur);
            dattn::prime(rc, (char*)F.lds, S, F.wave);
            for (;;) {
                const int nx = grab(F, qx); const bool last = nx >= 1024;
                const dattn::BlockRef rn = last ? rc : dattn_ref(B_H(F), B_OD(F), nx);
                dattn::block(rc, rn, (char*)F.lds, S, F.wave);
                if (last) break;
                rc = rn;
            }
            VM_WAIT(); __syncthreads();
        }
    }
#endif
    if (MIXMASK & 4) for (int rep = 0; rep < REPC; ++rep) { const int qx = rep * 16 + l * 4 + 2;
        for (int u = grab(F, qx); u < SEQ / 16; u = grab(F, qx)) sparse_unit(F, l, SEQ / 16 - 1 - u); }
}

struct Args { const float* in[14]; float* out; unsigned char* ws; int ph_lo, ph_hi, li, pad; };
constexpr int NPHASE = 1 + 6 * DEPTH;
__global__ void __launch_bounds__(NWAVES * 64, 2) trunk_fwd(Args args) {
    extern __shared__ __attribute__((aligned(16))) unsigned char lds[];
    Frame F;
    F.lds = (LAS unsigned char*)lds;
    F.MISC = (volatile LAS unsigned*)(F.lds + MISC_OFF);
    F.wave = __builtin_amdgcn_readfirstlane((int)threadIdx.x >> 6);
    F.G = gridDim.x; { const int bx = blockIdx.x; F.vcu = (F.G % 8 == 0) ? (bx % 8) * (F.G / 8) + bx / 8 : bx; }
    F.ws = args.ws;
    F.ctl = (gu32*)(args.ws + WS_CTL);
    if (threadIdx.x < 128) ((LAS unsigned*)(F.lds + MISC_OFF))[threadIdx.x] = 0u;
    __syncthreads();
    XcdBarrier bar = xcd_barrier_post((unsigned*)(F.ctl + CW_BAR), F.MISC + 0);
#ifndef PMASK
#define PMASK 0x7f
#endif
#define IN(k) true
#define SEAM(k) do { if ((k) + 1 < NPHASE) { XcdBarrier b2_ = bar; unsigned xx_ = b2_.x; asm volatile("" : "+s"(xx_)); b2_.x = xx_; for (int rb_ = 0; rb_ < REPBAR; ++rb_) xcd_barrier(b2_); } } while (0)
    if ((PMASK & 1) && IN(0)) { p0_prologue(F, args.in[0], args.in[1], args.in[2], args.in[11]); SEAM(0); }
    for (int l = 0; l < DEPTH; ++l) {
        const int pb = 1 + 6 * l;
        const float lam_init = 0.8f - 0.6f * expf(-0.3f * (float)l);
        if ((PMASK & 2) && IN(pb + 0)) {
            pg8::Gemm g{B_XB(F), B_WTIN(F) + (size_t)l * NPAD * DM, SEQ, NPAD, DM}; pg8::StaticOrder S; S.init(SEQ, NPAD, F.G, (int)blockIdx.x);
            pg8::EpiBf16Plain E{B_H(F), NPAD};
            for (int rep = 0; rep < REPG1; ++rep) pg8::gemm_phase<pg8::EpiBf16Plain, pg8::StaticOrder, true, true>(F.lds, g, S, E, F.wave);
            SEAM(pb + 0);
        }
        if ((PMASK & 4) && IN(pb + 1)) { for (int rep = 0; rep < REPS; ++rep) prep_phase(F, l, args.in[3], args.in[4], args.in[8], args.in[9], args.in[10]); SEAM(pb + 1); }
        if ((PMASK & 8) && IN(pb + 2)) { mix_phase(F, l); SEAM(pb + 2); }
        if ((PMASK & 16) && IN(pb + 3)) { for (int rep = 0; rep < REPS; ++rep) post_phase(F, l, lam_init, args.in[5], args.in[6], args.in[7]); SEAM(pb + 3); }
        if ((PMASK & 32) && IN(pb + 4)) {
            pg8::Gemm g{B_O(F), B_WTOUT(F) + (size_t)l * DM * DM, SEQ, DM, DM}; pg8::StaticOrder S; S.init(SEQ, DM, F.G, (int)blockIdx.x);
            pg8::EpiResid E{l == 0 ? args.in[0] : B_XF(F), B_XF(F), DM, 1.6817928305074290f};
            pg8::gemm_phase<pg8::EpiResid, pg8::StaticOrder, true, true>(F.lds, g, S, E, F.wave);
            SEAM(pb + 4);
        }
        if ((PMASK & 64) && IN(pb + 5)) {
#if defined(REPLN)
            ln_phase(F, l, args.in[12], args.in[13], args.out, true);
#endif
            ln_phase(F, l, args.in[12], args.in[13], args.out, false); SEAM(pb + 5); }
    }
#undef IN
#undef SEAM
}

#ifndef MK_N_LAUNCHES
#define MK_N_LAUNCHES 1
#endif
extern "C" void kernel_launch(void* const* d_in, const int* in_sizes, int n_in, void* d_out, int out_size, void* d_ws, size_t ws_size, hipStream_t stream) {
    static int grid = 0;
    if (grid == 0) {
        if (n_in != 14 || in_sizes[0] != SEQ * DM || out_size != SEQ * DM || ws_size < WS_END) {
            fprintf(stderr, "kernel_launch: shape mismatch (n_in %d, in0 %d, out %d, ws %zu; need ws >= %zu)\n", n_in, n_in > 0 ? in_sizes[0] : -1, out_size, ws_size, (size_t)WS_END); grid = -1; return; }
        int dev = 0, cus = 0, per_cu = 0;
        if (hipGetDevice(&dev) != hipSuccess || hipDeviceGetAttribute(&cus, hipDeviceAttributeMultiprocessorCount, dev) != hipSuccess) { grid = -1; return; }
        if (hipFuncSetAttribute((const void*)trunk_fwd, hipFuncAttributeMaxDynamicSharedMemorySize, LDS_BYTES) != hipSuccess) { fprintf(stderr, "kernel_launch: hipFuncSetAttribute failed\n"); grid = -1; return; }
        if (hipOccupancyMaxActiveBlocksPerMultiprocessor(&per_cu, (const void*)trunk_fwd, NWAVES * 64, LDS_BYTES) != hipSuccess || per_cu < 1)
            fprintf(stderr, "kernel_launch: occupancy query reports %d workgroups per CU\n", per_cu);
        (void)hipGetLastError();
        grid = cus;
    }
    if (grid < 0) return;
    if (hipMemsetAsync((char*)d_ws + WS_CTL, 0, CTL_ZERO_BYTES, stream) != hipSuccess) return;
    Args a{};
    for (int i = 0; i < 14; ++i) a.in[i] = (const float*)d_in[i];
    a.out = (float*)d_out; a.ws = (unsigned char*)d_ws;
    a.ph_lo = 0; a.ph_hi = NPHASE; a.li = 0; a.pad = 0;
    hipLaunchKernelGGL(trunk_fwd, dim3(grid), dim3(NWAVES * 64), LDS_BYTES, stream, a);
    const hipError_t le = hipPeekAtLastError();
    if (le != hipSuccess) fprintf(stderr, "kernel_launch: launch failed: %s\n", hipGetErrorName(le));
}
```

```cpp
#include <hip/hip_runtime.h>
#include <cstdio>
#include <cstdint>

#define GAS __attribute__((address_space(1)))
#define LAS __attribute__((address_space(3)))
typedef unsigned short bf16_t;
typedef short s16x4 __attribute__((ext_vector_type(4)));
typedef float f32x16 __attribute__((ext_vector_type(16)));
typedef unsigned u32x2 __attribute__((ext_vector_type(2)));
typedef GAS unsigned gu32;

__device__ __forceinline__ int hw_lane() { int r; asm volatile("v_mbcnt_lo_u32_b32 %0, -1, 0\n\tv_mbcnt_hi_u32_b32 %0, -1, %0" : "=v"(r)); return r; }

constexpr int SEQ = 16384, DM = 4096, DEPTH = 4, NIN = 14688, NPAD = 14848;
constexpr int CHUNK = 64, NCHUNK = SEQ / CHUNK;
constexpr int C_AQ = 0, C_AK = 1024, C_AV = 2048, C_AG = 4096, C_BQ = 6144, C_BK = 7168, C_BV = 8192, C_BG = 9216, C_CQ = 10240,
              C_CKV = 12288, C_CIQ = 12544, C_CG = 13568, C_CIK = 14592, C_AA = 14656, C_CIW = 14672;
__host__ __device__ __forceinline__ int srccol(int n) {
    if (n < 4096) return n;
    if (n < 6144) return n + 16;
    if (n < 13568) return n + 16;
    if (n < 14592) return n + 96;
    if (n < 14656) return n - 1008;
    if (n < 14672) return n - 10560;
    if (n < 14688) return n - 1024;
    return -1;
}
namespace pg8 {
#define PG8_LAS __attribute__((address_space(3)))
typedef unsigned short bf16_t;
typedef short bf16x8 __attribute__((ext_vector_type(8)));
typedef float f32x4 __attribute__((ext_vector_type(4)));
typedef unsigned u32x4 __attribute__((ext_vector_type(4)));
constexpr int BM = 256, BK = 64, HALF = 128, HTB = HALF * BK * 2  , STAGE_BYTES = 8 * HTB, NXCD = 8, WGM = 8;

__host__ __device__ __forceinline__ int lds_byte(int r, int c) { const int st = (r >> 4) * 2 + (c >> 5), rr = r & 15, cc = c & 31, ob = rr * 64 + cc * 2; return st * 1024 + (ob ^ (((ob >> 9) & 1) << 5)); }
__host__ __device__ __forceinline__ void stage_rc(int b, int& R, int& C) { const int st = b / 1024, sb = b % 1024, swz = sb ^ (((sb >> 9) & 1) << 5); R = (st >> 1) * 16 + swz / 64; C = (st & 1) * 32 + (swz % 64) / 2; }
__host__ __device__ __forceinline__ int perm32(int rho) { const int n = rho >> 4, i = rho & 15; return 8 * (i >> 2) + 4 * n + (i & 3); }

struct Unit { int pm, pn; };
struct Gemm { const bf16_t* A; const bf16_t* Bt; int M, N, K; };

struct StaticOrder {
    int nM, nN, nwg, G, c;
    __host__ __device__ void init(int M, int N, int G_, int c_) { nM = M / BM; nN = N / BM; nwg = nM * nN; G = G_; c = c_; }
    __host__ __device__ bool next(int i, Unit& u) const {
        const long L = (long)i * G + c; if (L >= nwg) return false;
        int wgid = (int)L; { const int q = nwg / NXCD, r = nwg % NXCD, xcd = wgid % NXCD, off = wgid / NXCD; wgid = (xcd < r ? xcd * (q + 1) : r * (q + 1) + (xcd - r) * q) + off; }
        const int nig = WGM * nN, gid = wgid / nig, fm = gid * WGM, gsz = (nM - fm) < WGM ? (nM - fm) : WGM;
        u.pm = fm + ((wgid % nig) % gsz); u.pn = (wgid % nig) / gsz; return true;
    }
    __device__ __forceinline__ void a_ready(const Unit&) const {}
    __device__ __forceinline__ void done(const Unit&) const {}
};

__device__ __forceinline__ unsigned cvt_pk_bf16(float lo, float hi) { unsigned r; asm volatile("v_cvt_pk_bf16_f32 %0, %1, %2" : "=v"(r) : "v"(lo), "v"(hi)); return r; }
typedef float f32x2 __attribute__((ext_vector_type(2)));
struct EpiBf16Plain {
    static constexpr bool PERM = true, AFTER_DRAIN = false;
    bf16_t* O; int ldc;
    __device__ __forceinline__ void operator()(const f32x4 (&acc)[2][2][4][2], const Unit& u, int wr, int wc, int fr, int fq) const {
        const int row0 = u.pm * BM + wr * 64 + fr, col0 = u.pn * BM + wc * 32 + 8 * fq;
#pragma unroll
        for (int ai = 0; ai < 2; ++ai)
#pragma unroll
            for (int m = 0; m < 4; ++m) { bf16_t* rowp = O + (size_t)(row0 + ai * HALF + m * 16) * ldc + col0;
#pragma unroll
                for (int bj = 0; bj < 2; ++bj) { const f32x4 v0 = acc[ai][bj][m][0], v1 = acc[ai][bj][m][1];
                    u32x4 w; w.x = cvt_pk_bf16(v0[0], v0[1]); w.y = cvt_pk_bf16(v0[2], v0[3]); w.z = cvt_pk_bf16(v1[0], v1[1]); w.w = cvt_pk_bf16(v1[2], v1[3]);
                    *(u32x4*)(rowp + bj * HALF) = w; } }
    }
};
struct EpiResid {
    static constexpr bool PERM = false, AFTER_DRAIN = false;
    const float* Xin; float* Xout; int ldc; float alpha;
    __device__ __forceinline__ void operator()(const f32x4 (&acc)[2][2][4][2], const Unit& u, int wr, int wc, int fr, int fq) const {
        const int row0 = u.pm * BM + wr * 64 + fr, col0 = u.pn * BM + wc * 32 + 4 * fq;
#pragma unroll
        for (int ai = 0; ai < 2; ++ai)
#pragma unroll
            for (int m = 0; m < 4; ++m) { const size_t off = (size_t)(row0 + ai * HALF + m * 16) * ldc + col0;
#pragma unroll
                for (int bj = 0; bj < 2; ++bj)
#pragma unroll
                    for (int n = 0; n < 2; ++n) { const f32x4 xi = *(const f32x4*)(Xin + off + bj * HALF + n * 16);
                        *(f32x4*)(Xout + off + bj * HALF + n * 16) = xi * alpha + acc[ai][bj][m][n]; }
                asm volatile("" ::: "memory"); }
    }
};
struct EpiResidB {
    static constexpr bool PERM = false, AFTER_DRAIN = false;
    const bf16_t* Xin; float* Xout; int ldc; float alpha;
    __device__ __forceinline__ void operator()(const f32x4 (&acc)[2][2][4][2], const Unit& u, int wr, int wc, int fr, int fq) const {
        const int row0 = u.pm * BM + wr * 64 + fr, col0 = u.pn * BM + wc * 32 + 4 * fq;
#pragma unroll
        for (int ai = 0; ai < 2; ++ai)
#pragma unroll
            for (int m = 0; m < 4; ++m) { const size_t off = (size_t)(row0 + ai * HALF + m * 16) * ldc + col0;
#pragma unroll
                for (int bj = 0; bj < 2; ++bj)
#pragma unroll
                    for (int n = 0; n < 2; ++n) { const unsigned long long w = *(const unsigned long long*)(Xin + off + bj * HALF + n * 16);
                        const unsigned lo = (unsigned)w, hi = (unsigned)(w >> 32);
                        const f32x4 xi = {__uint_as_float(lo << 16), __uint_as_float(lo & 0xffff0000u), __uint_as_float(hi << 16), __uint_as_float(hi & 0xffff0000u)};
                        *(f32x4*)(Xout + off + bj * HALF + n * 16) = xi * alpha + acc[ai][bj][m][n]; }
                asm volatile("" ::: "memory"); }
    }
};
template <class Epi, class Sched, bool ALIGN_EPI = false, bool SP2 = false>
__device__ __forceinline__ void gemm_phase(PG8_LAS unsigned char* lds, const Gemm g, const Sched& S, const Epi& E, int wave_id) {
    int tid_ = wave_id * 64 + hw_lane(); asm volatile("" : "+v"(tid_));
    const int tid = tid_, wid = __builtin_amdgcn_readfirstlane(tid >> 6), lane = tid & 63, wr = wid >> 2, wc = wid & 3, fr = lane & 15, fq = lane >> 4;
    const int K = g.K, nt = K / BK;
    unsigned voffA[2], voffB[2];
#pragma unroll
    for (int i = 0; i < 2; ++i) { int R, C; stage_rc(tid * 16 + i * 8192, R, C); const int Rb = Epi::PERM ? ((R & ~31) + perm32(R & 31)) : R;
        voffA[i] = (unsigned)(R * K + C) * 2u; voffB[i] = (unsigned)(Rb * K + C) * 2u; }
    const size_t kstep = (size_t)(BK * 2);
    const size_t hstep = (size_t)HALF * K * 2;
    const size_t tstep = 2 * hstep;
    const unsigned ldsw = (unsigned)wid * 1024u;
    const int aoff = lds_byte(wr * 64 + fr, fq * 8), boff = lds_byte(wc * 32 + fr, fq * 8);
#define PG8_SA(b, h) (((b) * 2 + (h)) * HTB)
#define PG8_SB(b, h) ((4 + (b) * 2 + (h)) * HTB)
#define PG8_STAGE(bufoff, gbase, voff) do { _Pragma("unroll") for (int _i = 0; _i < 2; ++_i) \
        __builtin_amdgcn_global_load_lds((const unsigned*)((const char*)(gbase) + (voff)[_i]), (PG8_LAS unsigned*)(lds + (bufoff) + ldsw + _i * 8192), 16, 0, 0); } while (0)
#define PG8_LDA(dst, b, h) do { _Pragma("unroll") for (int m = 0; m < 4; ++m) _Pragma("unroll") for (int k = 0; k < 2; ++k) dst[m][k] = *(const PG8_LAS bf16x8*)(lds + PG8_SA(b, h) + aoff + m * 2048 + k * 1024); } while (0)
#define PG8_LDB(dst, b, h) do { _Pragma("unroll") for (int n = 0; n < 2; ++n) _Pragma("unroll") for (int k = 0; k < 2; ++k) dst[n][k] = *(const PG8_LAS bf16x8*)(lds + PG8_SB(b, h) + boff + n * 2048 + k * 1024); } while (0)
#define PG8_MMA(ai, bj, At, Bt) do { __builtin_amdgcn_s_setprio(1); _Pragma("unroll") for (int m = 0; m < 4; ++m) _Pragma("unroll") for (int n = 0; n < 2; ++n) _Pragma("unroll") for (int k = 0; k < 2; ++k) \
        acc[ai][bj][m][n] = __builtin_amdgcn_mfma_f32_16x16x32_bf16(Bt[n][k], At[m][k], acc[ai][bj][m][n], 0, 0, 0); __builtin_amdgcn_s_setprio(0); } while (0)
#define PG8_WAIT_V(n) asm volatile("s_waitcnt vmcnt(" #n ")" ::: "memory")
#define PG8_WAIT_L(n) asm volatile("s_waitcnt lgkmcnt(" #n ")" ::: "memory")
#define PG8_BAR __builtin_amdgcn_s_barrier()
#define PG8_SCHED __builtin_amdgcn_sched_barrier(0)
    Unit cur, nxt; int ui = 0;
    if (!S.next(0, cur)) return;
    f32x4 acc[2][2][4][2];
#pragma unroll
    for (int a = 0; a < 2; ++a)
#pragma unroll
        for (int b = 0; b < 2; ++b)
#pragma unroll
            for (int m = 0; m < 4; ++m)
#pragma unroll
                for (int n = 0; n < 2; ++n) acc[a][b][m][n] = (f32x4){0.f, 0.f, 0.f, 0.f};
    bf16x8 At[4][2], B0[2][2], B1[2][2];
    const char* cA = (const char*)g.A + (size_t)cur.pm * tstep; const char* cB = (const char*)g.Bt + (size_t)cur.pn * tstep;
    S.a_ready(cur);
    if constexpr (SP2) {
        PG8_STAGE(PG8_SB(0, 0), cB, voffB); PG8_STAGE(PG8_SB(0, 1), cB + hstep, voffB); PG8_STAGE(PG8_SA(0, 0), cA, voffA); PG8_STAGE(PG8_SA(0, 1), cA + hstep, voffA);
        if (wr == 1) PG8_BAR;
        PG8_WAIT_V(2); PG8_BAR;
        PG8_STAGE(PG8_SB(1, 0), cB + kstep, voffB); PG8_STAGE(PG8_SA(1, 0), cA + kstep, voffA); PG8_STAGE(PG8_SB(1, 1), cB + hstep + kstep, voffB);
        PG8_WAIT_V(6); PG8_BAR;
    } else {
        PG8_STAGE(PG8_SB(0, 0), cB, voffB); PG8_STAGE(PG8_SA(0, 0), cA, voffA); PG8_STAGE(PG8_SB(0, 1), cB + hstep, voffB); PG8_STAGE(PG8_SA(0, 1), cA + hstep, voffA);
        if (wr == 1) PG8_BAR;
        PG8_WAIT_V(4); PG8_BAR;
        PG8_STAGE(PG8_SB(1, 0), cB + kstep, voffB); PG8_STAGE(PG8_SA(1, 0), cA + kstep, voffA); PG8_STAGE(PG8_SB(1, 1), cB + hstep + kstep, voffB);
        PG8_WAIT_V(6); PG8_BAR;
    }
    for (;;) {
        const bool has_next = S.next(ui + 1, nxt);
        const char* nA = has_next ? (const char*)g.A + (size_t)nxt.pm * tstep : cA; const char* nB = has_next ? (const char*)g.Bt + (size_t)nxt.pn * tstep : cB;
        for (int t = 0; t < nt; t += 2) {
            const bool last = (t == nt - 2);
            const char* a1 = cA + (size_t)(t + 1) * kstep;
            const char* a2 = last ? nA : cA + (size_t)(t + 2) * kstep; const char* b2 = last ? nB : cB + (size_t)(t + 2) * kstep;
            const char* a3 = a2 + kstep; const char* b3 = b2 + kstep;
            if (last && has_next) S.a_ready(nxt);
            if constexpr (SP2) {
            PG8_LDB(B0, 0, 0); PG8_LDB(B1, 0, 1); PG8_SCHED; PG8_LDA(At, 0, 0); PG8_STAGE(PG8_SA(1, 1), a1 + hstep, voffA);
            PG8_WAIT_V(8); PG8_WAIT_L(0); PG8_BAR; PG8_MMA(0, 0, At, B0); PG8_MMA(0, 1, At, B1); PG8_BAR; PG8_SCHED;
            PG8_LDA(At, 0, 1); PG8_STAGE(PG8_SB(0, 0), b2, voffB); PG8_STAGE(PG8_SB(0, 1), b2 + hstep, voffB); PG8_STAGE(PG8_SA(0, 0), a2, voffA);
            PG8_WAIT_V(8); PG8_WAIT_L(0); PG8_BAR; PG8_MMA(1, 0, At, B0); PG8_MMA(1, 1, At, B1); PG8_BAR; PG8_SCHED;
            PG8_LDB(B0, 1, 0); PG8_LDB(B1, 1, 1); PG8_SCHED; PG8_LDA(At, 1, 0); PG8_STAGE(PG8_SA(0, 1), a2 + hstep, voffA);
            PG8_WAIT_V(8); PG8_WAIT_L(0); PG8_BAR; PG8_MMA(0, 0, At, B0); PG8_MMA(0, 1, At, B1); PG8_BAR; PG8_SCHED;
            PG8_LDA(At, 1, 1); PG8_STAGE(PG8_SB(1, 0), b3, voffB); PG8_STAGE(PG8_SB(1, 1), b3 + hstep, voffB); PG8_STAGE(PG8_SA(1, 0), a3, voffA);
            PG8_WAIT_V(8); PG8_WAIT_L(0); PG8_BAR; PG8_MMA(1, 0, At, B0); PG8_MMA(1, 1, At, B1); PG8_BAR; PG8_SCHED;
            } else {
            PG8_LDB(B0, 0, 0); PG8_SCHED; PG8_LDA(At, 0, 0); PG8_STAGE(PG8_SA(1, 1), a1 + hstep, voffA);
            PG8_WAIT_L(8); PG8_BAR; PG8_WAIT_L(0); PG8_MMA(0, 0, At, B0); PG8_BAR; PG8_SCHED;
            PG8_LDB(B1, 0, 1); PG8_STAGE(PG8_SB(0, 0), b2, voffB);
            PG8_BAR; PG8_WAIT_L(0); PG8_MMA(0, 1, At, B1); PG8_BAR;
            PG8_LDA(At, 0, 1); PG8_STAGE(PG8_SA(0, 0), a2, voffA);
            PG8_BAR; PG8_WAIT_L(0); PG8_MMA(1, 0, At, B0); PG8_BAR; PG8_SCHED;
            PG8_STAGE(PG8_SB(0, 1), b2 + hstep, voffB);
            PG8_WAIT_V(6); PG8_BAR; PG8_MMA(1, 1, At, B1); PG8_BAR;
            PG8_LDB(B0, 1, 0); PG8_SCHED; PG8_LDA(At, 1, 0); PG8_STAGE(PG8_SA(0, 1), a2 + hstep, voffA);
            PG8_WAIT_L(8); PG8_BAR; PG8_WAIT_L(0); PG8_MMA(0, 0, At, B0); PG8_BAR; PG8_SCHED;
            PG8_LDB(B1, 1, 1); PG8_STAGE(PG8_SB(1, 0), b3, voffB);
            PG8_BAR; PG8_WAIT_L(0); PG8_MMA(0, 1, At, B1); PG8_BAR;
            PG8_LDA(At, 1, 1); PG8_STAGE(PG8_SA(1, 0), a3, voffA);
            PG8_BAR; PG8_WAIT_L(0); PG8_MMA(1, 0, At, B0); PG8_BAR; PG8_SCHED;
            PG8_STAGE(PG8_SB(1, 1), b3 + hstep, voffB);
            PG8_WAIT_V(6); PG8_BAR; PG8_MMA(1, 1, At, B1); PG8_BAR;
            }
        }
        if constexpr (ALIGN_EPI) { if (wr == 0) PG8_BAR; }
        if constexpr (!Epi::AFTER_DRAIN) { E(acc, cur, wr, wc, fr, fq); S.done(cur); }
        if (!has_next) break;
#pragma unroll
        for (int a = 0; a < 2; ++a)
#pragma unroll
            for (int b = 0; b < 2; ++b)
#pragma unroll
                for (int m = 0; m < 4; ++m)
#pragma unroll
                    for (int n = 0; n < 2; ++n) acc[a][b][m][n] = (f32x4){0.f, 0.f, 0.f, 0.f};
        cur = nxt; cA = nA; cB = nB; ++ui;
        if constexpr (ALIGN_EPI) { if (wr == 1) PG8_BAR; }
    }
    PG8_WAIT_V(0);
    if constexpr (!ALIGN_EPI) { if (wr == 0) PG8_BAR; }
    PG8_BAR;
    if constexpr (Epi::AFTER_DRAIN) { E.fused(acc, cur, wr, wc, fr, fq, lds, wid, lane); S.done(cur); }
#undef PG8_SA
#undef PG8_SB
#undef PG8_STAGE
#undef PG8_LDA
#undef PG8_LDB
#undef PG8_MMA
#undef PG8_WAIT_V
#undef PG8_WAIT_L
#undef PG8_BAR
#undef PG8_SCHED
}
}
using pg8::bf16x8; using pg8::f32x4; using pg8::u32x4;
namespace dattn {
constexpr int D = 128, LDQ = NPAD, LDK = NPAD, LDO = 2048;
constexpr float SCALE = 0.08838834764831845f;
constexpr float THR = 8.f;
constexpr int NW = 8, QBLK = 32, KVBLK = 64, QB = NW * QBLK;
constexpr int SHM_V = KVBLK * D * 2, SHM_K = KVBLK * D * 2;
constexpr int LDS_BYTES = 2 * SHM_V + 2 * SHM_K + NW * 64 * 4;

#define KSWZ(row, colB) ((row) * 256 + ((colB) ^ (((row) & 7) << 4)))
#define SBAR() __builtin_amdgcn_sched_barrier(0)
__device__ __forceinline__ int v_st(int k, int c) { const int kk = (k & ~0xC) | ((k & 4) << 1) | ((k & 8) >> 1); return ((kk >> 3) * 4 + (c >> 5)) * 512 + ((kk & 7) * 32 + (c & 31)) * 2; }
__device__ __forceinline__ int v_rd_base(int lane) { return ((lane & 3) << 3) | (((lane >> 2) & 3) << 6) | (((lane >> 4) & 1) << 5) | (((lane >> 5) & 1) << 8); }
constexpr int v_rd_off(int d0, int ks, int half) { return d0 * 512 + ks * 4096 + half * 2048; }
__device__ __forceinline__ int crow(int r, int hi) { return (r & 3) + 8 * (r >> 2) + 4 * hi; }
__device__ __forceinline__ unsigned cvtpk(float lo, float hi) { unsigned r; asm volatile("v_cvt_pk_bf16_f32 %0, %1, %2" : "=v"(r) : "v"(lo), "v"(hi)); return r; }
__device__ __forceinline__ bf16x8 load8(const bf16_t* p) { return *reinterpret_cast<const bf16x8*>(p); }

__device__ __forceinline__ void partialSM(f32x16& p0, f32x16& p1, float& m_reg, float& mn, float& alpha) {
    float pmax = p0[0]; for (int r = 1; r < 16; ++r) pmax = fmaxf(pmax, p0[r]); for (int r = 0; r < 16; ++r) pmax = fmaxf(pmax, p1[r]);
    { auto rr = __builtin_amdgcn_permlane32_swap(__float_as_uint(pmax), __float_as_uint(pmax), false, false);
      pmax = fmaxf(__uint_as_float(rr[0]), __uint_as_float(rr[1])); }
    constexpr float C2 = 1.4426950408889634f * SCALE;
    if (__builtin_expect(__all((pmax - m_reg) * SCALE <= THR), 1)) { mn = m_reg; alpha = 1.f; }
    else { mn = fmaxf(m_reg, pmax); alpha = __builtin_amdgcn_exp2f((m_reg - mn) * C2); m_reg = mn; }
    const float mnL = -mn * C2;
    for (int r = 0; r < 16; ++r) p0[r] = fmaf(p0[r], C2, mnL); for (int r = 0; r < 16; ++r) p1[r] = fmaf(p1[r], C2, mnL);
    for (int r = 0; r < 16; ++r) p0[r] = __builtin_amdgcn_exp2f(p0[r]);
}
__device__ __forceinline__ void finishSM(f32x16& p0, f32x16& p1, float alpha, float& l_reg, bf16x8& pa0, bf16x8& pa1, bf16x8& pa2, bf16x8& pa3) {
    for (int r = 0; r < 16; ++r) p1[r] = __builtin_amdgcn_exp2f(p1[r]);
    float ps = 0; for (int r = 0; r < 16; ++r) ps += p0[r]; for (int r = 0; r < 16; ++r) ps += p1[r];
    { auto rr = __builtin_amdgcn_permlane32_swap(__float_as_uint(ps), __float_as_uint(ps), false, false);
      ps = __uint_as_float(rr[0]) + __uint_as_float(rr[1]); }
    l_reg = l_reg * alpha + ps;
#define PK4(P, B_, OUT) do { unsigned a0 = cvtpk(P[B_+0], P[B_+1]), a1 = cvtpk(P[B_+2], P[B_+3]);                          \
        unsigned b0 = cvtpk(P[B_+4], P[B_+5]), b1 = cvtpk(P[B_+6], P[B_+7]);                                             \
        auto r0 = __builtin_amdgcn_permlane32_swap(a0, b0, false, false); auto r1 = __builtin_amdgcn_permlane32_swap(a1, b1, false, false); \
        u32x4 w = {r0[0], r1[0], r0[1], r1[1]}; OUT = *reinterpret_cast<bf16x8*>(&w); } while (0)
    PK4(p0, 0, pa0); PK4(p0, 8, pa1); PK4(p1, 0, pa2); PK4(p1, 8, pa3);
#undef PK4
}
template <int KB>
__device__ __forceinline__ void qkt(f32x16& p0, f32x16& p1, const char* K_lds, int r32, int hi, const bf16x8* qr) {
    p0 = f32x16{}; p1 = f32x16{};
    const char* kb[4];
#pragma unroll
    for (int dd = 0; dd < 4; ++dd) kb[dd] = K_lds + KB * SHM_K + KSWZ(r32, (dd * 16 + hi * 8) * 2);
#pragma unroll
    for (int d0 = 0; d0 < 8; ++d0) { const char* a = kb[d0 & 3] + (d0 >> 2) * 128;
        bf16x8 b0 = *reinterpret_cast<const bf16x8*>(a);
        bf16x8 b1 = *reinterpret_cast<const bf16x8*>(a + 32 * 256);
        p0 = __builtin_amdgcn_mfma_f32_32x32x16_bf16(b0, qr[d0], p0, 0, 0, 0);
        p1 = __builtin_amdgcn_mfma_f32_32x32x16_bf16(b1, qr[d0], p1, 0, 0, 0); }
}
template <int VB>
__device__ __forceinline__ void pv_tile(f32x16* o, int vb0, bf16x8 pa0, bf16x8 pa1, bf16x8 pa2, bf16x8 pa3) {
#define TRRD(dst, off) asm volatile("ds_read_b64_tr_b16 %0, %1 offset:%2" : "=&v"(dst) : "v"(vb0), "i"(off) : "memory")
#define PV_D0(d0) do { s16x4 l0, l1, l2, l3, h0, h1, h2, h3; constexpr int b_ = VB * SHM_V + v_rd_off(d0, 0, 0);   \
        TRRD(l0, b_); TRRD(h0, b_ + 2048); TRRD(l1, b_ + 4096); TRRD(h1, b_ + 6144); TRRD(l2, b_ + 8192); TRRD(h2, b_ + 10240); TRRD(l3, b_ + 12288); TRRD(h3, b_ + 14336); \
        asm volatile("s_waitcnt lgkmcnt(0)" ::: "memory"); SBAR();                                                   \
        o[d0] = __builtin_amdgcn_mfma_f32_32x32x16_bf16(pa0, (bf16x8){l0[0], l0[1], l0[2], l0[3], h0[0], h0[1], h0[2], h0[3]}, o[d0], 0, 0, 0);   \
        o[d0] = __builtin_amdgcn_mfma_f32_32x32x16_bf16(pa1, (bf16x8){l1[0], l1[1], l1[2], l1[3], h1[0], h1[1], h1[2], h1[3]}, o[d0], 0, 0, 0);   \
        o[d0] = __builtin_amdgcn_mfma_f32_32x32x16_bf16(pa2, (bf16x8){l2[0], l2[1], l2[2], l2[3], h2[0], h2[1], h2[2], h2[3]}, o[d0], 0, 0, 0);   \
        o[d0] = __builtin_amdgcn_mfma_f32_32x32x16_bf16(pa3, (bf16x8){l3[0], l3[1], l3[2], l3[3], h3[0], h3[1], h3[2], h3[3]}, o[d0], 0, 0, 0); } while (0)
    PV_D0(0); PV_D0(1); PV_D0(2); PV_D0(3);
#undef PV_D0
#undef TRRD
}

struct BlockRef { const bf16_t* Q; const bf16_t* K; const bf16_t* V; float* O; int P0; };
struct Seam { bf16x8 qr[8]; bf16x8 st_v0, st_v1, st_k0, st_k1; };
#define ROW(p, k0, rr) ((p) + (size_t)((k0) + (rr)) * LDK + sc)
#define VMW() asm volatile("s_waitcnt vmcnt(0)" ::: "memory")
#define VMWN(n) asm volatile("s_waitcnt vmcnt(%0)" :: "i"(n) : "memory")
#define SLOAD_H(Kp, Vp, k0) do { S.st_v0 = load8(ROW(Vp, k0, sr)); S.st_v1 = load8(ROW(Vp, k0, 32 + sr));              \
                         S.st_k0 = load8(ROW(Kp, k0, sr)); S.st_k1 = load8(ROW(Kp, k0, 32 + sr)); } while (0)
#define SWRITE_HK(bf) do { *(bf16x8*)(K_lds + (bf) * SHM_K + kws) = S.st_k0; *(bf16x8*)(K_lds + (bf) * SHM_K + kws + 32 * 256) = S.st_k1; } while (0)
#define SWRITE_HV(bf) do { *(bf16x8*)(V_lds + (bf) * SHM_V + vst0) = S.st_v0; *(bf16x8*)(V_lds + (bf) * SHM_V + vst1) = S.st_v1; } while (0)
#define SWRITE_H(bf) do { SWRITE_HV(bf); SWRITE_HK(bf); } while (0)
__device__ __forceinline__ void prime(const BlockRef& cur, char* lds, Seam& S, int wave_id) {
    int tid_ = wave_id * 64 + hw_lane(); asm volatile("" : "+v"(tid_));
    const int tid = tid_, wid = __builtin_amdgcn_readfirstlane(tid >> 6), lane = tid & 63, r32 = lane & 31, hi = lane >> 5;
    const int sr = tid >> 4, sc = (tid & 15) * 8, kws = KSWZ(sr, sc * 2); char* K_lds = lds + 2 * SHM_V;
#pragma unroll
    for (int d0 = 0; d0 < 8; ++d0) S.qr[d0] = load8(cur.Q + (size_t)(wid * QBLK + r32) * LDQ + d0 * 16 + hi * 8);
    SLOAD_H(cur.K, cur.V, 0); VMW(); SWRITE_HK(0);
    __syncthreads();
}
__device__ __forceinline__ void block(const BlockRef& cur, const BlockRef& nxt, char* lds, Seam& S, int wave_id) {
    int tid_ = wave_id * 64 + hw_lane(); asm volatile("" : "+v"(tid_));
    const int tid = tid_, wid = __builtin_amdgcn_readfirstlane(tid >> 6), lane = tid & 63, r32 = lane & 31, hi = lane >> 5;
    const int NT = cur.P0 / KVBLK + 4;
    const int qlo = cur.P0 + wid * QBLK;
    const int qend = qlo | 63;
    char* V_lds = lds; char* K_lds = lds + 2 * SHM_V;
    float* ws = (float*)(lds + 2 * SHM_V + 2 * SHM_K) + wid * 64; float* li_l = ws, * al_l = ws + 32;
    float m_reg = -1e30f, l_reg = 0; f32x16 o[4] = {};
    const int sr = tid >> 4, sc = (tid & 15) * 8, vst0 = v_st(sr, sc), vst1 = v_st(32 + sr, sc), kws = KSWZ(sr, sc * 2);
    const int vb0 = (int)(uintptr_t)V_lds + v_rd_base(lane);
    const bf16_t* Kh = cur.K; const bf16_t* Vh = cur.V;
#define RESC(a) do { if (__any((a) < 1.f)) { if (hi == 0) al_l[r32] = (a); asm volatile("s_waitcnt lgkmcnt(0)" ::: "memory");              \
                     for (int d_ = 0; d_ < 4; ++d_) for (int r = 0; r < 16; ++r) o[d_][r] *= al_l[crow(r, hi)]; } } while (0)
#define KBASE(t) ((t) * KVBLK)
#define MASKT(P0_, P1_, t) do { if (KBASE(t) > qend) { const float NEG_ = -__builtin_inff(); _Pragma("unroll") for (int r_ = 0; r_ < 16; ++r_) { P0_[r_] = NEG_; P1_[r_] = NEG_; } } } while (0)
    constexpr int NQL = 8;
#define SEAM_K0() do { VMWN(NQL); SWRITE_HK(0); SBAR(); } while (0)
    f32x16 pA0, pA1, pB0, pB1; float mnA, mnB, alA, alB; bf16x8 pa0, pa1, pa2, pa3;
    SWRITE_HV(0); SBAR();
    if (NT > 1) { SLOAD_H(Kh, Vh, KBASE(1)); }
    SBAR(); qkt<0>(pA0, pA1, K_lds, r32, hi, S.qr);
    MASKT(pA0, pA1, 0); partialSM(pA0, pA1, m_reg, mnA, alA);
    if (NT > 1) { VMW(); SWRITE_H(1); }
    __syncthreads();
#define HALF_STEP(PX0, PX1, mnX, alX, PY0, PY1, alY, t, KB, VB, SB) do {                                                      \
        SBAR(); qkt<KB>(PX0, PX1, K_lds, r32, hi, S.qr);                                                                      \
        finishSM(PY0, PY1, alY, l_reg, pa0, pa1, pa2, pa3); SBAR();                                                           \
        if ((t) + 1 < NT) { SLOAD_H(Kh, Vh, KBASE((t) + 1)); SBAR(); }                                                        \
        pv_tile<VB>(o, vb0, pa0, pa1, pa2, pa3); MASKT(PX0, PX1, (t)); partialSM(PX0, PX1, m_reg, mnX, alX);                  \
        __syncthreads();                                                                                                      \
        if ((t) + 1 < NT) { VMW(); SWRITE_H(SB); }                                                                            \
        RESC(alX); __syncthreads(); } while (0)
    for (int t = 1; t + 1 < NT; t += 2) {
        HALF_STEP(pB0, pB1, mnB, alB, pA0, pA1, alA, t, 1, 0, 0);
        HALF_STEP(pA0, pA1, mnA, alA, pB0, pB1, alB, t + 1, 0, 1, 1);
    }
    SBAR(); qkt<1>(pB0, pB1, K_lds, r32, hi, S.qr); SBAR();
    SLOAD_H(nxt.K, nxt.V, 0); SBAR();
#pragma unroll
    for (int d0 = 0; d0 < 8; ++d0) S.qr[d0] = load8(nxt.Q + (size_t)(wid * QBLK + r32) * LDQ + d0 * 16 + hi * 8);
    SBAR();
    finishSM(pA0, pA1, alA, l_reg, pa0, pa1, pa2, pa3); SBAR();
    pv_tile<0>(o, vb0, pa0, pa1, pa2, pa3);
    MASKT(pB0, pB1, NT - 1); partialSM(pB0, pB1, m_reg, mnB, alB); __syncthreads(); RESC(alB);
    finishSM(pB0, pB1, alB, l_reg, pa0, pa1, pa2, pa3); SBAR(); pv_tile<1>(o, vb0, pa0, pa1, pa2, pa3);
    SBAR(); SEAM_K0();
    if (hi == 0) li_l[r32] = l_reg; asm volatile("s_waitcnt lgkmcnt(0)" ::: "memory");
    float rli[16];
#pragma unroll
    for (int r = 0; r < 16; ++r) rli[r] = __builtin_amdgcn_rcpf(li_l[crow(r, hi)]);
    float* Ow = cur.O + (size_t)(wid * QBLK) * LDO;
#pragma unroll
    for (int r = 0; r < 16; ++r) { const int orow = crow(r, hi);
#pragma unroll
        for (int d0 = 0; d0 < 4; ++d0) Ow[(size_t)orow * LDO + d0 * 32 + r32] = o[d0][r] * rli[r]; }
    __syncthreads();
#undef RESC
#undef KBASE
#undef MASKT
#undef SEAM_K0
#undef HALF_STEP
}
#undef ROW
#undef VMW
#undef VMWN
#undef SLOAD_H
#undef SWRITE_HK
#undef SWRITE_HV
#undef SWRITE_H
#undef KSWZ
#undef SBAR
}
#define XB_TMO      128
#define XB_XCNT(j)  (256  + 64 * (j))
#define XB_XSUB(j)  (1280 + 64 * (j))
#define XB_XGEN(j)  (2304 + 64 * (j))
#define XB_TOP      3328
#define XB_TOPGEN   3392
#define XCD_BAR_WORDS 3456
#define XB_SPIN_CAP (1u << 18)

__device__ __forceinline__ unsigned xb_ld(unsigned* p)              { return __hip_atomic_load(p, __ATOMIC_RELAXED, __HIP_MEMORY_SCOPE_AGENT); }
__device__ __forceinline__ unsigned xb_add(unsigned* p, unsigned v) { return __hip_atomic_fetch_add(p, v, __ATOMIC_RELAXED, __HIP_MEMORY_SCOPE_AGENT); }
__device__ __forceinline__ unsigned xb_xcc_id() { return (unsigned)__builtin_amdgcn_s_getreg((3 << 11) | 20) & 0xFu; }
#define XB_SPIN(cond, bar) do { unsigned _sp = 0; while (cond) { __builtin_amdgcn_s_sleep(1); \
    if ((++_sp & 255u) == 0u) { if (xb_ld(&(bar)[XB_TMO])) break; if (_sp > XB_SPIN_CAP) { atomicAdd(&(bar)[XB_TMO], 1u); break; } } } } while (0)

struct XcdBarrier {
    unsigned* bar; unsigned x;
    volatile LAS unsigned* st;
};

__device__ __forceinline__ XcdBarrier xcd_barrier_post(unsigned* bar, volatile LAS unsigned* st) {
    XcdBarrier b; b.bar = bar; b.x = xb_xcc_id(); b.st = st;
    if (threadIdx.x == 0) (void)xb_add(&bar[XB_XCNT(b.x)], 1u);
    return b;
}
__device__ __forceinline__ void xcd_barrier_complete(unsigned* bar, unsigned x, unsigned& nloc, unsigned& nx) {
    const unsigned G = gridDim.x * gridDim.y * gridDim.z;
    unsigned sum, cnt, mine, sp = 0u;
    for (;;) {
        sum = 0u; cnt = 0u; mine = 0u;
#pragma unroll
        for (unsigned j = 0; j < 16; ++j) { const unsigned c = xb_ld(&bar[XB_XCNT(j)]); sum += c; cnt += (c > 0u) ? 1u : 0u; mine = (j == x) ? c : mine; }
        if (sum == G) break;
        __builtin_amdgcn_s_sleep(1);
        if ((++sp & 255u) == 0u) { if (xb_ld(&bar[XB_TMO])) break; if (sp > XB_SPIN_CAP) { atomicAdd(&bar[XB_TMO], 1u); break; } }
    }
    nloc = mine > 0u ? mine : 1u; nx = cnt > 0u ? cnt : 1u;
}

__device__ __forceinline__ void xcd_barrier(const XcdBarrier& b) {
    asm volatile("s_waitcnt vmcnt(0)" ::: "memory");
    __syncthreads();
    if (threadIdx.x == 0) {
        unsigned* bar = b.bar;
        __builtin_amdgcn_s_waitcnt(0);
        unsigned nloc = b.st[0], nx = b.st[1];
        if (nloc == 0u) { xcd_barrier_complete(bar, b.x, nloc, nx); b.st[0] = nloc; b.st[1] = nx; }
        const unsigned old = xb_add(&bar[XB_XSUB(b.x)], 1u);
        const unsigned gen = old / nloc;
        if (old + 1u == (gen + 1u) * nloc) {
            __builtin_amdgcn_fence(__ATOMIC_RELEASE, "agent");
            asm volatile("s_waitcnt vmcnt(0)" ::: "memory");
            const unsigned og = xb_add(&bar[XB_TOP], 1u);
            const unsigned tg = og / nx;
            if (og + 1u == (tg + 1u) * nx) xb_add(&bar[XB_TOPGEN], 1u);
            else XB_SPIN(xb_ld(&bar[XB_TOPGEN]) == tg, bar);
            __builtin_amdgcn_fence(__ATOMIC_ACQUIRE, "agent");
            xb_add(&bar[XB_XGEN(b.x)], 1u);
            asm volatile("s_waitcnt vmcnt(0)" ::: "memory");
        } else {
            XB_SPIN(xb_ld(&bar[XB_XGEN(b.x)]) == gen, bar);
            __builtin_amdgcn_fence(__ATOMIC_ACQUIRE, "agent");
            asm volatile("s_waitcnt vmcnt(0)" ::: "memory");
        }
    }
    __syncthreads();
}
constexpr size_t MiB = 1u << 20;
constexpr size_t WS_CTL = 0, CTL_ZERO_BYTES = 1 * MiB;
constexpr size_t WS_WTIN = 2 * MiB;
constexpr size_t WS_WTOUT = WS_WTIN + (size_t)DEPTH * NPAD * DM * 2;
constexpr size_t WS_WUVT = WS_WTOUT + (size_t)DEPTH * DM * DM * 2;
constexpr size_t WS_XB = WS_WUVT + 2 * MiB;
constexpr size_t WS_XF = WS_XB + (size_t)SEQ * DM * 2;
constexpr size_t WS_H = WS_XF + (size_t)SEQ * DM * 4;
constexpr size_t WS_O = WS_H + (size_t)SEQ * NPAD * 2;
constexpr size_t WS_CN = WS_O + (size_t)SEQ * DM * 2;
constexpr size_t WS_IKN = WS_CN + (size_t)SEQ * 256 * 2;
constexpr size_t WS_KDT = WS_IKN + (size_t)SEQ * 64 * 2;
constexpr size_t WS_DEC = WS_KDT + (size_t)NCHUNK * 1024 * 64 * 2;
constexpr size_t WS_VT = WS_DEC + (size_t)NCHUNK * 1024 * 4;
constexpr size_t WS_OA = WS_VT + (size_t)NCHUNK * 2048 * 64 * 2;
constexpr size_t WS_OD = WS_OA + (size_t)SEQ * 2048 * 4;
constexpr size_t WS_END = WS_OD + (size_t)SEQ * 2048 * 4;
constexpr int CW_TMO = 0;
constexpr int CW_BAR = 4096, BAR_STRIDE = 4096;
constexpr int CW_Q = 200000;
static_assert((CW_Q + 64 * 16 + 64) * 4 <= (int)CTL_ZERO_BYTES && CW_BAR + 32 * BAR_STRIDE <= CW_Q, "CTL map");
constexpr int NWAVES = 8;
constexpr int WREG = 18432;
constexpr int MISC_OFF = NWAVES * WREG;
constexpr int LDS_BYTES = MISC_OFF + 512;
static_assert(pg8::STAGE_BYTES <= MISC_OFF && dattn::LDS_BYTES <= MISC_OFF, "LDS map");

#define LDS_WAIT() asm volatile("s_waitcnt lgkmcnt(0)" ::: "memory")
#define VM_WAIT() asm volatile("s_waitcnt vmcnt(0)" ::: "memory")
typedef __bf16 bf16x2v __attribute__((ext_vector_type(2)));
typedef float f32x2 __attribute__((ext_vector_type(2)));
__device__ __forceinline__ unsigned cvtpk_c(float lo, float hi) { f32x2 v = {lo, hi}; bf16x2v b = __builtin_convertvector(v, bf16x2v); return __builtin_bit_cast(unsigned, b); }
__device__ __forceinline__ float bf2f(unsigned b) { return __uint_as_float(b << 16); }
__device__ __forceinline__ float bflo(unsigned w) { return __uint_as_float(w << 16); }
__device__ __forceinline__ float bfhi(unsigned w) { return __uint_as_float(w & 0xffff0000u); }
__device__ __forceinline__ bf16x8 pack8f(float a0, float a1, float a2, float a3, float a4, float a5, float a6, float a7) {
    u32x4 w = {cvtpk_c(a0, a1), cvtpk_c(a2, a3), cvtpk_c(a4, a5), cvtpk_c(a6, a7)}; return __builtin_bit_cast(bf16x8, w); }
__device__ __forceinline__ float bperm_f(int src_lane, float v) { return __int_as_float(__builtin_amdgcn_ds_bpermute(src_lane << 2, __float_as_int(v))); }
__device__ __forceinline__ float xmax16(float x) { const auto r = __builtin_amdgcn_permlane16_swap(__float_as_uint(x), __float_as_uint(x), false, false); return fmaxf(__uint_as_float(r[0]), __uint_as_float(r[1])); }
__device__ __forceinline__ float xmax32(float x) { const auto r = __builtin_amdgcn_permlane32_swap(__float_as_uint(x), __float_as_uint(x), false, false); return fmaxf(__uint_as_float(r[0]), __uint_as_float(r[1])); }
__device__ __forceinline__ float xsum16(float x) { const auto r = __builtin_amdgcn_permlane16_swap(__float_as_uint(x), __float_as_uint(x), false, false); return __uint_as_float(r[0]) + __uint_as_float(r[1]); }
__device__ __forceinline__ float xsum32(float x) { const auto r = __builtin_amdgcn_permlane32_swap(__float_as_uint(x), __float_as_uint(x), false, false); return __uint_as_float(r[0]) + __uint_as_float(r[1]); }
__device__ __forceinline__ float wave_sum(float v) {
    const int ln = hw_lane();
#pragma unroll
    for (int o = 1; o < 64; o <<= 1) v += bperm_f(ln ^ o, v);
    return v;
}
__device__ __forceinline__ void wave_sum2(float& a, float& b) {
    const int ln = hw_lane();
#pragma unroll
    for (int o = 1; o < 64; o <<= 1) { const float ta = bperm_f(ln ^ o, a), tb = bperm_f(ln ^ o, b); a += ta; b += tb; }
}
__device__ __forceinline__ float silu(float x) { return x / (1.f + __expf(-x)); }
#define MFMA16(a, b, c) __builtin_amdgcn_mfma_f32_16x16x32_bf16((a), (b), (c), 0, 0, 0)
#define MFMA32(a, b, c) __builtin_amdgcn_mfma_f32_32x32x16_bf16((a), (b), (c), 0, 0, 0)

struct Frame {
    LAS unsigned char* lds;
    volatile LAS unsigned* MISC;
    gu32* ctl;
    unsigned char* ws;
    int wave, vcu, G;
};
#define B_WTIN(F)  ((bf16_t*)((F).ws + WS_WTIN))
#define B_WTOUT(F) ((bf16_t*)((F).ws + WS_WTOUT))
#define B_WUVT(F)  ((bf16_t*)((F).ws + WS_WUVT))
#define B_XB(F)    ((bf16_t*)((F).ws + WS_XB))
#define B_XF(F)    ((float*)((F).ws + WS_XF))
#define B_H(F)     ((bf16_t*)((F).ws + WS_H))
#define B_O(F)     ((bf16_t*)((F).ws + WS_O))
#define B_CN(F)    ((bf16_t*)((F).ws + WS_CN))
#define B_IKN(F)   ((bf16_t*)((F).ws + WS_IKN))
#define B_KDT(F)   ((bf16_t*)((F).ws + WS_KDT))
#define B_DEC(F)   ((float*)((F).ws + WS_DEC))
#define B_VT(F)    ((bf16_t*)((F).ws + WS_VT))
#define B_OA(F)    ((float*)((F).ws + WS_OA))
#define B_OD(F)    ((float*)((F).ws + WS_OD))
__device__ __forceinline__ int grab(Frame& F, int qidx) {
    if ((F.wave * 64 + hw_lane()) == 0) F.MISC[2] = __hip_atomic_fetch_add((unsigned*)(F.ctl + CW_Q + 64 * qidx), 1u, __ATOMIC_RELAXED, __HIP_MEMORY_SCOPE_AGENT);
    __syncthreads(); const int v = (int)F.MISC[2]; __syncthreads(); return v;
}
template <bool REMAP>
__device__ __forceinline__ void tr_item(const float* W, int K, int ldw, bf16_t* WT, int nblk, LAS float* scr, int item, int lane) {
    const int kb = item / nblk, nb = item - kb * nblk, k0 = 64 * kb, n0 = 32 * nb;
    const int q = lane & 7, r = lane >> 3;
    const int sc = REMAP ? srccol(n0 + 4 * q) : n0 + 4 * q;
    f32x4 v[8];
#pragma unroll
    for (int i = 0; i < 8; ++i) v[i] = sc >= 0 ? *(const f32x4*)(W + (size_t)(k0 + 8 * i + r) * ldw + sc) : (f32x4){0.f, 0.f, 0.f, 0.f};
#pragma unroll
    for (int i = 0; i < 8; ++i) { LAS float* d = scr + (8 * i + r) * 33 + 4 * q; d[0] = v[i][0]; d[1] = v[i][1]; d[2] = v[i][2]; d[3] = v[i][3]; }
    LDS_WAIT();
    const int c = lane & 7;
#pragma unroll
    for (int j = 0; j < 4; ++j) { const int nn = (lane >> 3) + 8 * j; const LAS float* s = scr + (8 * c) * 33 + nn;
        u32x4 o; o.x = cvtpk_c(s[0 * 33], s[1 * 33]); o.y = cvtpk_c(s[2 * 33], s[3 * 33]); o.z = cvtpk_c(s[4 * 33], s[5 * 33]); o.w = cvtpk_c(s[6 * 33], s[7 * 33]);
        *(u32x4*)(WT + (size_t)(n0 + nn) * K + k0 + 8 * c) = o; }
    LDS_WAIT();
}
__device__ __forceinline__ void p0_prologue(Frame& F, const float* x_in, const float* w_in, const float* w_out, const float* w_uv) {
    LAS float* scr = (LAS float*)(F.lds + F.wave * 16384);
    const int gw = F.vcu * NWAVES + F.wave, NGW = F.G * NWAVES;
    constexpr int I_IN = (DM / 64) * (NPAD / 32), I_OUT = (DM / 64) * (DM / 32), I_UV = (256 / 64) * (128 / 32);
    constexpr int N_IN = DEPTH * I_IN, N_OUT = DEPTH * I_OUT, N_UV = DEPTH * 8 * I_UV;
    for (int it = gw; it < N_IN + N_OUT + N_UV; it += NGW) {
        int r = it;
        if (r < N_IN) { const int l = r / I_IN; r -= l * I_IN;
            tr_item<true>(w_in + (size_t)l * DM * NIN, DM, NIN, B_WTIN(F) + (size_t)l * NPAD * DM, NPAD / 32, scr, r, hw_lane()); continue; }
        r -= N_IN;
        if (r < N_OUT) { const int l = r / I_OUT; r -= l * I_OUT;
            tr_item<false>(w_out + (size_t)l * DM * DM, DM, DM, B_WTOUT(F) + (size_t)l * DM * DM, DM / 32, scr, r, hw_lane()); continue; }
        r -= N_OUT;
        { const int lh = r / I_UV; r -= lh * I_UV;
          tr_item<false>(w_uv + (size_t)lh * 256 * 128, 256, 128, B_WUVT(F) + (size_t)lh * 128 * 256, 128 / 32, scr, r, hw_lane()); }
    }
    const f32x4* xs = (const f32x4*)x_in;
    for (size_t i = (size_t)gw * 64 + hw_lane(); i < (size_t)SEQ * DM / 8; i += (size_t)NGW * 64) {
        const f32x4 a = xs[2 * i], b = xs[2 * i + 1];
        u32x4 o = {cvtpk_c(a[0], a[1]), cvtpk_c(a[2], a[3]), cvtpk_c(b[0], b[1]), cvtpk_c(b[2], b[3])};
        *(u32x4*)(B_XB(F) + 8 * i) = o;
    }
}

__device__ __forceinline__ void prep_phase(Frame& F, int l, const float* w_gate2, const float* b_gate, const float* kv_g, const float* ik_g, const float* ik_b) {
    int lane_ = hw_lane(); asm volatile("" : "+v"(lane_));
    const int gw = F.vcu * NWAVES + F.wave, NGW = F.G * NWAVES, lane = lane_;
    const bf16_t* H = B_H(F);
    {
        const float* kvg = kv_g + l * 256; const float* ikg = ik_g + l * 64; const float* ikb = ik_b + l * 64;
        const f32x4 g4 = *(const f32x4*)(kvg + 4 * lane); const float g1 = ikg[lane], b1 = ikb[lane];
        for (int t0 = gw; t0 < SEQ; t0 += 2 * NGW) {
            float v[2][4], x[2], ss[2];
#pragma unroll
            for (int k = 0; k < 2; ++k) { const bf16_t* hr = H + (size_t)(t0 + k * NGW) * NPAD;
                const u32x2 raw = *(const u32x2*)(hr + C_CKV + 4 * lane);
                v[k][0] = bflo(raw.x); v[k][1] = bfhi(raw.x); v[k][2] = bflo(raw.y); v[k][3] = bfhi(raw.y);
                x[k] = bf2f(hr[C_CIK + lane]);
                ss[k] = (v[k][0] * v[k][0] + v[k][1] * v[k][1]) + (v[k][2] * v[k][2] + v[k][3] * v[k][3]); }
            float mu[2] = {x[0], x[1]};
            wave_sum2(ss[0], ss[1]); wave_sum2(mu[0], mu[1]);
            float dv[2], var[2];
#pragma unroll
            for (int k = 0; k < 2; ++k) { dv[k] = x[k] - mu[k] * (1.f / 64.f); var[k] = dv[k] * dv[k]; }
            wave_sum2(var[0], var[1]);
#pragma unroll
            for (int k = 0; k < 2; ++k) { const int t = t0 + k * NGW;
                const float rs = rsqrtf(ss[k] * (1.f / 256.f) + 1e-6f);
                u32x2 o; o.x = cvtpk_c(v[k][0] * rs * g4[0], v[k][1] * rs * g4[1]); o.y = cvtpk_c(v[k][2] * rs * g4[2], v[k][3] * rs * g4[3]);
                *(u32x2*)(B_CN(F) + (size_t)t * 256 + 4 * lane) = o;
                const float y = dv[k] * rsqrtf(var[k] * (1.f / 64.f) + 1e-5f) * g1 + b1;
                B_IKN(F)[(size_t)t * 64 + lane] = (bf16_t)(cvtpk_c(y, 0.f) & 0xffffu); }
        }
    }
    {
        LAS float* aas = (LAS float*)(F.lds + F.wave * 16384);
        const float* W2 = w_gate2 + (size_t)l * 16 * 1024; const float* BG = b_gate + (size_t)l * 1024;
        for (int u = gw; u < NCHUNK * 16; u += NGW) {
            const int c = u >> 4, dk = (u & 15) * 64 + lane;
            { const bf16_t* ap = H + (size_t)(64 * c + lane) * NPAD + C_AA;
              const bf16x8 a0 = *(const bf16x8*)ap, a1 = *(const bf16x8*)(ap + 8);
#pragma unroll
              for (int j = 0; j < 8; ++j) { aas[lane * 16 + j] = bf2f((unsigned short)a0[j]); aas[lane * 16 + 8 + j] = bf2f((unsigned short)a1[j]); } }
            float w2[16];
#pragma unroll
            for (int r = 0; r < 16; ++r) w2[r] = W2[r * 1024 + dk];
            const float bgv = BG[dk];
            LDS_WAIT();
            float la[64]; float total = 0.f;
#pragma unroll
            for (int t = 0; t < 64; ++t) {
                float z = bgv;
#pragma unroll
                for (int r = 0; r < 16; ++r) z += aas[t * 16 + r] * w2[r];
                la[t] = (fminf(z, 0.f) - __logf(1.f + __expf(-fabsf(z)))) * (1.f / 16.f);
                total += la[t];
            }
            B_DEC(F)[(size_t)c * 1024 + dk] = __expf(total);
            float run = 0.f;
#pragma unroll
            for (int t8 = 0; t8 < 8; ++t8) {
                float kd[8];
#pragma unroll
                for (int j = 0; j < 8; ++j) { const int t = 8 * t8 + j;
                    run += la[t];
                    kd[j] = bf2f(H[(size_t)(64 * c + t) * NPAD + C_AK + dk]) * __expf(total - run); }
                *(bf16x8*)(B_KDT(F) + ((size_t)c * 1024 + dk) * 64 + 8 * t8) = pack8f(kd[0], kd[1], kd[2], kd[3], kd[4], kd[5], kd[6], kd[7]);
            }
            LDS_WAIT();
        }
    }
    for (int u = gw; u < NCHUNK * 16; u += NGW) {
        const int c = u >> 4, dv = (u & 15) * 128 + 2 * lane;
#pragma unroll
        for (int t8 = 0; t8 < 8; ++t8) {
            unsigned w[8];
#pragma unroll
            for (int j = 0; j < 8; ++j) w[j] = *(const unsigned*)(H + (size_t)(64 * c + 8 * t8 + j) * NPAD + C_AV + dv);
            u32x4 lo = {(w[0] & 0xffffu) | (w[1] << 16), (w[2] & 0xffffu) | (w[3] << 16), (w[4] & 0xffffu) | (w[5] << 16), (w[6] & 0xffffu) | (w[7] << 16)};
            u32x4 hi = {(w[0] >> 16) | (w[1] & 0xffff0000u), (w[2] >> 16) | (w[3] & 0xffff0000u), (w[4] >> 16) | (w[5] & 0xffff0000u), (w[6] >> 16) | (w[7] & 0xffff0000u)};
            *(u32x4*)(B_VT(F) + ((size_t)c * 2048 + dv) * 64 + 8 * t8) = lo;
            *(u32x4*)(B_VT(F) + ((size_t)c * 2048 + dv + 1) * 64 + 8 * t8) = hi;
        }
    }
}

__device__ __forceinline__ void post_phase(Frame& F, int l, float lam_init, const float* gla_g, const float* dlam, const float* diff_g) {
    int lane_ = hw_lane(); asm volatile("" : "+v"(lane_));
    const int gw = F.vcu * NWAVES + F.wave, NGW = F.G * NWAVES, lane = lane_;
    float lam;
    { const float* lp = dlam + (size_t)l * 512;
      const float p0 = lp[lane] * lp[128 + lane] + lp[64 + lane] * lp[192 + lane];
      const float p1 = lp[256 + lane] * lp[384 + lane] + lp[320 + lane] * lp[448 + lane];
      lam = expf(wave_sum(p0)) - expf(wave_sum(p1)) + lam_init; }
    { const float* g = gla_g + (size_t)l * 512;
      const f32x4 ga = *(const f32x4*)(g + 8 * lane), gb = *(const f32x4*)(g + 8 * lane + 4);
      for (int u0 = gw; u0 < SEQ * 4; u0 += 2 * NGW) {
          f32x4 a[2], b[2]; u32x4 gr[2]; float ss[2];
#pragma unroll
          for (int k = 0; k < 2; ++k) { const int u = u0 + k * NGW, t = u >> 2, hd = u & 3;
              const float* src = B_OA(F) + (size_t)t * 2048 + hd * 512 + 8 * lane;
              a[k] = *(const f32x4*)src; b[k] = *(const f32x4*)(src + 4);
              gr[k] = *(const u32x4*)(B_H(F) + (size_t)t * NPAD + C_AG + hd * 512 + 8 * lane);
              ss[k] = (a[k][0] * a[k][0] + a[k][1] * a[k][1]) + (a[k][2] * a[k][2] + a[k][3] * a[k][3]) + (b[k][0] * b[k][0] + b[k][1] * b[k][1]) + (b[k][2] * b[k][2] + b[k][3] * b[k][3]); }
          wave_sum2(ss[0], ss[1]);
#pragma unroll
          for (int k = 0; k < 2; ++k) { const int u = u0 + k * NGW, t = u >> 2, hd = u & 3;
              const float rs = rsqrtf(ss[k] * (1.f / 512.f) + 1e-6f);
              u32x4 o;
              o.x = cvtpk_c(a[k][0] * rs * ga[0] * silu(bflo(gr[k].x)), a[k][1] * rs * ga[1] * silu(bfhi(gr[k].x)));
              o.y = cvtpk_c(a[k][2] * rs * ga[2] * silu(bflo(gr[k].y)), a[k][3] * rs * ga[3] * silu(bfhi(gr[k].y)));
              o.z = cvtpk_c(b[k][0] * rs * gb[0] * silu(bflo(gr[k].z)), b[k][1] * rs * gb[1] * silu(bfhi(gr[k].z)));
              o.w = cvtpk_c(b[k][2] * rs * gb[2] * silu(bflo(gr[k].w)), b[k][3] * rs * gb[3] * silu(bfhi(gr[k].w)));
              *(u32x4*)(B_O(F) + (size_t)t * DM + hd * 512 + 8 * lane) = o; }
      } }
    { const float* g = diff_g + (size_t)l * 256;
      const f32x4 g4 = *(const f32x4*)(g + 4 * lane); const float post = 1.f - lam_init;
      for (int u0 = gw; u0 < SEQ * 4; u0 += 2 * NGW) {
          f32x4 d[2]; u32x2 gr[2]; float ss[2];
#pragma unroll
          for (int k = 0; k < 2; ++k) { const int u = u0 + k * NGW, t = u >> 2, hd = u & 3;
              const float* src = B_OD(F) + (size_t)t * 2048 + hd * 512 + 4 * lane;
              const f32x4 a0 = *(const f32x4*)src, a1 = *(const f32x4*)(src + 256);
              gr[k] = *(const u32x2*)(B_H(F) + (size_t)t * NPAD + C_BG + hd * 256 + 4 * lane);
              d[k] = a0 - a1 * lam;
              ss[k] = (d[k][0] * d[k][0] + d[k][1] * d[k][1]) + (d[k][2] * d[k][2] + d[k][3] * d[k][3]); }
          wave_sum2(ss[0], ss[1]);
#pragma unroll
          for (int k = 0; k < 2; ++k) { const int u = u0 + k * NGW, t = u >> 2, hd = u & 3;
              const float rs = rsqrtf(ss[k] * (1.f / 256.f) + 1e-6f) * post;
              u32x2 o;
              o.x = cvtpk_c(d[k][0] * rs * g4[0] * silu(bflo(gr[k].x)), d[k][1] * rs * g4[1] * silu(bfhi(gr[k].x)));
              o.y = cvtpk_c(d[k][2] * rs * g4[2] * silu(bflo(gr[k].y)), d[k][3] * rs * g4[3] * silu(bfhi(gr[k].y)));
              *(u32x2*)(B_O(F) + (size_t)t * DM + 2048 + hd * 256 + 4 * lane) = o; }
      } }
}

__device__ __forceinline__ void ln_phase(Frame& F, int l, const float* ln_g, const float* ln_b, float* outp, bool dry) {
    int lane_ = hw_lane(); asm volatile("" : "+v"(lane_));
    const int gw = F.vcu * NWAVES + F.wave, NGW = F.G * NWAVES, lane = lane_;
    const float* g = ln_g + (size_t)l * DM; const float* b = ln_b + (size_t)l * DM;
    float* dst = dry ? B_OA(F) : ((l == DEPTH - 1) ? outp : B_XF(F));
    for (int t = gw; t < SEQ; t += NGW) {
        const f32x4* xr = (const f32x4*)(B_XF(F) + (size_t)t * DM) + lane;
        f32x4 v[16]; float s = 0.f;
#pragma unroll
        for (int j = 0; j < 16; ++j) { v[j] = xr[64 * j]; s += (v[j][0] + v[j][1]) + (v[j][2] + v[j][3]); }
        const float mean = wave_sum(s) * (1.f / DM); float s2 = 0.f;
#pragma unroll
        for (int j = 0; j < 16; ++j) { v[j] = v[j] - mean; s2 += (v[j][0] * v[j][0] + v[j][1] * v[j][1]) + (v[j][2] * v[j][2] + v[j][3] * v[j][3]); }
        const float rstd = rsqrtf(wave_sum(s2) * (1.f / DM) + 1e-5f);
        f32x4* orow = (f32x4*)(dst + (size_t)t * DM) + lane;
        u32x2* brow = (u32x2*)(B_XB(F) + (size_t)t * DM) + lane;
#pragma unroll
        for (int j = 0; j < 16; ++j) {
            const f32x4 gg = *((const f32x4*)g + lane + 64 * j), bb = *((const f32x4*)b + lane + 64 * j);
            const f32x4 y = v[j] * rstd * gg + bb;
            orow[64 * j] = y;
            u32x2 w; w.x = cvtpk_c(y[0], y[1]); w.y = cvtpk_c(y[2], y[3]); brow[64 * j] = w;
        }
    }
}
namespace gla {
constexpr int KD_ROW = 144, Q_ROW = 528, V_ROW = 144;
constexpr int L_KD = 0, L_Q = L_KD + 256 * KD_ROW, L_V = L_Q + 64 * Q_ROW, L_DEC = L_V + 128 * V_ROW, L_END = L_DEC + 1024;
}
static_assert(gla::L_END <= MISC_OFF, "GLA LDS map");
__device__ __forceinline__ void gla_unit(Frame& F, int unit) {
    using namespace gla;
    int tid_ = (F.wave * 64 + hw_lane()); asm volatile("" : "+v"(tid_));
    const int tid = tid_, lane = tid & 63, c16 = lane & 15, g = lane >> 4, wave = F.wave;
    const int head = unit >> 2, blk = unit & 3;
    const int dv0 = 128 * blk + 16 * wave;
    LAS unsigned char* lds = F.lds;
    f32x4 S[16];
#pragma unroll
    for (int T = 0; T < 16; ++T) S[T] = (f32x4){0.f, 0.f, 0.f, 0.f};
    const bf16_t* kd_g = B_KDT(F) + (size_t)head * 256 * 64 + (size_t)tid * 8;
    const bf16_t* q_g = B_H(F) + (size_t)(tid >> 5) * NPAD + C_AQ + head * 256 + (tid & 31) * 8;
    const bf16_t* v_g = B_VT(F) + ((size_t)head * 512 + 128 * blk) * 64 + (size_t)tid * 8;
    const float* d_g = B_DEC(F) + head * 256 + (tid & 63) * 4;
    const int kd_w = (tid >> 3) * KD_ROW + (tid & 7) * 16;
    const int q_w = (tid >> 5) * Q_ROW + (tid & 31) * 16;
    const int v_w = (tid >> 3) * V_ROW + (tid & 7) * 16;
    u32x4 skd[4], sq[4], sv[2]; f32x4 sd;
#define GLA_LOAD(c_) do { _Pragma("unroll") for (int i = 0; i < 4; ++i) skd[i] = *(const u32x4*)(kd_g + (size_t)(c_) * 1024 * 64 + i * 4096); \
        _Pragma("unroll") for (int i = 0; i < 4; ++i) sq[i] = *(const u32x4*)(q_g + (size_t)(64 * (c_) + 16 * i) * NPAD);                        \
        _Pragma("unroll") for (int i = 0; i < 2; ++i) sv[i] = *(const u32x4*)(v_g + (size_t)(c_) * 2048 * 64 + i * 4096);                        \
        if (tid < 64) sd = *(const f32x4*)(d_g + (size_t)(c_) * 1024); } while (0)
#define GLA_WRITE() do { _Pragma("unroll") for (int i = 0; i < 4; ++i) *(LAS u32x4*)(lds + L_KD + kd_w + i * 64 * KD_ROW) = skd[i];            \
        _Pragma("unroll") for (int i = 0; i < 4; ++i) *(LAS u32x4*)(lds + L_Q + q_w + i * 16 * Q_ROW) = sq[i];                                   \
        _Pragma("unroll") for (int i = 0; i < 2; ++i) *(LAS u32x4*)(lds + L_V + v_w + i * 64 * V_ROW) = sv[i];                                   \
        if (tid < 64) *(LAS f32x4*)(lds + L_DEC + tid * 16) = sd; } while (0)
    const int a_rd = L_KD + c16 * KD_ROW + 16 * g;
    const int b_rd = L_V + (16 * wave + c16) * V_ROW + 16 * g;
    const int q_rd = L_Q + c16 * Q_ROW + 8 * g;
    const int d_rd = L_DEC + 16 * g;
    float* o_l = B_OA(F) + (size_t)(4 * g) * 2048 + head * 512 + dv0 + c16;
    GLA_LOAD(0);
    __syncthreads();
    GLA_WRITE();
    for (int c = 0; c < NCHUNK; ++c) {
        __syncthreads();
        if (c + 1 < NCHUNK) GLA_LOAD(c + 1);
        const bf16x8 vb0 = *(const LAS bf16x8*)(lds + b_rd), vb1 = *(const LAS bf16x8*)(lds + b_rd + 64);
#pragma unroll
        for (int T4 = 0; T4 < 4; ++T4) {
            bf16x8 a[4][2]; f32x4 d4[4];
#pragma unroll
            for (int i = 0; i < 4; ++i) { const int T = 4 * T4 + i;
                a[i][0] = *(const LAS bf16x8*)(lds + a_rd + T * 16 * KD_ROW); a[i][1] = *(const LAS bf16x8*)(lds + a_rd + T * 16 * KD_ROW + 64);
                d4[i] = *(const LAS f32x4*)(lds + d_rd + 64 * T); }
#pragma unroll
            for (int i = 0; i < 4; ++i) { const int T = 4 * T4 + i;
                f32x4 acc = (f32x4){0.f, 0.f, 0.f, 0.f};
                acc = MFMA16(a[i][0], vb0, acc); acc = MFMA16(a[i][1], vb1, acc);
                S[T] = S[T] * d4[i] + acc; }
        }
        bf16x8 sb[8];
#pragma unroll
        for (int s = 0; s < 8; ++s) sb[s] = pack8f(S[2 * s][0], S[2 * s][1], S[2 * s][2], S[2 * s][3], S[2 * s + 1][0], S[2 * s + 1][1], S[2 * s + 1][2], S[2 * s + 1][3]);
#pragma unroll
        for (int tt = 0; tt < 4; ++tt) {
            u32x2 ql[8], qh[8];
#pragma unroll
            for (int s = 0; s < 8; ++s) { ql[s] = *(const LAS u32x2*)(lds + q_rd + tt * 16 * Q_ROW + 64 * s); qh[s] = *(const LAS u32x2*)(lds + q_rd + tt * 16 * Q_ROW + 64 * s + 32); }
            f32x4 acc = (f32x4){0.f, 0.f, 0.f, 0.f};
#pragma unroll
            for (int s = 0; s < 8; ++s) { const u32x4 aw = {ql[s].x, ql[s].y, qh[s].x, qh[s].y}; acc = MFMA16(__builtin_bit_cast(bf16x8, aw), sb[s], acc); }
            float* op = o_l + (size_t)(64 * c + 16 * tt) * 2048;
#pragma unroll
            for (int r = 0; r < 4; ++r) op[(size_t)r * 2048] = acc[r] * 0.0625f;
        }
        __syncthreads();
        if (c + 1 < NCHUNK) GLA_WRITE();
    }
#undef GLA_LOAD
#undef GLA_WRITE
}
__device__ __forceinline__ unsigned f2key(float s) { const unsigned b = __float_as_uint(s); return b ^ ((b >> 31) ? 0xFFFFFFFFu : 0x80000000u); }
__device__ __forceinline__ unsigned half_of(unsigned long long b, int hh) { return hh ? (unsigned)(b >> 32) : (unsigned)b; }
template <int EPL, int NB>
__device__ __forceinline__ void compactK(LAS unsigned* cv, int& cnt, unsigned& thr, int lane32, int hh) {
    unsigned k[EPL];
#pragma unroll
    for (int i = 0; i < EPL; ++i) { const int e = lane32 + 32 * i; const unsigned v = cv[e]; k[i] = (e < cnt) ? v : 0u; }
    unsigned T = 0u;
    for (int b = 31; b >= 32 - NB; --b) {
        const unsigned cand = T | (1u << b); int clo = 0, chi = 0;
#pragma unroll
        for (int i = 0; i < EPL; ++i) { const unsigned long long m = __ballot(k[i] >= cand); clo += __popc((unsigned)m); chi += __popc((unsigned)(m >> 32)); }
        if ((hh ? chi : clo) >= 256) T = cand;
        if (NB == 32 && clo == 256 && chi == 256) break;
    }
    const unsigned ltm = (1u << lane32) - 1u;
    int kept = 0;
#pragma unroll
    for (int i = 0; i < EPL; ++i) {
        const bool keep = (k[i] >= T) && (k[i] != 0u);
        const unsigned mk = half_of(__ballot(keep), hh);
        const int pos = kept + __popc(mk & ltm);
        if (keep) cv[pos] = k[i];
        kept += __popc(mk);
    }
    cnt = kept; thr = (NB == 32) ? T : (T ? T - 1u : 0u);
}
__device__ __forceinline__ int goff(int row, int ch) { return 512 * row + 16 * ((ch & 16) | ((ch & 15) ^ (((row & 3) << 2) | (((row >> 2) & 1) << 1)))); }

#ifndef SP_REPF
#define SP_REPF 1
#endif
#ifndef SP_REPB
#define SP_REPB 1
#endif
#ifndef SP_REPK
#define SP_REPK 1
#endif
#ifndef SP_REPX
#define SP_REPX 1
#endif
constexpr int SP_CAND = 0, SP_OL = 65536, SP_SEL = 131072, SP_END = SP_SEL + 8192;
static_assert(SP_END <= MISC_OFF, "sparse LDS map");
__device__ __forceinline__ void sparse_unit(Frame& F, int l, int unit) {
    int tid_ = (F.wave * 64 + hw_lane()); asm volatile("" : "+v"(tid_));
    const int tid = tid_, lane = tid & 63, wave = F.wave, r32 = lane & 31, hh = lane >> 5, c16 = lane & 15, g = lane >> 4;
    const int t0 = 16 * unit, tq0 = t0 + 2 * wave;
    const int N = 64 * ((t0 >> 6) + 1), nkb = N >> 5, ntile = (nkb + 7) >> 3;
    LAS unsigned char* reg = F.lds + SP_CAND + wave * 8192;
    LAS unsigned* cv = (LAS unsigned*)(reg + hh * 4096);
    LAS unsigned short* sel = (LAS unsigned short*)(F.lds + SP_SEL + wave * 1024);
    const bf16_t* H = B_H(F);
    int cnt = 0;
    {
        const int qq = (r32 >> 2) & 1, hd = (r32 & 3) + 4 * (r32 >> 3);
        bf16x8 A[4];
#pragma unroll
        for (int s = 0; s < 4; ++s) A[s] = *(const bf16x8*)(H + (size_t)(tq0 + qq) * NPAD + C_CIQ + hd * 64 + 16 * s + 8 * hh);
        float wv[16];
        { const bf16_t* wp = H + (size_t)(tq0 + hh) * NPAD + C_CIW;
          const bf16x8 w0 = *(const bf16x8*)wp, w1 = *(const bf16x8*)(wp + 8);
#pragma unroll
          for (int j = 0; j < 8; ++j) { wv[j] = bf2f((unsigned short)w0[j]) * 0.03125f; wv[8 + j] = bf2f((unsigned short)w1[j]) * 0.03125f; } }
        unsigned thr = 0u;
        const unsigned ltm = (1u << r32) - 1u;
        const bf16_t* kg = B_IKN(F) + (size_t)tid * 8;
        const int kw = SP_OL + (tid >> 3) * 128 + (((tid & 7) ^ ((tid >> 4) & 7)) * 16);
        int brd[4];
#pragma unroll
        for (int s = 0; s < 4; ++s) brd[s] = SP_OL + r32 * 128 + (((2 * s + hh) ^ ((r32 >> 1) & 7)) * 16);
        u32x4 stgA[4], stgB[4];
#define SP_KLOAD(st_, t_) do { _Pragma("unroll") for (int i = 0; i < 4; ++i) st_[i] = *(const u32x4*)(kg + (size_t)(t_) * 256 * 64 + i * 4096); } while (0)
#define SP_KWRITE(st_, b_) do { _Pragma("unroll") for (int i = 0; i < 4; ++i) *(LAS u32x4*)(F.lds + (b_) * 32768 + kw + i * 8192) = st_[i]; } while (0)
#define SP_TILE(tile_, b_) do {                                                                                                                  \
            { const bool full_ = __any(cnt > 640); if (lane == 0) F.MISC[16 + (b_) * 8 + wave] = full_ ? 1u : 0u; }                              \
            for (int rb_ = 0; rb_ < SP_REPB; ++rb_) __syncthreads();                                                                             \
            bool squeeze_ = __any(F.MISC[16 + (b_) * 8 + (lane & 7)] != 0u);                                                                     \
            const int nb_ = (nkb - 8 * (tile_)) < 8 ? (nkb - 8 * (tile_)) : 8;                                                                   \
            LAS unsigned char* tb_ = F.lds + (b_) * 32768;                                                                                       \
            for (int kb = 0; kb < nb_; kb += 2) {                                                                                                \
                if (squeeze_ || __any(cnt > 960)) { squeeze_ = false;                                                                            \
                    for (int rc_ = 0; rc_ < SP_REPK; ++rc_) compactK<32, 14>(cv, cnt, thr, r32, hh);                                             \
                    if (__any(cnt > 800)) compactK<32, 32>(cv, cnt, thr, r32, hh); }                                                             \
                float sc0 = 0.f, sc1 = 0.f;                                                                                                      \
                for (int rx_ = 0; rx_ < SP_REPX; ++rx_) {                                                                                        \
                bf16x8 B0[4], B1[4];                                                                                                             \
                _Pragma("unroll") for (int s = 0; s < 4; ++s) { B0[s] = *(const LAS bf16x8*)(tb_ + brd[s] + kb * 4096); B1[s] = *(const LAS bf16x8*)(tb_ + brd[s] + kb * 4096 + 4096); } \
                asm volatile("" : "+v"(B0[0]), "+v"(B0[1]), "+v"(B0[2]), "+v"(B0[3]), "+v"(B1[0]), "+v"(B1[1]), "+v"(B1[2]), "+v"(B1[3]));      \
                f32x16 acc0 = {}, acc1 = {};                                                                                                     \
                _Pragma("unroll") for (int s = 0; s < 4; ++s) { acc0 = MFMA32(A[s], B0[s], acc0); acc1 = MFMA32(A[s], B1[s], acc1); }            \
                { f32x2 s0_ = {0.f, 0.f}, s1_ = {0.f, 0.f};                                                                                      \
                _Pragma("unroll") for (int j = 0; j < 16; j += 2) { const int a0 = __float_as_int(acc0[j]), a1 = __float_as_int(acc0[j + 1]), b0 = __float_as_int(acc1[j]), b1 = __float_as_int(acc1[j + 1]); \
                    const f32x2 r0_ = {__int_as_float(a0 > 0 ? a0 : 0), __int_as_float(a1 > 0 ? a1 : 0)}, r1_ = {__int_as_float(b0 > 0 ? b0 : 0), __int_as_float(b1 > 0 ? b1 : 0)}; \
                    const f32x2 w_ = {wv[j], wv[j + 1]};                                                                                         \
                    s0_ = __builtin_elementwise_fma(r0_, w_, s0_); s1_ = __builtin_elementwise_fma(r1_, w_, s1_); }                               \
                sc0 = s0_[0] + s0_[1]; sc1 = s1_[0] + s1_[1]; }                                                                                  \
                asm volatile("" : "+v"(sc0), "+v"(sc1)); }                                                                                       \
                const unsigned ib_ = 16383u - (unsigned)(256 * (tile_) + 32 * kb + r32);                                                         \
                const unsigned key0 = (f2key(sc0) & 0xFFFFC000u) | ib_, key1 = (f2key(sc1) & 0xFFFFC000u) | (ib_ - 32u);                         \
                const bool f0 = key0 > thr, f1 = key1 > thr;                                                                                     \
                const unsigned m0 = half_of(__ballot(f0), hh), m1 = half_of(__ballot(f1), hh);                                                   \
                const int pos0 = cnt + __popc(m0 & ltm), pos1 = cnt + __popc(m0) + __popc(m1 & ltm);                                             \
                if (f0) cv[pos0] = key0;                                                                                                         \
                if (f1) cv[pos1] = key1;                                                                                                         \
                cnt += __popc(m0) + __popc(m1);                                                                                                  \
            } } while (0)
        SP_KLOAD(stgA, 0);
        SP_KWRITE(stgA, 0);
        __builtin_amdgcn_s_waitcnt(0x0F70);
        if (ntile > 1) SP_KLOAD(stgB, 1);
        for (int tile = 0; tile < ntile; tile += 2) {
            if (tile + 2 < ntile) SP_KLOAD(stgA, tile + 2);
            SP_TILE(tile, 0);
            if (tile + 1 >= ntile) break;
            SP_KWRITE(stgB, 1);
            if (tile + 3 < ntile) SP_KLOAD(stgB, tile + 3);
            SP_TILE(tile + 1, 1);
            if (tile + 2 < ntile) SP_KWRITE(stgA, 0);
        }
#undef SP_TILE
#undef SP_KLOAD
#undef SP_KWRITE
        if (__any(cnt > 256)) {
            compactK<32, 14>(cv, cnt, thr, r32, hh);
            if (__any(cnt > 512)) compactK<32, 32>(cv, cnt, thr, r32, hh); else compactK<16, 32>(cv, cnt, thr, r32, hh);
        }
#pragma unroll
        for (int i = 0; i < 8; ++i) { const int e = r32 + 32 * i; if (e < cnt) sel[hh * 256 + e] = (unsigned short)(16383u - (cv[e] & 0x3FFFu)); }
    }
    LDS_WAIT();
    __syncthreads();
    const int ns0 = __builtin_amdgcn_readlane(cnt, 0), ns1 = __builtin_amdgcn_readlane(cnt, 32);
    const int q4 = c16 >> 2, p4 = c16 & 3;
    const int trx = (q4 << 2) | ((g & 1) << 1);
    const unsigned gb = (unsigned)(uintptr_t)reg;
    unsigned tra[8];
#pragma unroll
    for (int c = 0; c < 8; ++c) tra[c] = gb + 512 * (4 * g + q4) + 8 * (p4 & 1) + 16 * ((2 * c + (p4 >> 1)) ^ trx);
    LAS unsigned short* ol = (LAS unsigned short*)(F.lds + SP_OL + wave * 8192);
#pragma unroll 1
    for (int qi = 0; qi < 2; ++qi) {
        const int tq = tq0 + qi, ns = qi ? ns1 : ns0;
        bf16x8 qf[8];
#pragma unroll
        for (int s = 0; s < 8; ++s) { bf16x8 z = {}; qf[s] = (c16 < 8) ? *(const bf16x8*)(H + (size_t)tq * NPAD + C_CQ + c16 * 256 + 32 * s + 8 * g) : z; }
        f32x4 Z[16];
#pragma unroll
        for (int c = 0; c < 16; ++c) Z[c] = (f32x4){0.f, 0.f, 0.f, 0.f};
        float m = -1e30f, ls = 0.f;
        const int nsb = (ns + 15) >> 4;
        u32x4 datA[8], datB[8];
#define SP_GATHER(d_, j_) do { const int e_ = 16 * (j_) + c16; const int idx_ = (e_ < ns) ? (int)sel[qi * 256 + e_] : 0;                        \
            const bf16_t* rp_ = B_CN(F) + (size_t)idx_ * 256 + 8 * g;                                                                            \
            _Pragma("unroll") for (int i = 0; i < 8; ++i) d_[i] = *(const u32x4*)(rp_ + 32 * i); } while (0)
#define SP_GWRITE(d_) do { _Pragma("unroll") for (int i = 0; i < 8; ++i) *(LAS u32x4*)(reg + goff(c16, 4 * i + g)) = d_[i]; } while (0)
#define TRRD(dst, a, off) asm volatile("ds_read_b64_tr_b16 %0, %1 offset:%2" : "=&v"(dst) : "v"(a), "i"(off) : "memory")
#define SP_QK(d_) do { st = (f32x4){0.f, 0.f, 0.f, 0.f};                                                                                         \
            _Pragma("unroll") for (int s = 0; s < 8; ++s) st = MFMA16(__builtin_bit_cast(bf16x8, d_[s]), qf[s], st); } while (0)
#define SP_STEP(j_) do {                                                                                                                         \
            float mloc = -__builtin_inff();                                                                                                      \
            _Pragma("unroll") for (int r = 0; r < 4; ++r) { const int e = 16 * (j_) + 4 * g + r; const float v = (e < ns) ? st[r] * 0.0625f : -__builtin_inff(); st[r] = v; mloc = fmaxf(mloc, v); } \
            mloc = xmax16(mloc); mloc = xmax32(mloc);                                                                                                      \
            const float mn = fmaxf(m, mloc), alpha = __expf(m - mn);                                                                             \
            float ps = 0.f;                                                                                                                      \
            _Pragma("unroll") for (int r = 0; r < 4; ++r) { const float p = __expf(st[r] - mn); st[r] = p; ps += p; }                            \
            ps = xsum16(ps); ps = xsum32(ps);                                                                                                            \
            ls = ls * alpha + ps; m = mn;                                                                                                        \
            const bf16x8 pa = pack8f(st[0], st[1], st[2], st[3], 0.f, 0.f, 0.f, 0.f);                                                            \
            if (__any(alpha < 1.f)) {                                                                                                            \
                float ar[4];                                                                                                                     \
                _Pragma("unroll") for (int r = 0; r < 4; ++r) ar[r] = bperm_f(4 * g + r, alpha);                                                  \
                _Pragma("unroll") for (int c = 0; c < 16; ++c) _Pragma("unroll") for (int r = 0; r < 4; ++r) Z[c][r] *= ar[r];                   \
            }                                                                                                                                    \
            _Pragma("unroll") for (int c = 0; c < 8; c += 2) {                                                                                   \
                s16x4 l0, l1, l2, l3;                                                                                                            \
                TRRD(l0, tra[c], 0); TRRD(l1, tra[c], 256); TRRD(l2, tra[c + 1], 0); TRRD(l3, tra[c + 1], 256);                                  \
                asm volatile("s_waitcnt lgkmcnt(0)" ::: "memory"); __builtin_amdgcn_sched_barrier(0);                                            \
                Z[c] = MFMA16(pa, ((bf16x8){l0[0], l0[1], l0[2], l0[3], 0, 0, 0, 0}), Z[c]);                                                     \
                Z[c + 8] = MFMA16(pa, ((bf16x8){l1[0], l1[1], l1[2], l1[3], 0, 0, 0, 0}), Z[c + 8]);                                             \
                Z[c + 1] = MFMA16(pa, ((bf16x8){l2[0], l2[1], l2[2], l2[3], 0, 0, 0, 0}), Z[c + 1]);                                             \
                Z[c + 9] = MFMA16(pa, ((bf16x8){l3[0], l3[1], l3[2], l3[3], 0, 0, 0, 0}), Z[c + 9]);                                             \
            } } while (0)
        f32x4 st;
        SP_GATHER(datA, 0);
        if (nsb > 1) SP_GATHER(datB, 1);
        for (int j = 0; j < nsb; j += 2) {
            SP_QK(datA); SP_GWRITE(datA);
            if (j + 2 < nsb) SP_GATHER(datA, j + 2);
            SP_STEP(j);
            if (j + 1 >= nsb) break;
            SP_QK(datB); SP_GWRITE(datB);
            if (j + 3 < nsb) SP_GATHER(datB, j + 3);
            SP_STEP(j + 1);
        }
#undef SP_QK
#undef SP_STEP
#undef TRRD
#undef SP_GATHER
#undef SP_GWRITE
        float inv[4];
#pragma unroll
        for (int r = 0; r < 4; ++r) inv[r] = 1.f / bperm_f(4 * g + r, ls);
        if (g < 2) {
#pragma unroll
            for (int c = 0; c < 16; ++c) {
                const int lat = 16 * c + c16;
#pragma unroll
                for (int r = 0; r < 4; ++r) ol[(qi * 8 + 4 * g + r) * 256 + lat] = (unsigned short)(cvtpk_c(Z[c][r] * inv[r], 0.f) & 0xffffu);
            }
        }
    }
    LDS_WAIT();
    __syncthreads();
    {
        const int hd = wave;
        bf16x8 A[8];
#pragma unroll
        for (int s = 0; s < 8; ++s) A[s] = *(const LAS bf16x8*)(F.lds + SP_OL + (c16 >> 1) * 8192 + (((c16 & 1) * 8 + hd) * 256 + 32 * s + 8 * g) * 2);
        const bf16_t* wb = B_WUVT(F) + ((size_t)(l * 8 + hd) * 128 + c16) * 256 + 8 * g;
#pragma unroll 1
        for (int n4 = 0; n4 < 2; ++n4) {
            bf16x8 b[4][8];
#pragma unroll
            for (int n = 0; n < 4; ++n)
#pragma unroll
                for (int s = 0; s < 8; ++s) b[n][s] = *(const bf16x8*)(wb + (size_t)(4 * n4 + n) * 16 * 256 + 32 * s);
#pragma unroll
            for (int n = 0; n < 4; ++n) {
                f32x4 acc = (f32x4){0.f, 0.f, 0.f, 0.f};
#pragma unroll
                for (int s = 0; s < 8; ++s) acc = MFMA16(A[s], b[n][s], acc);
#pragma unroll
                for (int r = 0; r < 4; ++r) { const int t = t0 + 4 * g + r; const int col = hd * 128 + 16 * (4 * n4 + n) + c16;
                    const float gt = bf2f(H[(size_t)t * NPAD + C_CG + col]);
                    B_O(F)[(size_t)t * DM + 3072 + col] = (bf16_t)(cvtpk_c(acc[r] * silu(gt), 0.f) & 0xffffu); }
            }
        }
    }
}
namespace da2 {
constexpr int VB = 32768, KB0 = 98304, KBS = 16384;
constexpr float C2 = 0.08838834764831845f * 1.4426950408889634f;
static_assert(KB0 + 3 * KBS <= MISC_OFF, "da2 LDS map");
__device__ __forceinline__ void block(Frame& F, int id) {
    int tid_ = F.wave * 64 + hw_lane(); asm volatile("" : "+v"(tid_));
    const int tid = tid_, lane = tid & 63, c16 = lane & 15, g = lane >> 4, wave = F.wave;
    const int qb = 127 - (id >> 3), hm = id & 7, hd = hm >> 1, mp = hm & 1;
    const int P0 = 128 * qb, NT = 2 * qb + 2;
    const int cw = (P0 + 16 * wave) >> 6;
    const bf16_t* H = B_H(F);
    LAS unsigned char* lds = F.lds;
    bf16x8 qf[4];
#pragma unroll
    for (int s = 0; s < 4; ++s) qf[s] = *(const bf16x8*)(H + (size_t)(P0 + 16 * wave + c16) * NPAD + C_BQ + hd * 256 + mp * 128 + 32 * s + 8 * g);
    const bf16_t* Kb = H + C_BK + hd * 256 + mp * 128;
    const bf16_t* Vb = H + C_BV + hd * 256;
    int kofs[2], vofs[4];
#pragma unroll
    for (int i = 0; i < 2; ++i) { const int row = 8 * wave + 4 * i + (lane >> 4); kofs[i] = row * NPAD + 8 * ((lane & 15) ^ (row & 15)); }
#pragma unroll
    for (int i = 0; i < 4; ++i) { const int row = 8 * wave + 2 * i + (lane >> 5), sl = lane & 31; vofs[i] = row * NPAD + 8 * ((sl & 16) | ((sl & 15) ^ (((row & 3) << 2) | (((row >> 2) & 1) << 1)))); }
    int ksw[4];
#pragma unroll
    for (int s = 0; s < 4; ++s) ksw[s] = KB0 + c16 * 256 + (((4 * s + g) ^ c16) * 16);
    const int q4 = c16 >> 2, p4 = c16 & 3, trx = (q4 << 2) | ((g & 1) << 1);
    const unsigned lb = (unsigned)(uintptr_t)lds;
    unsigned tra[8];
#pragma unroll
    for (int c = 0; c < 8; ++c) { tra[c] = lb + 512 * (4 * g + q4) + 8 * (p4 & 1) + 16 * ((2 * c + (p4 >> 1)) ^ trx); }
    f32x4 O[16];
#pragma unroll
    for (int c = 0; c < 16; ++c) O[c] = (f32x4){0.f, 0.f, 0.f, 0.f};
    float m = -1e30f, l = 0.f;
    f32x4 st[4], sn[4];
#define DA_DMAK(t_, slot_) do { const int tt_ = (t_) < NT ? (t_) : NT - 1; _Pragma("unroll") for (int i = 0; i < 2; ++i)                                \
        __builtin_amdgcn_global_load_lds((const unsigned*)(Kb + (size_t)(64 * tt_) * NPAD + kofs[i]), (LAS unsigned*)(lds + KB0 + (slot_) * KBS + (2 * wave + i) * 1024), 16, 0, 0); } while (0)
#define DA_DMAV(t_, buf_) do { const int tt_ = (t_) < NT ? (t_) : NT - 1; _Pragma("unroll") for (int i = 0; i < 4; ++i)                                 \
        __builtin_amdgcn_global_load_lds((const unsigned*)(Vb + (size_t)(64 * tt_) * NPAD + vofs[i]), (LAS unsigned*)(lds + (buf_) * VB + (4 * wave + i) * 1024), 16, 0, 0); } while (0)
#define DA_TR(dst, a, off) asm volatile("ds_read_b64_tr_b16 %0, %1 offset:%2" : "=&v"(dst) : "v"(a), "i"(off) : "memory")
#define DA_TR8(A_, c_, o_, L0, H0, L1, H1, L2, H2, L3, H3) do { const unsigned ta_ = tra[c_] + (A_);                                             \
        DA_TR(L0, ta_, (o_) + 0); DA_TR(H0, ta_, (o_) + 8192); DA_TR(L1, ta_, (o_) + 256); DA_TR(H1, ta_, (o_) + 8448);                           \
        DA_TR(L2, ta_, (o_) + 16384); DA_TR(H2, ta_, (o_) + 24576); DA_TR(L3, ta_, (o_) + 16640); DA_TR(H3, ta_, (o_) + 24832); } while (0)
#define DA_MM4(c_, L0, H0, L1, H1, L2, H2, L3, H3) do {                                                                                          \
        O[c_] = MFMA16(pa0, ((bf16x8){L0[0], L0[1], L0[2], L0[3], H0[0], H0[1], H0[2], H0[3]}), O[c_]);                                          \
        O[c_ + 8] = MFMA16(pa0, ((bf16x8){L1[0], L1[1], L1[2], L1[3], H1[0], H1[1], H1[2], H1[3]}), O[c_ + 8]);                                  \
        O[c_] = MFMA16(pa1, ((bf16x8){L2[0], L2[1], L2[2], L2[3], H2[0], H2[1], H2[2], H2[3]}), O[c_]);                                          \
        O[c_ + 8] = MFMA16(pa1, ((bf16x8){L3[0], L3[1], L3[2], L3[3], H3[0], H3[1], H3[2], H3[3]}), O[c_ + 8]); } while (0)
#define DA_WAITL(n_) do { asm volatile("s_waitcnt lgkmcnt(" #n_ ")" ::: "memory"); __builtin_amdgcn_sched_barrier(0); } while (0)
#define DA_QK(dst_, koff_) do { bf16x8 a_[4][4];                            \
        _Pragma("unroll") for (int T = 0; T < 4; ++T) _Pragma("unroll") for (int s = 0; s < 4; ++s) a_[T][s] = *(const LAS bf16x8*)(lds + (koff_) + ksw[s] + T * 4096); \
        asm volatile("" : "+v"(a_[0][0]), "+v"(a_[0][1]), "+v"(a_[0][2]), "+v"(a_[0][3]), "+v"(a_[1][0]), "+v"(a_[1][1]), "+v"(a_[1][2]), "+v"(a_[1][3]), \
                          "+v"(a_[2][0]), "+v"(a_[2][1]), "+v"(a_[2][2]), "+v"(a_[2][3]), "+v"(a_[3][0]), "+v"(a_[3][1]), "+v"(a_[3][2]), "+v"(a_[3][3])); \
        _Pragma("unroll") for (int T = 0; T < 4; ++T) dst_[T] = (f32x4){0.f, 0.f, 0.f, 0.f};                                                     \
        _Pragma("unroll") for (int s = 0; s < 4; ++s) _Pragma("unroll") for (int T = 0; T < 4; ++T) dst_[T] = MFMA16(a_[T][s], qf[s], dst_[T]); } while (0)
#define DA_SM() \
        float mloc = st[0][0];                                                                                                                   \
        _Pragma("unroll") for (int T = 0; T < 4; ++T) _Pragma("unroll") for (int r = 0; r < 4; ++r) mloc = fmaxf(mloc, st[T][r]);                \
        mloc = xmax16(mloc); mloc = xmax32(mloc);                                              \
        const float mn = fmaxf(m, mloc), alpha = __builtin_amdgcn_exp2f((m - mn) * C2), mnL = -mn * C2;                                         \
        float ps = 0.f;                                                                                                                          \
        _Pragma("unroll") for (int T = 0; T < 4; ++T) _Pragma("unroll") for (int r = 0; r < 4; ++r) { const float p = __builtin_amdgcn_exp2f(fmaf(st[T][r], C2, mnL)); st[T][r] = p; ps += p; } \
        ps = xsum16(ps); ps = xsum32(ps);                                                                              \
        l = l * alpha + ps; m = mn;                                                                                                              \
        const bf16x8 pa0 = pack8f(st[0][0], st[0][1], st[0][2], st[0][3], st[1][0], st[1][1], st[1][2], st[1][3]);                               \
        const bf16x8 pa1 = pack8f(st[2][0], st[2][1], st[2][2], st[2][3], st[3][0], st[3][1], st[3][2], st[3][3]);
#define DA_RESC() do { if (__any(alpha < 1.f)) { float ar[4];                                                                                    \
            _Pragma("unroll") for (int r = 0; r < 4; ++r) ar[r] = bperm_f(4 * g + r, alpha);                                                     \
            _Pragma("unroll") for (int c = 0; c < 16; ++c) _Pragma("unroll") for (int r = 0; r < 4; ++r) O[c][r] *= ar[r]; } } while (0)
#define DA_PV(A_, o_) do { s16x4 xl0, xh0, xl1, xh1, xl2, xh2, xl3, xh3, yl0, yh0, yl1, yh1, yl2, yh2, yl3, yh3;                                 \
          LDS_WAIT();                                                                                                                            \
          DA_TR8(A_, 0, o_, xl0, xh0, xl1, xh1, xl2, xh2, xl3, xh3);                                                                             \
          DA_TR8(A_, 1, o_, yl0, yh0, yl1, yh1, yl2, yh2, yl3, yh3); DA_WAITL(8); DA_MM4(0, xl0, xh0, xl1, xh1, xl2, xh2, xl3, xh3);             \
          DA_TR8(A_, 2, o_, xl0, xh0, xl1, xh1, xl2, xh2, xl3, xh3); DA_WAITL(8); DA_MM4(1, yl0, yh0, yl1, yh1, yl2, yh2, yl3, yh3);             \
          DA_TR8(A_, 3, o_, yl0, yh0, yl1, yh1, yl2, yh2, yl3, yh3); DA_WAITL(8); DA_MM4(2, xl0, xh0, xl1, xh1, xl2, xh2, xl3, xh3);             \
          DA_TR8(A_, 4, o_, xl0, xh0, xl1, xh1, xl2, xh2, xl3, xh3); DA_WAITL(8); DA_MM4(3, yl0, yh0, yl1, yh1, yl2, yh2, yl3, yh3);             \
          DA_TR8(A_, 5, o_, yl0, yh0, yl1, yh1, yl2, yh2, yl3, yh3); DA_WAITL(8); DA_MM4(4, xl0, xh0, xl1, xh1, xl2, xh2, xl3, xh3);             \
          DA_TR8(A_, 6, o_, xl0, xh0, xl1, xh1, xl2, xh2, xl3, xh3); DA_WAITL(8); DA_MM4(5, yl0, yh0, yl1, yh1, yl2, yh2, yl3, yh3);             \
          DA_TR8(A_, 7, o_, yl0, yh0, yl1, yh1, yl2, yh2, yl3, yh3); DA_WAITL(8); DA_MM4(6, xl0, xh0, xl1, xh1, xl2, xh2, xl3, xh3);             \
          DA_WAITL(0); DA_MM4(7, yl0, yh0, yl1, yh1, yl2, yh2, yl3, yh3); } while (0)
#define DA_ITER(t_, p_, A_, o_) do {                                                                                                             \
        asm volatile("s_waitcnt vmcnt(6)" ::: "memory"); __builtin_amdgcn_s_barrier(); asm volatile("" ::: "memory");                            \
        DA_DMAK((t_) + 3, (p_)); DA_DMAV((t_) + 2, ((p_) + 2) % 3);                                                                              \
        const bool nxt_ = ((t_) + 1 < NT) && ((t_) + 1 <= cw);                                                                                   \
          \
        if (nxt_) DA_QK(sn, (((p_) + 1) % 3) * KBS);                                                                                             \
        if ((t_) <= cw) { DA_SM() DA_RESC(); DA_PV(A_, o_); }                                                                                    \
        if (nxt_) { _Pragma("unroll") for (int T = 0; T < 4; ++T) st[T] = sn[T]; } } while (0)
    asm volatile("s_waitcnt vmcnt(0)" ::: "memory");
    __syncthreads();
    DA_DMAK(0, 0); DA_DMAV(0, 0); DA_DMAK(1, 1);
    DA_DMAK(2, 2); DA_DMAV(1, 1);
    asm volatile("s_waitcnt vmcnt(6)" ::: "memory"); __builtin_amdgcn_s_barrier(); asm volatile("" ::: "memory");
    DA_QK(st, 0);
    for (int t = 0; t < NT; t += 3) {
        DA_ITER(t, 0, 0u, 0);
        if (t + 1 >= NT) break;
        DA_ITER(t + 1, 1, 0u, 32768);
        if (t + 2 >= NT) break;
        DA_ITER(t + 2, 2, 65536u, 0);
    }
    asm volatile("s_waitcnt vmcnt(0)" ::: "memory");
#undef DA_ITER
#undef DA_PV
#undef DA_RESC
#undef DA_SM
#undef DA_QK
#undef DA_TR8
#undef DA_MM4
#undef DA_WAITL
#undef DA_TR
#undef DA_DMAK
#undef DA_DMAV
    float inv[4];
#pragma unroll
    for (int r = 0; r < 4; ++r) inv[r] = 1.f / bperm_f(4 * g + r, l);
    float* Op = B_OD(F) + (size_t)(P0 + 16 * wave + 4 * g) * 2048 + hd * 512 + mp * 256 + c16;
#pragma unroll
    for (int c = 0; c < 16; ++c)
#pragma unroll
        for (int r = 0; r < 4; ++r) Op[(size_t)r * 2048 + 16 * c] = O[c][r] * inv[r];
}
}
__device__ __forceinline__ dattn::BlockRef dattn_ref(const bf16_t* H, float* OD, int id) {
    dattn::BlockRef r; const int qb = 63 - (id >> 4), ph = id & 15, hd = ph >> 2, mp = (ph >> 1) & 1, e = ph & 1;
    r.Q = H + (size_t)(qb * 256) * NPAD + C_BQ + hd * 256 + mp * 128; r.K = H + C_BK + hd * 256 + mp * 128; r.V = H + C_BV + hd * 256 + e * 128;
    r.O = OD + (size_t)(qb * 256) * 2048 + hd * 512 + mp * 256 + e * 128; r.P0 = qb * 256; return r;
}
#ifndef REPP
#define REPP 1
#endif
#ifndef REPBAR
#define REPBAR 1
#endif
#ifndef REPA
#define REPA 1
#endif
#ifndef REPB
#define REPB 1
#endif
#ifndef REPC
#define REPC 1
#endif
#ifndef REPG1
#define REPG1 1
#endif
#ifndef REPS
#define REPS 1
#endif
#ifndef MIXMASK
#define MIXMASK 7
#endif
__device__ __forceinline__ void mix_phase(Frame& F, int l) {
    if (MIXMASK & 1) for (int rep = 0; rep < REPA; ++rep) { const int qx = rep * 16 + l * 4 + 0;
        for (int u = grab(F, qx); u < 16; u = grab(F, qx)) gla_unit(F, u); }
#ifndef USE_DA2
#define USE_DA2 1
#endif
#if USE_DA2
    if (MIXMASK & 2) for (int rep = 0; rep < REPB; ++rep) { const int qx = rep * 16 + l * 4 + 1;
        for (int u = grab(F, qx); u < 1024; u = grab(F, qx)) da2::block(F, u);
        __syncthreads();
    }
#else
    if (MIXMASK & 2) for (int rep = 0; rep < REPB; ++rep) { const int qx = rep * 16 + l * 4 + 1;
        int cur = grab(F, qx);
        if (cur < 1024) {
            dattn::Seam S;
            dattn::BlockRef rc = dattn_ref(B_H(F), B_OD(F), cur);
            dattn::prime(rc, (char*)F.lds, S, F.wave);
            for (;;) {
                const int nx = grab(F, qx); const bool last = nx >= 1024;
                const dattn::BlockRef rn = last ? rc : dattn_ref(B_H(F), B_OD(F), nx);
                dattn::block(rc, rn, (char*)F.lds, S, F.wave);
                if (last) break;
                rc = rn;
            }
            VM_WAIT(); __syncthreads();
        }
    }
#endif
    if (MIXMASK & 4) for (int rep = 0; rep < REPC; ++rep) { const int qx = rep * 16 + l * 4 + 2;
        for (int u = grab(F, qx); u < SEQ / 16; u = grab(F, qx)) sparse_unit(F, l, SEQ / 16 - 1 - u); }
}

struct Args { const float* in[14]; float* out; unsigned char* ws; int ph_lo, ph_hi, li, pad; };
constexpr int NPHASE = 1 + 6 * DEPTH;
__global__ void __launch_bounds__(NWAVES * 64, 2) trunk_fwd(Args args) {
    extern __shared__ __attribute__((aligned(16))) unsigned char lds[];
    Frame F;
    F.lds = (LAS unsigned char*)lds;
    F.MISC = (volatile LAS unsigned*)(F.lds + MISC_OFF);
    F.wave = __builtin_amdgcn_readfirstlane((int)threadIdx.x >> 6);
    F.G = gridDim.x; { const int bx = blockIdx.x; F.vcu = (F.G % 8 == 0) ? (bx % 8) * (F.G / 8) + bx / 8 : bx; }
    F.ws = args.ws;
    F.ctl = (gu32*)(args.ws + WS_CTL);
    if (threadIdx.x < 128) ((LAS unsigned*)(F.lds + MISC_OFF))[threadIdx.x] = 0u;
    __syncthreads();
    XcdBarrier bar = xcd_barrier_post((unsigned*)(F.ctl + CW_BAR), F.MISC + 0);
#ifndef PMASK
#define PMASK 0x7f
#endif
#define IN(k) true
#define SEAM(k) do { if ((k) + 1 < NPHASE) { XcdBarrier b2_ = bar; unsigned xx_ = b2_.x; asm volatile("" : "+s"(xx_)); b2_.x = xx_; for (int rb_ = 0; rb_ < REPBAR; ++rb_) xcd_barrier(b2_); } } while (0)
    if ((PMASK & 1) && IN(0)) { for (int rp_ = 0; rp_ < REPP; ++rp_) p0_prologue(F, args.in[0], args.in[1], args.in[2], args.in[11]); SEAM(0); }
    for (int l = 0; l < DEPTH; ++l) {
        const int pb = 1 + 6 * l;
        const float lam_init = 0.8f - 0.6f * expf(-0.3f * (float)l);
        if ((PMASK & 2) && IN(pb + 0)) {
            pg8::Gemm g{B_XB(F), B_WTIN(F) + (size_t)l * NPAD * DM, SEQ, NPAD, DM}; pg8::StaticOrder S; S.init(SEQ, NPAD, F.G, (int)blockIdx.x);
            pg8::EpiBf16Plain E{B_H(F), NPAD};
            for (int rep = 0; rep < REPG1; ++rep) pg8::gemm_phase<pg8::EpiBf16Plain, pg8::StaticOrder, true, true>(F.lds, g, S, E, F.wave);
            SEAM(pb + 0);
        }
        if ((PMASK & 4) && IN(pb + 1)) { for (int rep = 0; rep < REPS; ++rep) prep_phase(F, l, args.in[3], args.in[4], args.in[8], args.in[9], args.in[10]); SEAM(pb + 1); }
        if ((PMASK & 8) && IN(pb + 2)) { mix_phase(F, l); SEAM(pb + 2); }
        if ((PMASK & 16) && IN(pb + 3)) { for (int rep = 0; rep < REPS; ++rep) post_phase(F, l, lam_init, args.in[5], args.in[6], args.in[7]); SEAM(pb + 3); }
        if ((PMASK & 32) && IN(pb + 4)) {
            pg8::Gemm g{B_O(F), B_WTOUT(F) + (size_t)l * DM * DM, SEQ, DM, DM}; pg8::StaticOrder S; S.init(SEQ, DM, F.G, (int)blockIdx.x);
            pg8::EpiResid E{l == 0 ? args.in[0] : B_XF(F), B_XF(F), DM, 1.6817928305074290f};
            pg8::gemm_phase<pg8::EpiResid, pg8::StaticOrder, true, true>(F.lds, g, S, E, F.wave);
            SEAM(pb + 4);
        }
        if ((PMASK & 64) && IN(pb + 5)) {
#if defined(REPLN)
            ln_phase(F, l, args.in[12], args.in[13], args.out, true);
#endif
            ln_phase(F, l, args.in[12], args.in[13], args.out, false); SEAM(pb + 5); }
    }
#undef IN
#undef SEAM
}

#ifndef MK_N_LAUNCHES
#define MK_N_LAUNCHES 1
#endif
extern "C" void kernel_launch(void* const* d_in, const int* in_sizes, int n_in, void* d_out, int out_size, void* d_ws, size_t ws_size, hipStream_t stream) {
    static int grid = 0;
    if (grid == 0) {
        if (n_in != 14 || in_sizes[0] != SEQ * DM || out_size != SEQ * DM || ws_size < WS_END) {
            fprintf(stderr, "kernel_launch: shape mismatch (n_in %d, in0 %d, out %d, ws %zu; need ws >= %zu)\n", n_in, n_in > 0 ? in_sizes[0] : -1, out_size, ws_size, (size_t)WS_END); grid = -1; return; }
        int dev = 0, cus = 0, per_cu = 0;
        if (hipGetDevice(&dev) != hipSuccess || hipDeviceGetAttribute(&cus, hipDeviceAttributeMultiprocessorCount, dev) != hipSuccess) { grid = -1; return; }
        if (hipFuncSetAttribute((const void*)trunk_fwd, hipFuncAttributeMaxDynamicSharedMemorySize, LDS_BYTES) != hipSuccess) { fprintf(stderr, "kernel_launch: hipFuncSetAttribute failed\n"); grid = -1; return; }
        if (hipOccupancyMaxActiveBlocksPerMultiprocessor(&per_cu, (const void*)trunk_fwd, NWAVES * 64, LDS_BYTES) != hipSuccess || per_cu < 1)
            fprintf(stderr, "kernel_launch: occupancy query reports %d workgroups per CU\n", per_cu);
        (void)hipGetLastError();
        grid = cus;
    }
    if (grid < 0) return;
    if (hipMemsetAsync((char*)d_ws + WS_CTL, 0, CTL_ZERO_BYTES, stream) != hipSuccess) return;
    Args a{};
    for (int i = 0; i < 14; ++i) a.in[i] = (const float*)d_in[i];
    a.out = (float*)d_out; a.ws = (unsigned char*)d_ws;
    a.ph_lo = 0; a.ph_hi = NPHASE; a.li = 0; a.pad = 0;
    hipLaunchKernelGGL(trunk_fwd, dim3(grid), dim3(NWAVES * 64), LDS_BYTES, stream, a);
    const hipError_t le = hipPeekAtLastError();
    if (le != hipSuccess) fprintf(stderr, "kernel_launch: launch failed: %s\n", hipGetErrorName(le));
}
```

```cpp
#include <hip/hip_runtime.h>
#include <cstdio>
#include <cstdint>

#define GAS __attribute__((address_space(1)))
#define LAS __attribute__((address_space(3)))
typedef unsigned short bf16_t;
typedef short s16x4 __attribute__((ext_vector_type(4)));
typedef float f32x16 __attribute__((ext_vector_type(16)));
typedef unsigned u32x2 __attribute__((ext_vector_type(2)));
typedef GAS unsigned gu32;

__device__ __forceinline__ int hw_lane() { int r; asm volatile("v_mbcnt_lo_u32_b32 %0, -1, 0\n\tv_mbcnt_hi_u32_b32 %0, -1, %0" : "=v"(r)); return r; }

constexpr int SEQ = 16384, DM = 4096, DEPTH = 4, NIN = 14688, NPAD = 14848;
constexpr int CHUNK = 64, NCHUNK = SEQ / CHUNK;
constexpr int C_AQ = 0, C_AK = 1024, C_AV = 2048, C_AG = 4096, C_BQ = 6144, C_BK = 7168, C_BV = 8192, C_BG = 9216, C_CQ = 10240,
              C_CKV = 12288, C_CIQ = 12544, C_CG = 13568, C_CIK = 14592, C_AA = 14656, C_CIW = 14672;
__host__ __device__ __forceinline__ int srccol(int n) {
    if (n < 4096) return n;
    if (n < 6144) return n + 16;
    if (n < 13568) return n + 16;
    if (n < 14592) return n + 96;
    if (n < 14656) return n - 1008;
    if (n < 14672) return n - 10560;
    if (n < 14688) return n - 1024;
    return -1;
}
namespace pg8 {
#define PG8_LAS __attribute__((address_space(3)))
typedef unsigned short bf16_t;
typedef short bf16x8 __attribute__((ext_vector_type(8)));
typedef float f32x4 __attribute__((ext_vector_type(4)));
typedef unsigned u32x4 __attribute__((ext_vector_type(4)));
constexpr int BM = 256, BK = 64, HALF = 128, HTB = HALF * BK * 2  , STAGE_BYTES = 8 * HTB, NXCD = 8, WGM = 8;

__host__ __device__ __forceinline__ int lds_byte(int r, int c) { const int st = (r >> 4) * 2 + (c >> 5), rr = r & 15, cc = c & 31, ob = rr * 64 + cc * 2; return st * 1024 + (ob ^ (((ob >> 9) & 1) << 5)); }
__host__ __device__ __forceinline__ void stage_rc(int b, int& R, int& C) { const int st = b / 1024, sb = b % 1024, swz = sb ^ (((sb >> 9) & 1) << 5); R = (st >> 1) * 16 + swz / 64; C = (st & 1) * 32 + (swz % 64) / 2; }
__host__ __device__ __forceinline__ int perm32(int rho) { const int n = rho >> 4, i = rho & 15; return 8 * (i >> 2) + 4 * n + (i & 3); }

struct Unit { int pm, pn; };
struct Gemm { const bf16_t* A; const bf16_t* Bt; int M, N, K; };

struct StaticOrder {
    int nM, nN, nwg, G, c;
    __host__ __device__ void init(int M, int N, int G_, int c_) { nM = M / BM; nN = N / BM; nwg = nM * nN; G = G_; c = c_; }
    __host__ __device__ bool next(int i, Unit& u) const {
        const long L = (long)i * G + c; if (L >= nwg) return false;
        int wgid = (int)L; { const int q = nwg / NXCD, r = nwg % NXCD, xcd = wgid % NXCD, off = wgid / NXCD; wgid = (xcd < r ? xcd * (q + 1) : r * (q + 1) + (xcd - r) * q) + off; }
        const int nig = WGM * nN, gid = wgid / nig, fm = gid * WGM, gsz = (nM - fm) < WGM ? (nM - fm) : WGM;
        u.pm = fm + ((wgid % nig) % gsz); u.pn = (wgid % nig) / gsz; return true;
    }
    __device__ __forceinline__ void a_ready(const Unit&) const {}
    __device__ __forceinline__ void done(const Unit&) const {}
};

__device__ __forceinline__ unsigned cvt_pk_bf16(float lo, float hi) { unsigned r; asm volatile("v_cvt_pk_bf16_f32 %0, %1, %2" : "=v"(r) : "v"(lo), "v"(hi)); return r; }
typedef float f32x2 __attribute__((ext_vector_type(2)));
struct EpiBf16Plain {
    static constexpr bool PERM = true, AFTER_DRAIN = false;
    bf16_t* O; int ldc;
    __device__ __forceinline__ void operator()(const f32x4 (&acc)[2][2][4][2], const Unit& u, int wr, int wc, int fr, int fq) const {
        const int row0 = u.pm * BM + wr * 64 + fr, col0 = u.pn * BM + wc * 32 + 8 * fq;
#pragma unroll
        for (int ai = 0; ai < 2; ++ai)
#pragma unroll
            for (int m = 0; m < 4; ++m) { bf16_t* rowp = O + (size_t)(row0 + ai * HALF + m * 16) * ldc + col0;
#pragma unroll
                for (int bj = 0; bj < 2; ++bj) { const f32x4 v0 = acc[ai][bj][m][0], v1 = acc[ai][bj][m][1];
                    u32x4 w; w.x = cvt_pk_bf16(v0[0], v0[1]); w.y = cvt_pk_bf16(v0[2], v0[3]); w.z = cvt_pk_bf16(v1[0], v1[1]); w.w = cvt_pk_bf16(v1[2], v1[3]);
                    *(u32x4*)(rowp + bj * HALF) = w; } }
    }
};
struct EpiResid {
    static constexpr bool PERM = false, AFTER_DRAIN = false;
    const float* Xin; float* Xout; int ldc; float alpha;
    __device__ __forceinline__ void operator()(const f32x4 (&acc)[2][2][4][2], const Unit& u, int wr, int wc, int fr, int fq) const {
        const int row0 = u.pm * BM + wr * 64 + fr, col0 = u.pn * BM + wc * 32 + 4 * fq;
#pragma unroll
        for (int ai = 0; ai < 2; ++ai)
#pragma unroll
            for (int m = 0; m < 4; ++m) { const size_t off = (size_t)(row0 + ai * HALF + m * 16) * ldc + col0;
#pragma unroll
                for (int bj = 0; bj < 2; ++bj)
#pragma unroll
                    for (int n = 0; n < 2; ++n) { const f32x4 xi = *(const f32x4*)(Xin + off + bj * HALF + n * 16);
                        *(f32x4*)(Xout + off + bj * HALF + n * 16) = xi * alpha + acc[ai][bj][m][n]; }
                asm volatile("" ::: "memory"); }
    }
};
struct EpiResidB {
    static constexpr bool PERM = false, AFTER_DRAIN = false;
    const bf16_t* Xin; float* Xout; int ldc; float alpha;
    __device__ __forceinline__ void operator()(const f32x4 (&acc)[2][2][4][2], const Unit& u, int wr, int wc, int fr, int fq) const {
        const int row0 = u.pm * BM + wr * 64 + fr, col0 = u.pn * BM + wc * 32 + 4 * fq;
#pragma unroll
        for (int ai = 0; ai < 2; ++ai)
#pragma unroll
            for (int m = 0; m < 4; ++m) { const size_t off = (size_t)(row0 + ai * HALF + m * 16) * ldc + col0;
#pragma unroll
                for (int bj = 0; bj < 2; ++bj)
#pragma unroll
                    for (int n = 0; n < 2; ++n) { const unsigned long long w = *(const unsigned long long*)(Xin + off + bj * HALF + n * 16);
                        const unsigned lo = (unsigned)w, hi = (unsigned)(w >> 32);
                        const f32x4 xi = {__uint_as_float(lo << 16), __uint_as_float(lo & 0xffff0000u), __uint_as_float(hi << 16), __uint_as_float(hi & 0xffff0000u)};
                        *(f32x4*)(Xout + off + bj * HALF + n * 16) = xi * alpha + acc[ai][bj][m][n]; }
                asm volatile("" ::: "memory"); }
    }
};
template <class Epi, class Sched, bool ALIGN_EPI = false, bool SP2 = false>
__device__ __forceinline__ void gemm_phase(PG8_LAS unsigned char* lds, const Gemm g, const Sched& S, const Epi& E, int wave_id) {
    int tid_ = wave_id * 64 + hw_lane(); asm volatile("" : "+v"(tid_));
    const int tid = tid_, wid = __builtin_amdgcn_readfirstlane(tid >> 6), lane = tid & 63, wr = wid >> 2, wc = wid & 3, fr = lane & 15, fq = lane >> 4;
    const int K = g.K, nt = K / BK;
    unsigned voffA[2], voffB[2];
#pragma unroll
    for (int i = 0; i < 2; ++i) { int R, C; stage_rc(tid * 16 + i * 8192, R, C); const int Rb = Epi::PERM ? ((R & ~31) + perm32(R & 31)) : R;
        voffA[i] = (unsigned)(R * K + C) * 2u; voffB[i] = (unsigned)(Rb * K + C) * 2u; }
    const size_t kstep = (size_t)(BK * 2);
    const size_t hstep = (size_t)HALF * K * 2;
    const size_t tstep = 2 * hstep;
    const unsigned ldsw = (unsigned)wid * 1024u;
    const int aoff = lds_byte(wr * 64 + fr, fq * 8), boff = lds_byte(wc * 32 + fr, fq * 8);
#define PG8_SA(b, h) (((b) * 2 + (h)) * HTB)
#define PG8_SB(b, h) ((4 + (b) * 2 + (h)) * HTB)
#define PG8_STAGE(bufoff, gbase, voff) do { _Pragma("unroll") for (int _i = 0; _i < 2; ++_i) \
        __builtin_amdgcn_global_load_lds((const unsigned*)((const char*)(gbase) + (voff)[_i]), (PG8_LAS unsigned*)(lds + (bufoff) + ldsw + _i * 8192), 16, 0, 0); } while (0)
#define PG8_LDA(dst, b, h) do { _Pragma("unroll") for (int m = 0; m < 4; ++m) _Pragma("unroll") for (int k = 0; k < 2; ++k) dst[m][k] = *(const PG8_LAS bf16x8*)(lds + PG8_SA(b, h) + aoff + m * 2048 + k * 1024); } while (0)
#define PG8_LDB(dst, b, h) do { _Pragma("unroll") for (int n = 0; n < 2; ++n) _Pragma("unroll") for (int k = 0; k < 2; ++k) dst[n][k] = *(const PG8_LAS bf16x8*)(lds + PG8_SB(b, h) + boff + n * 2048 + k * 1024); } while (0)
#define PG8_MMA(ai, bj, At, Bt) do { __builtin_amdgcn_s_setprio(1); _Pragma("unroll") for (int m = 0; m < 4; ++m) _Pragma("unroll") for (int n = 0; n < 2; ++n) _Pragma("unroll") for (int k = 0; k < 2; ++k) \
        acc[ai][bj][m][n] = __builtin_amdgcn_mfma_f32_16x16x32_bf16(Bt[n][k], At[m][k], acc[ai][bj][m][n], 0, 0, 0); __builtin_amdgcn_s_setprio(0); } while (0)
#define PG8_WAIT_V(n) asm volatile("s_waitcnt vmcnt(" #n ")" ::: "memory")
#define PG8_WAIT_L(n) asm volatile("s_waitcnt lgkmcnt(" #n ")" ::: "memory")
#define PG8_BAR __builtin_amdgcn_s_barrier()
#define PG8_SCHED __builtin_amdgcn_sched_barrier(0)
    Unit cur, nxt; int ui = 0;
    if (!S.next(0, cur)) return;
    f32x4 acc[2][2][4][2];
#pragma unroll
    for (int a = 0; a < 2; ++a)
#pragma unroll
        for (int b = 0; b < 2; ++b)
#pragma unroll
            for (int m = 0; m < 4; ++m)
#pragma unroll
                for (int n = 0; n < 2; ++n) acc[a][b][m][n] = (f32x4){0.f, 0.f, 0.f, 0.f};
    bf16x8 At[4][2], B0[2][2], B1[2][2];
    const char* cA = (const char*)g.A + (size_t)cur.pm * tstep; const char* cB = (const char*)g.Bt + (size_t)cur.pn * tstep;
    S.a_ready(cur);
    if constexpr (SP2) {
        PG8_STAGE(PG8_SB(0, 0), cB, voffB); PG8_STAGE(PG8_SB(0, 1), cB + hstep, voffB); PG8_STAGE(PG8_SA(0, 0), cA, voffA); PG8_STAGE(PG8_SA(0, 1), cA + hstep, voffA);
        if (wr == 1) PG8_BAR;
        PG8_WAIT_V(2); PG8_BAR;
        PG8_STAGE(PG8_SB(1, 0), cB + kstep, voffB); PG8_STAGE(PG8_SA(1, 0), cA + kstep, voffA); PG8_STAGE(PG8_SB(1, 1), cB + hstep + kstep, voffB);
        PG8_WAIT_V(6); PG8_BAR;
    } else {
        PG8_STAGE(PG8_SB(0, 0), cB, voffB); PG8_STAGE(PG8_SA(0, 0), cA, voffA); PG8_STAGE(PG8_SB(0, 1), cB + hstep, voffB); PG8_STAGE(PG8_SA(0, 1), cA + hstep, voffA);
        if (wr == 1) PG8_BAR;
        PG8_WAIT_V(4); PG8_BAR;
        PG8_STAGE(PG8_SB(1, 0), cB + kstep, voffB); PG8_STAGE(PG8_SA(1, 0), cA + kstep, voffA); PG8_STAGE(PG8_SB(1, 1), cB + hstep + kstep, voffB);
        PG8_WAIT_V(6); PG8_BAR;
    }
    for (;;) {
        const bool has_next = S.next(ui + 1, nxt);
        const char* nA = has_next ? (const char*)g.A + (size_t)nxt.pm * tstep : cA; const char* nB = has_next ? (const char*)g.Bt + (size_t)nxt.pn * tstep : cB;
        for (int t = 0; t < nt; t += 2) {
            const bool last = (t == nt - 2);
            const char* a1 = cA + (size_t)(t + 1) * kstep;
            const char* a2 = last ? nA : cA + (size_t)(t + 2) * kstep; const char* b2 = last ? nB : cB + (size_t)(t + 2) * kstep;
            const char* a3 = a2 + kstep; const char* b3 = b2 + kstep;
            if (last && has_next) S.a_ready(nxt);
            if constexpr (SP2) {
            PG8_LDB(B0, 0, 0); PG8_LDB(B1, 0, 1); PG8_SCHED; PG8_LDA(At, 0, 0); PG8_STAGE(PG8_SA(1, 1), a1 + hstep, voffA);
            PG8_WAIT_V(8); PG8_WAIT_L(0); PG8_BAR; PG8_MMA(0, 0, At, B0); PG8_MMA(0, 1, At, B1); PG8_BAR; PG8_SCHED;
            PG8_LDA(At, 0, 1); PG8_STAGE(PG8_SB(0, 0), b2, voffB); PG8_STAGE(PG8_SB(0, 1), b2 + hstep, voffB); PG8_STAGE(PG8_SA(0, 0), a2, voffA);
            PG8_WAIT_V(8); PG8_WAIT_L(0); PG8_BAR; PG8_MMA(1, 0, At, B0); PG8_MMA(1, 1, At, B1); PG8_BAR; PG8_SCHED;
            PG8_LDB(B0, 1, 0); PG8_LDB(B1, 1, 1); PG8_SCHED; PG8_LDA(At, 1, 0); PG8_STAGE(PG8_SA(0, 1), a2 + hstep, voffA);
            PG8_WAIT_V(8); PG8_WAIT_L(0); PG8_BAR; PG8_MMA(0, 0, At, B0); PG8_MMA(0, 1, At, B1); PG8_BAR; PG8_SCHED;
            PG8_LDA(At, 1, 1); PG8_STAGE(PG8_SB(1, 0), b3, voffB); PG8_STAGE(PG8_SB(1, 1), b3 + hstep, voffB); PG8_STAGE(PG8_SA(1, 0), a3, voffA);
            PG8_WAIT_V(8); PG8_WAIT_L(0); PG8_BAR; PG8_MMA(1, 0, At, B0); PG8_MMA(1, 1, At, B1); PG8_BAR; PG8_SCHED;
            } else {
            PG8_LDB(B0, 0, 0); PG8_SCHED; PG8_LDA(At, 0, 0); PG8_STAGE(PG8_SA(1, 1), a1 + hstep, voffA);
            PG8_WAIT_L(8); PG8_BAR; PG8_WAIT_L(0); PG8_MMA(0, 0, At, B0); PG8_BAR; PG8_SCHED;
            PG8_LDB(B1, 0, 1); PG8_STAGE(PG8_SB(0, 0), b2, voffB);
            PG8_BAR; PG8_WAIT_L(0); PG8_MMA(0, 1, At, B1); PG8_BAR;
            PG8_LDA(At, 0, 1); PG8_STAGE(PG8_SA(0, 0), a2, voffA);
            PG8_BAR; PG8_WAIT_L(0); PG8_MMA(1, 0, At, B0); PG8_BAR; PG8_SCHED;
            PG8_STAGE(PG8_SB(0, 1), b2 + hstep, voffB);
            PG8_WAIT_V(6); PG8_BAR; PG8_MMA(1, 1, At, B1); PG8_BAR;
            PG8_LDB(B0, 1, 0); PG8_SCHED; PG8_LDA(At, 1, 0); PG8_STAGE(PG8_SA(0, 1), a2 + hstep, voffA);
            PG8_WAIT_L(8); PG8_BAR; PG8_WAIT_L(0); PG8_MMA(0, 0, At, B0); PG8_BAR; PG8_SCHED;
            PG8_LDB(B1, 1, 1); PG8_STAGE(PG8_SB(1, 0), b3, voffB);
            PG8_BAR; PG8_WAIT_L(0); PG8_MMA(0, 1, At, B1); PG8_BAR;
            PG8_LDA(At, 1, 1); PG8_STAGE(PG8_SA(1, 0), a3, voffA);
            PG8_BAR; PG8_WAIT_L(0); PG8_MMA(1, 0, At, B0); PG8_BAR; PG8_SCHED;
            PG8_STAGE(PG8_SB(1, 1), b3 + hstep, voffB);
            PG8_WAIT_V(6); PG8_BAR; PG8_MMA(1, 1, At, B1); PG8_BAR;
            }
        }
        if constexpr (ALIGN_EPI) { if (wr == 0) PG8_BAR; }
        if constexpr (!Epi::AFTER_DRAIN) { E(acc, cur, wr, wc, fr, fq); S.done(cur); }
        if (!has_next) break;
#pragma unroll
        for (int a = 0; a < 2; ++a)
#pragma unroll
            for (int b = 0; b < 2; ++b)
#pragma unroll
                for (int m = 0; m < 4; ++m)
#pragma unroll
                    for (int n = 0; n < 2; ++n) acc[a][b][m][n] = (f32x4){0.f, 0.f, 0.f, 0.f};
        cur = nxt; cA = nA; cB = nB; ++ui;
        if constexpr (ALIGN_EPI) { if (wr == 1) PG8_BAR; }
    }
    PG8_WAIT_V(0);
    if constexpr (!ALIGN_EPI) { if (wr == 0) PG8_BAR; }
    PG8_BAR;
    if constexpr (Epi::AFTER_DRAIN) { E.fused(acc, cur, wr, wc, fr, fq, lds, wid, lane); S.done(cur); }
#undef PG8_SA
#undef PG8_SB
#undef PG8_STAGE
#undef PG8_LDA
#undef PG8_LDB
#undef PG8_MMA
#undef PG8_WAIT_V
#undef PG8_WAIT_L
#undef PG8_BAR
#undef PG8_SCHED
}
}
using pg8::bf16x8; using pg8::f32x4; using pg8::u32x4;
namespace dattn {
constexpr int D = 128, LDQ = NPAD, LDK = NPAD, LDO = 2048;
constexpr float SCALE = 0.08838834764831845f;
constexpr float THR = 8.f;
constexpr int NW = 8, QBLK = 32, KVBLK = 64, QB = NW * QBLK;
constexpr int SHM_V = KVBLK * D * 2, SHM_K = KVBLK * D * 2;
constexpr int LDS_BYTES = 2 * SHM_V + 2 * SHM_K + NW * 64 * 4;

#define KSWZ(row, colB) ((row) * 256 + ((colB) ^ (((row) & 7) << 4)))
#define SBAR() __builtin_amdgcn_sched_barrier(0)
__device__ __forceinline__ int v_st(int k, int c) { const int kk = (k & ~0xC) | ((k & 4) << 1) | ((k & 8) >> 1); return ((kk >> 3) * 4 + (c >> 5)) * 512 + ((kk & 7) * 32 + (c & 31)) * 2; }
__device__ __forceinline__ int v_rd_base(int lane) { return ((lane & 3) << 3) | (((lane >> 2) & 3) << 6) | (((lane >> 4) & 1) << 5) | (((lane >> 5) & 1) << 8); }
constexpr int v_rd_off(int d0, int ks, int half) { return d0 * 512 + ks * 4096 + half * 2048; }
__device__ __forceinline__ int crow(int r, int hi) { return (r & 3) + 8 * (r >> 2) + 4 * hi; }
__device__ __forceinline__ unsigned cvtpk(float lo, float hi) { unsigned r; asm volatile("v_cvt_pk_bf16_f32 %0, %1, %2" : "=v"(r) : "v"(lo), "v"(hi)); return r; }
__device__ __forceinline__ bf16x8 load8(const bf16_t* p) { return *reinterpret_cast<const bf16x8*>(p); }

__device__ __forceinline__ void partialSM(f32x16& p0, f32x16& p1, float& m_reg, float& mn, float& alpha) {
    float pmax = p0[0]; for (int r = 1; r < 16; ++r) pmax = fmaxf(pmax, p0[r]); for (int r = 0; r < 16; ++r) pmax = fmaxf(pmax, p1[r]);
    { auto rr = __builtin_amdgcn_permlane32_swap(__float_as_uint(pmax), __float_as_uint(pmax), false, false);
      pmax = fmaxf(__uint_as_float(rr[0]), __uint_as_float(rr[1])); }
    constexpr float C2 = 1.4426950408889634f * SCALE;
    if (__builtin_expect(__all((pmax - m_reg) * SCALE <= THR), 1)) { mn = m_reg; alpha = 1.f; }
    else { mn = fmaxf(m_reg, pmax); alpha = __builtin_amdgcn_exp2f((m_reg - mn) * C2); m_reg = mn; }
    const float mnL = -mn * C2;
    for (int r = 0; r < 16; ++r) p0[r] = fmaf(p0[r], C2, mnL); for (int r = 0; r < 16; ++r) p1[r] = fmaf(p1[r], C2, mnL);
    for (int r = 0; r < 16; ++r) p0[r] = __builtin_amdgcn_exp2f(p0[r]);
}
__device__ __forceinline__ void finishSM(f32x16& p0, f32x16& p1, float alpha, float& l_reg, bf16x8& pa0, bf16x8& pa1, bf16x8& pa2, bf16x8& pa3) {
    for (int r = 0; r < 16; ++r) p1[r] = __builtin_amdgcn_exp2f(p1[r]);
    float ps = 0; for (int r = 0; r < 16; ++r) ps += p0[r]; for (int r = 0; r < 16; ++r) ps += p1[r];
    { auto rr = __builtin_amdgcn_permlane32_swap(__float_as_uint(ps), __float_as_uint(ps), false, false);
      ps = __uint_as_float(rr[0]) + __uint_as_float(rr[1]); }
    l_reg = l_reg * alpha + ps;
#define PK4(P, B_, OUT) do { unsigned a0 = cvtpk(P[B_+0], P[B_+1]), a1 = cvtpk(P[B_+2], P[B_+3]);                          \
        unsigned b0 = cvtpk(P[B_+4], P[B_+5]), b1 = cvtpk(P[B_+6], P[B_+7]);                                             \
        auto r0 = __builtin_amdgcn_permlane32_swap(a0, b0, false, false); auto r1 = __builtin_amdgcn_permlane32_swap(a1, b1, false, false); \
        u32x4 w = {r0[0], r1[0], r0[1], r1[1]}; OUT = *reinterpret_cast<bf16x8*>(&w); } while (0)
    PK4(p0, 0, pa0); PK4(p0, 8, pa1); PK4(p1, 0, pa2); PK4(p1, 8, pa3);
#undef PK4
}
template <int KB>
__device__ __forceinline__ void qkt(f32x16& p0, f32x16& p1, const char* K_lds, int r32, int hi, const bf16x8* qr) {
    p0 = f32x16{}; p1 = f32x16{};
    const char* kb[4];
#pragma unroll
    for (int dd = 0; dd < 4; ++dd) kb[dd] = K_lds + KB * SHM_K + KSWZ(r32, (dd * 16 + hi * 8) * 2);
#pragma unroll
    for (int d0 = 0; d0 < 8; ++d0) { const char* a = kb[d0 & 3] + (d0 >> 2) * 128;
        bf16x8 b0 = *reinterpret_cast<const bf16x8*>(a);
        bf16x8 b1 = *reinterpret_cast<const bf16x8*>(a + 32 * 256);
        p0 = __builtin_amdgcn_mfma_f32_32x32x16_bf16(b0, qr[d0], p0, 0, 0, 0);
        p1 = __builtin_amdgcn_mfma_f32_32x32x16_bf16(b1, qr[d0], p1, 0, 0, 0); }
}
template <int VB>
__device__ __forceinline__ void pv_tile(f32x16* o, int vb0, bf16x8 pa0, bf16x8 pa1, bf16x8 pa2, bf16x8 pa3) {
#define TRRD(dst, off) asm volatile("ds_read_b64_tr_b16 %0, %1 offset:%2" : "=&v"(dst) : "v"(vb0), "i"(off) : "memory")
#define PV_D0(d0) do { s16x4 l0, l1, l2, l3, h0, h1, h2, h3; constexpr int b_ = VB * SHM_V + v_rd_off(d0, 0, 0);   \
        TRRD(l0, b_); TRRD(h0, b_ + 2048); TRRD(l1, b_ + 4096); TRRD(h1, b_ + 6144); TRRD(l2, b_ + 8192); TRRD(h2, b_ + 10240); TRRD(l3, b_ + 12288); TRRD(h3, b_ + 14336); \
        asm volatile("s_waitcnt lgkmcnt(0)" ::: "memory"); SBAR();                                                   \
        o[d0] = __builtin_amdgcn_mfma_f32_32x32x16_bf16(pa0, (bf16x8){l0[0], l0[1], l0[2], l0[3], h0[0], h0[1], h0[2], h0[3]}, o[d0], 0, 0, 0);   \
        o[d0] = __builtin_amdgcn_mfma_f32_32x32x16_bf16(pa1, (bf16x8){l1[0], l1[1], l1[2], l1[3], h1[0], h1[1], h1[2], h1[3]}, o[d0], 0, 0, 0);   \
        o[d0] = __builtin_amdgcn_mfma_f32_32x32x16_bf16(pa2, (bf16x8){l2[0], l2[1], l2[2], l2[3], h2[0], h2[1], h2[2], h2[3]}, o[d0], 0, 0, 0);   \
        o[d0] = __builtin_amdgcn_mfma_f32_32x32x16_bf16(pa3, (bf16x8){l3[0], l3[1], l3[2], l3[3], h3[0], h3[1], h3[2], h3[3]}, o[d0], 0, 0, 0); } while (0)
    PV_D0(0); PV_D0(1); PV_D0(2); PV_D0(3);
#undef PV_D0
#undef TRRD
}

struct BlockRef { const bf16_t* Q; const bf16_t* K; const bf16_t* V; float* O; int P0; };
struct Seam { bf16x8 qr[8]; bf16x8 st_v0, st_v1, st_k0, st_k1; };
#define ROW(p, k0, rr) ((p) + (size_t)((k0) + (rr)) * LDK + sc)
#define VMW() asm volatile("s_waitcnt vmcnt(0)" ::: "memory")
#define VMWN(n) asm volatile("s_waitcnt vmcnt(%0)" :: "i"(n) : "memory")
#define SLOAD_H(Kp, Vp, k0) do { S.st_v0 = load8(ROW(Vp, k0, sr)); S.st_v1 = load8(ROW(Vp, k0, 32 + sr));              \
                         S.st_k0 = load8(ROW(Kp, k0, sr)); S.st_k1 = load8(ROW(Kp, k0, 32 + sr)); } while (0)
#define SWRITE_HK(bf) do { *(bf16x8*)(K_lds + (bf) * SHM_K + kws) = S.st_k0; *(bf16x8*)(K_lds + (bf) * SHM_K + kws + 32 * 256) = S.st_k1; } while (0)
#define SWRITE_HV(bf) do { *(bf16x8*)(V_lds + (bf) * SHM_V + vst0) = S.st_v0; *(bf16x8*)(V_lds + (bf) * SHM_V + vst1) = S.st_v1; } while (0)
#define SWRITE_H(bf) do { SWRITE_HV(bf); SWRITE_HK(bf); } while (0)
__device__ __forceinline__ void prime(const BlockRef& cur, char* lds, Seam& S, int wave_id) {
    int tid_ = wave_id * 64 + hw_lane(); asm volatile("" : "+v"(tid_));
    const int tid = tid_, wid = __builtin_amdgcn_readfirstlane(tid >> 6), lane = tid & 63, r32 = lane & 31, hi = lane >> 5;
    const int sr = tid >> 4, sc = (tid & 15) * 8, kws = KSWZ(sr, sc * 2); char* K_lds = lds + 2 * SHM_V;
#pragma unroll
    for (int d0 = 0; d0 < 8; ++d0) S.qr[d0] = load8(cur.Q + (size_t)(wid * QBLK + r32) * LDQ + d0 * 16 + hi * 8);
    SLOAD_H(cur.K, cur.V, 0); VMW(); SWRITE_HK(0);
    __syncthreads();
}
__device__ __forceinline__ void block(const BlockRef& cur, const BlockRef& nxt, char* lds, Seam& S, int wave_id) {
    int tid_ = wave_id * 64 + hw_lane(); asm volatile("" : "+v"(tid_));
    const int tid = tid_, wid = __builtin_amdgcn_readfirstlane(tid >> 6), lane = tid & 63, r32 = lane & 31, hi = lane >> 5;
    const int NT = cur.P0 / KVBLK + 4;
    const int qlo = cur.P0 + wid * QBLK;
    const int qend = qlo | 63;
    char* V_lds = lds; char* K_lds = lds + 2 * SHM_V;
    float* ws = (float*)(lds + 2 * SHM_V + 2 * SHM_K) + wid * 64; float* li_l = ws, * al_l = ws + 32;
    float m_reg = -1e30f, l_reg = 0; f32x16 o[4] = {};
    const int sr = tid >> 4, sc = (tid & 15) * 8, vst0 = v_st(sr, sc), vst1 = v_st(32 + sr, sc), kws = KSWZ(sr, sc * 2);
    const int vb0 = (int)(uintptr_t)V_lds + v_rd_base(lane);
    const bf16_t* Kh = cur.K; const bf16_t* Vh = cur.V;
#define RESC(a) do { if (__any((a) < 1.f)) { if (hi == 0) al_l[r32] = (a); asm volatile("s_waitcnt lgkmcnt(0)" ::: "memory");              \
                     for (int d_ = 0; d_ < 4; ++d_) for (int r = 0; r < 16; ++r) o[d_][r] *= al_l[crow(r, hi)]; } } while (0)
#define KBASE(t) ((t) * KVBLK)
#define MASKT(P0_, P1_, t) do { if (KBASE(t) > qend) { const float NEG_ = -__builtin_inff(); _Pragma("unroll") for (int r_ = 0; r_ < 16; ++r_) { P0_[r_] = NEG_; P1_[r_] = NEG_; } } } while (0)
    constexpr int NQL = 8;
#define SEAM_K0() do { VMWN(NQL); SWRITE_HK(0); SBAR(); } while (0)
    f32x16 pA0, pA1, pB0, pB1; float mnA, mnB, alA, alB; bf16x8 pa0, pa1, pa2, pa3;
    SWRITE_HV(0); SBAR();
    if (NT > 1) { SLOAD_H(Kh, Vh, KBASE(1)); }
    SBAR(); qkt<0>(pA0, pA1, K_lds, r32, hi, S.qr);
    MASKT(pA0, pA1, 0); partialSM(pA0, pA1, m_reg, mnA, alA);
    if (NT > 1) { VMW(); SWRITE_H(1); }
    __syncthreads();
#define HALF_STEP(PX0, PX1, mnX, alX, PY0, PY1, alY, t, KB, VB, SB) do {                                                      \
        SBAR(); qkt<KB>(PX0, PX1, K_lds, r32, hi, S.qr);                                                                      \
        finishSM(PY0, PY1, alY, l_reg, pa0, pa1, pa2, pa3); SBAR();                                                           \
        if ((t) + 1 < NT) { SLOAD_H(Kh, Vh, KBASE((t) + 1)); SBAR(); }                                                        \
        pv_tile<VB>(o, vb0, pa0, pa1, pa2, pa3); MASKT(PX0, PX1, (t)); partialSM(PX0, PX1, m_reg, mnX, alX);                  \
        __syncthreads();                                                                                                      \
        if ((t) + 1 < NT) { VMW(); SWRITE_H(SB); }                                                                            \
        RESC(alX); __syncthreads(); } while (0)
    for (int t = 1; t + 1 < NT; t += 2) {
        HALF_STEP(pB0, pB1, mnB, alB, pA0, pA1, alA, t, 1, 0, 0);
        HALF_STEP(pA0, pA1, mnA, alA, pB0, pB1, alB, t + 1, 0, 1, 1);
    }
    SBAR(); qkt<1>(pB0, pB1, K_lds, r32, hi, S.qr); SBAR();
    SLOAD_H(nxt.K, nxt.V, 0); SBAR();
#pragma unroll
    for (int d0 = 0; d0 < 8; ++d0) S.qr[d0] = load8(nxt.Q + (size_t)(wid * QBLK + r32) * LDQ + d0 * 16 + hi * 8);
    SBAR();
    finishSM(pA0, pA1, alA, l_reg, pa0, pa1, pa2, pa3); SBAR();
    pv_tile<0>(o, vb0, pa0, pa1, pa2, pa3);
    MASKT(pB0, pB1, NT - 1); partialSM(pB0, pB1, m_reg, mnB, alB); __syncthreads(); RESC(alB);
    finishSM(pB0, pB1, alB, l_reg, pa0, pa1, pa2, pa3); SBAR(); pv_tile<1>(o, vb0, pa0, pa1, pa2, pa3);
    SBAR(); SEAM_K0();
    if (hi == 0) li_l[r32] = l_reg; asm volatile("s_waitcnt lgkmcnt(0)" ::: "memory");
    float rli[16];
#pragma unroll
    for (int r = 0; r < 16; ++r) rli[r] = __builtin_amdgcn_rcpf(li_l[crow(r, hi)]);
    float* Ow = cur.O + (size_t)(wid * QBLK) * LDO;
#pragma unroll
    for (int r = 0; r < 16; ++r) { const int orow = crow(r, hi);
#pragma unroll
        for (int d0 = 0; d0 < 4; ++d0) Ow[(size_t)orow * LDO + d0 * 32 + r32] = o[d0][r] * rli[r]; }
    __syncthreads();
#undef RESC
#undef KBASE
#undef MASKT
#undef SEAM_K0
#undef HALF_STEP
}
#undef ROW
#undef VMW
#undef VMWN
#undef SLOAD_H
#undef SWRITE_HK
#undef SWRITE_HV
#undef SWRITE_H
#undef KSWZ
#undef SBAR
}
#define XB_TMO      128
#define XB_XCNT(j)  (256  + 64 * (j))
#define XB_XSUB(j)  (1280 + 64 * (j))
#define XB_XGEN(j)  (2304 + 64 * (j))
#define XB_TOP      3328
#define XB_TOPGEN   3392
#define XCD_BAR_WORDS 3456
#define XB_SPIN_CAP (1u << 18)

__device__ __forceinline__ unsigned xb_ld(unsigned* p)              { return __hip_atomic_load(p, __ATOMIC_RELAXED, __HIP_MEMORY_SCOPE_AGENT); }
__device__ __forceinline__ unsigned xb_add(unsigned* p, unsigned v) { return __hip_atomic_fetch_add(p, v, __ATOMIC_RELAXED, __HIP_MEMORY_SCOPE_AGENT); }
__device__ __forceinline__ unsigned xb_xcc_id() { return (unsigned)__builtin_amdgcn_s_getreg((3 << 11) | 20) & 0xFu; }
#define XB_SPIN(cond, bar) do { unsigned _sp = 0; while (cond) { __builtin_amdgcn_s_sleep(1); \
    if ((++_sp & 255u) == 0u) { if (xb_ld(&(bar)[XB_TMO])) break; if (_sp > XB_SPIN_CAP) { atomicAdd(&(bar)[XB_TMO], 1u); break; } } } } while (0)

struct XcdBarrier {
    unsigned* bar; unsigned x;
    volatile LAS unsigned* st;
};

__device__ __forceinline__ XcdBarrier xcd_barrier_post(unsigned* bar, volatile LAS unsigned* st) {
    XcdBarrier b; b.bar = bar; b.x = xb_xcc_id(); b.st = st;
    if (threadIdx.x == 0) (void)xb_add(&bar[XB_XCNT(b.x)], 1u);
    return b;
}
__device__ __forceinline__ void xcd_barrier_complete(unsigned* bar, unsigned x, unsigned& nloc, unsigned& nx) {
    const unsigned G = gridDim.x * gridDim.y * gridDim.z;
    unsigned sum, cnt, mine, sp = 0u;
    for (;;) {
        sum = 0u; cnt = 0u; mine = 0u;
#pragma unroll
        for (unsigned j = 0; j < 16; ++j) { const unsigned c = xb_ld(&bar[XB_XCNT(j)]); sum += c; cnt += (c > 0u) ? 1u : 0u; mine = (j == x) ? c : mine; }
        if (sum == G) break;
        __builtin_amdgcn_s_sleep(1);
        if ((++sp & 255u) == 0u) { if (xb_ld(&bar[XB_TMO])) break; if (sp > XB_SPIN_CAP) { atomicAdd(&bar[XB_TMO], 1u); break; } }
    }
    nloc = mine > 0u ? mine : 1u; nx = cnt > 0u ? cnt : 1u;
}

__device__ __forceinline__ void xcd_barrier(const XcdBarrier& b) {
    asm volatile("s_waitcnt vmcnt(0)" ::: "memory");
    __syncthreads();
    if (threadIdx.x == 0) {
        unsigned* bar = b.bar;
        __builtin_amdgcn_s_waitcnt(0);
        unsigned nloc = b.st[0], nx = b.st[1];
        if (nloc == 0u) { xcd_barrier_complete(bar, b.x, nloc, nx); b.st[0] = nloc; b.st[1] = nx; }
        const unsigned old = xb_add(&bar[XB_XSUB(b.x)], 1u);
        const unsigned gen = old / nloc;
        if (old + 1u == (gen + 1u) * nloc) {
            __builtin_amdgcn_fence(__ATOMIC_RELEASE, "agent");
            asm volatile("s_waitcnt vmcnt(0)" ::: "memory");
            const unsigned og = xb_add(&bar[XB_TOP], 1u);
            const unsigned tg = og / nx;
            if (og + 1u == (tg + 1u) * nx) xb_add(&bar[XB_TOPGEN], 1u);
            else XB_SPIN(xb_ld(&bar[XB_TOPGEN]) == tg, bar);
            __builtin_amdgcn_fence(__ATOMIC_ACQUIRE, "agent");
            xb_add(&bar[XB_XGEN(b.x)], 1u);
            asm volatile("s_waitcnt vmcnt(0)" ::: "memory");
        } else {
            XB_SPIN(xb_ld(&bar[XB_XGEN(b.x)]) == gen, bar);
            __builtin_amdgcn_fence(__ATOMIC_ACQUIRE, "agent");
            asm volatile("s_waitcnt vmcnt(0)" ::: "memory");
        }
    }
    __syncthreads();
}
constexpr size_t MiB = 1u << 20;
constexpr size_t WS_CTL = 0, CTL_ZERO_BYTES = 1 * MiB;
constexpr size_t WS_WTIN = 2 * MiB;
constexpr size_t WS_WTOUT = WS_WTIN + (size_t)DEPTH * NPAD * DM * 2;
constexpr size_t WS_WUVT = WS_WTOUT + (size_t)DEPTH * DM * DM * 2;
constexpr size_t WS_XB = WS_WUVT + 2 * MiB;
constexpr size_t WS_XF = WS_XB + (size_t)SEQ * DM * 2;
constexpr size_t WS_H = WS_XF + (size_t)SEQ * DM * 4;
constexpr size_t WS_O = WS_H + (size_t)SEQ * NPAD * 2;
constexpr size_t WS_CN = WS_O + (size_t)SEQ * DM * 2;
constexpr size_t WS_IKN = WS_CN + (size_t)SEQ * 256 * 2;
constexpr size_t WS_KDT = WS_IKN + (size_t)SEQ * 64 * 2;
constexpr size_t WS_DEC = WS_KDT + (size_t)NCHUNK * 1024 * 64 * 2;
constexpr size_t WS_VT = WS_DEC + (size_t)NCHUNK * 1024 * 4;
constexpr size_t WS_OA = WS_VT + (size_t)NCHUNK * 2048 * 64 * 2;
constexpr size_t WS_OD = WS_OA + (size_t)SEQ * 2048 * 4;
constexpr size_t WS_END = WS_OD + (size_t)SEQ * 2048 * 4;
constexpr int CW_TMO = 0;
constexpr int CW_BAR = 4096, BAR_STRIDE = 4096;
constexpr int CW_Q = 200000;
static_assert((CW_Q + 64 * 16 + 64) * 4 <= (int)CTL_ZERO_BYTES && CW_BAR + 32 * BAR_STRIDE <= CW_Q, "CTL map");
constexpr int NWAVES = 8;
constexpr int WREG = 18432;
constexpr int MISC_OFF = NWAVES * WREG;
constexpr int LDS_BYTES = MISC_OFF + 512;
static_assert(pg8::STAGE_BYTES <= MISC_OFF && dattn::LDS_BYTES <= MISC_OFF, "LDS map");

#define LDS_WAIT() asm volatile("s_waitcnt lgkmcnt(0)" ::: "memory")
#define VM_WAIT() asm volatile("s_waitcnt vmcnt(0)" ::: "memory")
typedef __bf16 bf16x2v __attribute__((ext_vector_type(2)));
typedef float f32x2 __attribute__((ext_vector_type(2)));
__device__ __forceinline__ unsigned cvtpk_c(float lo, float hi) { f32x2 v = {lo, hi}; bf16x2v b = __builtin_convertvector(v, bf16x2v); return __builtin_bit_cast(unsigned, b); }
__device__ __forceinline__ float bf2f(unsigned b) { return __uint_as_float(b << 16); }
__device__ __forceinline__ float bflo(unsigned w) { return __uint_as_float(w << 16); }
__device__ __forceinline__ float bfhi(unsigned w) { return __uint_as_float(w & 0xffff0000u); }
__device__ __forceinline__ bf16x8 pack8f(float a0, float a1, float a2, float a3, float a4, float a5, float a6, float a7) {
    u32x4 w = {cvtpk_c(a0, a1), cvtpk_c(a2, a3), cvtpk_c(a4, a5), cvtpk_c(a6, a7)}; return __builtin_bit_cast(bf16x8, w); }
__device__ __forceinline__ float bperm_f(int src_lane, float v) { return __int_as_float(__builtin_amdgcn_ds_bpermute(src_lane << 2, __float_as_int(v))); }
__device__ __forceinline__ float xmax16(float x) { const auto r = __builtin_amdgcn_permlane16_swap(__float_as_uint(x), __float_as_uint(x), false, false); return fmaxf(__uint_as_float(r[0]), __uint_as_float(r[1])); }
__device__ __forceinline__ float xmax32(float x) { const auto r = __builtin_amdgcn_permlane32_swap(__float_as_uint(x), __float_as_uint(x), false, false); return fmaxf(__uint_as_float(r[0]), __uint_as_float(r[1])); }
__device__ __forceinline__ float xsum16(float x) { const auto r = __builtin_amdgcn_permlane16_swap(__float_as_uint(x), __float_as_uint(x), false, false); return __uint_as_float(r[0]) + __uint_as_float(r[1]); }
__device__ __forceinline__ float xsum32(float x) { const auto r = __builtin_amdgcn_permlane32_swap(__float_as_uint(x), __float_as_uint(x), false, false); return __uint_as_float(r[0]) + __uint_as_float(r[1]); }
__device__ __forceinline__ float wave_sum(float v) {
    const int ln = hw_lane();
#pragma unroll
    for (int o = 1; o < 64; o <<= 1) v += bperm_f(ln ^ o, v);
    return v;
}
__device__ __forceinline__ void wave_sum2(float& a, float& b) {
    const int ln = hw_lane();
#pragma unroll
    for (int o = 1; o < 64; o <<= 1) { const float ta = bperm_f(ln ^ o, a), tb = bperm_f(ln ^ o, b); a += ta; b += tb; }
}
__device__ __forceinline__ float silu(float x) { return x / (1.f + __expf(-x)); }
#define MFMA16(a, b, c) __builtin_amdgcn_mfma_f32_16x16x32_bf16((a), (b), (c), 0, 0, 0)
#define MFMA32(a, b, c) __builtin_amdgcn_mfma_f32_32x32x16_bf16((a), (b), (c), 0, 0, 0)

struct Frame {
    LAS unsigned char* lds;
    volatile LAS unsigned* MISC;
    gu32* ctl;
    unsigned char* ws;
    int wave, vcu, G;
};
#define B_WTIN(F)  ((bf16_t*)((F).ws + WS_WTIN))
#define B_WTOUT(F) ((bf16_t*)((F).ws + WS_WTOUT))
#define B_WUVT(F)  ((bf16_t*)((F).ws + WS_WUVT))
#define B_XB(F)    ((bf16_t*)((F).ws + WS_XB))
#define B_XF(F)    ((float*)((F).ws + WS_XF))
#define B_H(F)     ((bf16_t*)((F).ws + WS_H))
#define B_O(F)     ((bf16_t*)((F).ws + WS_O))
#define B_CN(F)    ((bf16_t*)((F).ws + WS_CN))
#define B_IKN(F)   ((bf16_t*)((F).ws + WS_IKN))
#define B_KDT(F)   ((bf16_t*)((F).ws + WS_KDT))
#define B_DEC(F)   ((float*)((F).ws + WS_DEC))
#define B_VT(F)    ((bf16_t*)((F).ws + WS_VT))
#define B_OA(F)    ((float*)((F).ws + WS_OA))
#define B_OD(F)    ((float*)((F).ws + WS_OD))
__device__ __forceinline__ int grab(Frame& F, int qidx) {
    if ((F.wave * 64 + hw_lane()) == 0) F.MISC[2] = __hip_atomic_fetch_add((unsigned*)(F.ctl + CW_Q + 64 * qidx), 1u, __ATOMIC_RELAXED, __HIP_MEMORY_SCOPE_AGENT);
    __syncthreads(); const int v = (int)F.MISC[2]; __syncthreads(); return v;
}
template <bool REMAP>
__device__ __forceinline__ void tr_item(const float* W, int K, int ldw, bf16_t* WT, int nblk, LAS float* scr, int item, int lane) {
    const int kb = item / nblk, nb = item - kb * nblk, k0 = 64 * kb, n0 = 32 * nb;
    const int q = lane & 7, r = lane >> 3;
    const int sc = REMAP ? srccol(n0 + 4 * q) : n0 + 4 * q;
    f32x4 v[8];
#pragma unroll
    for (int i = 0; i < 8; ++i) v[i] = sc >= 0 ? *(const f32x4*)(W + (size_t)(k0 + 8 * i + r) * ldw + sc) : (f32x4){0.f, 0.f, 0.f, 0.f};
#pragma unroll
    for (int i = 0; i < 8; ++i) { LAS float* d = scr + (8 * i + r) * 33 + 4 * q; d[0] = v[i][0]; d[1] = v[i][1]; d[2] = v[i][2]; d[3] = v[i][3]; }
    LDS_WAIT();
    const int c = lane & 7;
#pragma unroll
    for (int j = 0; j < 4; ++j) { const int nn = (lane >> 3) + 8 * j; const LAS float* s = scr + (8 * c) * 33 + nn;
        u32x4 o; o.x = cvtpk_c(s[0 * 33], s[1 * 33]); o.y = cvtpk_c(s[2 * 33], s[3 * 33]); o.z = cvtpk_c(s[4 * 33], s[5 * 33]); o.w = cvtpk_c(s[6 * 33], s[7 * 33]);
        *(u32x4*)(WT + (size_t)(n0 + nn) * K + k0 + 8 * c) = o; }
    LDS_WAIT();
}
__device__ __forceinline__ void p0_prologue(Frame& F, const float* x_in, const float* w_in, const float* w_out, const float* w_uv) {
    LAS float* scr = (LAS float*)(F.lds + F.wave * 16384);
    const int gw = F.vcu * NWAVES + F.wave, NGW = F.G * NWAVES;
    constexpr int I_IN = (DM / 64) * (NPAD / 32), I_OUT = (DM / 64) * (DM / 32), I_UV = (256 / 64) * (128 / 32);
    constexpr int N_IN = DEPTH * I_IN, N_OUT = DEPTH * I_OUT, N_UV = DEPTH * 8 * I_UV;
    for (int it = gw; it < N_IN + N_OUT + N_UV; it += NGW) {
        int r = it;
        if (r < N_IN) { const int l = r / I_IN; r -= l * I_IN;
            tr_item<true>(w_in + (size_t)l * DM * NIN, DM, NIN, B_WTIN(F) + (size_t)l * NPAD * DM, NPAD / 32, scr, r, hw_lane()); continue; }
        r -= N_IN;
        if (r < N_OUT) { const int l = r / I_OUT; r -= l * I_OUT;
            tr_item<false>(w_out + (size_t)l * DM * DM, DM, DM, B_WTOUT(F) + (size_t)l * DM * DM, DM / 32, scr, r, hw_lane()); continue; }
        r -= N_OUT;
        { const int lh = r / I_UV; r -= lh * I_UV;
          tr_item<false>(w_uv + (size_t)lh * 256 * 128, 256, 128, B_WUVT(F) + (size_t)lh * 128 * 256, 128 / 32, scr, r, hw_lane()); }
    }
    const f32x4* xs = (const f32x4*)x_in;
    for (size_t i = (size_t)gw * 64 + hw_lane(); i < (size_t)SEQ * DM / 8; i += (size_t)NGW * 64) {
        const f32x4 a = xs[2 * i], b = xs[2 * i + 1];
        u32x4 o = {cvtpk_c(a[0], a[1]), cvtpk_c(a[2], a[3]), cvtpk_c(b[0], b[1]), cvtpk_c(b[2], b[3])};
        *(u32x4*)(B_XB(F) + 8 * i) = o;
    }
}

__device__ __forceinline__ void prep_phase(Frame& F, int l, const float* w_gate2, const float* b_gate, const float* kv_g, const float* ik_g, const float* ik_b) {
    int lane_ = hw_lane(); asm volatile("" : "+v"(lane_));
    const int gw = F.vcu * NWAVES + F.wave, NGW = F.G * NWAVES, lane = lane_;
    const bf16_t* H = B_H(F);
    {
        const float* kvg = kv_g + l * 256; const float* ikg = ik_g + l * 64; const float* ikb = ik_b + l * 64;
        const f32x4 g4 = *(const f32x4*)(kvg + 4 * lane); const float g1 = ikg[lane], b1 = ikb[lane];
        for (int t0 = gw; t0 < SEQ; t0 += 2 * NGW) {
            float v[2][4], x[2], ss[2];
#pragma unroll
            for (int k = 0; k < 2; ++k) { const bf16_t* hr = H + (size_t)(t0 + k * NGW) * NPAD;
                const u32x2 raw = *(const u32x2*)(hr + C_CKV + 4 * lane);
                v[k][0] = bflo(raw.x); v[k][1] = bfhi(raw.x); v[k][2] = bflo(raw.y); v[k][3] = bfhi(raw.y);
                x[k] = bf2f(hr[C_CIK + lane]);
                ss[k] = (v[k][0] * v[k][0] + v[k][1] * v[k][1]) + (v[k][2] * v[k][2] + v[k][3] * v[k][3]); }
            float mu[2] = {x[0], x[1]};
            wave_sum2(ss[0], ss[1]); wave_sum2(mu[0], mu[1]);
            float dv[2], var[2];
#pragma unroll
            for (int k = 0; k < 2; ++k) { dv[k] = x[k] - mu[k] * (1.f / 64.f); var[k] = dv[k] * dv[k]; }
            wave_sum2(var[0], var[1]);
#pragma unroll
            for (int k = 0; k < 2; ++k) { const int t = t0 + k * NGW;
                const float rs = rsqrtf(ss[k] * (1.f / 256.f) + 1e-6f);
                u32x2 o; o.x = cvtpk_c(v[k][0] * rs * g4[0], v[k][1] * rs * g4[1]); o.y = cvtpk_c(v[k][2] * rs * g4[2], v[k][3] * rs * g4[3]);
                *(u32x2*)(B_CN(F) + (size_t)t * 256 + 4 * lane) = o;
                const float y = dv[k] * rsqrtf(var[k] * (1.f / 64.f) + 1e-5f) * g1 + b1;
                B_IKN(F)[(size_t)t * 64 + lane] = (bf16_t)(cvtpk_c(y, 0.f) & 0xffffu); }
        }
    }
    {
        LAS float* aas = (LAS float*)(F.lds + F.wave * 16384);
        const float* W2 = w_gate2 + (size_t)l * 16 * 1024; const float* BG = b_gate + (size_t)l * 1024;
        for (int u = gw; u < NCHUNK * 16; u += NGW) {
            const int c = u >> 4, dk = (u & 15) * 64 + lane;
            { const bf16_t* ap = H + (size_t)(64 * c + lane) * NPAD + C_AA;
              const bf16x8 a0 = *(const bf16x8*)ap, a1 = *(const bf16x8*)(ap + 8);
#pragma unroll
              for (int j = 0; j < 8; ++j) { aas[lane * 16 + j] = bf2f((unsigned short)a0[j]); aas[lane * 16 + 8 + j] = bf2f((unsigned short)a1[j]); } }
            float w2[16];
#pragma unroll
            for (int r = 0; r < 16; ++r) w2[r] = W2[r * 1024 + dk];
            const float bgv = BG[dk];
            unsigned short kq[64];
#pragma unroll
            for (int t = 0; t < 64; ++t) kq[t] = H[(size_t)(64 * c + t) * NPAD + C_AK + dk];
            LDS_WAIT();
            float la[64]; float total = 0.f;
#pragma unroll
            for (int t = 0; t < 64; ++t) {
                float z = bgv;
#pragma unroll
                for (int r = 0; r < 16; ++r) z += aas[t * 16 + r] * w2[r];
                la[t] = (fminf(z, 0.f) - __logf(1.f + __expf(-fabsf(z)))) * (1.f / 16.f);
                total += la[t];
            }
            B_DEC(F)[(size_t)c * 1024 + dk] = __expf(total);
            float run = 0.f;
#pragma unroll
            for (int t8 = 0; t8 < 8; ++t8) {
                float kd[8];
#pragma unroll
                for (int j = 0; j < 8; ++j) { const int t = 8 * t8 + j;
                    run += la[t];
                    kd[j] = bf2f(kq[t]) * __expf(total - run); }
                *(bf16x8*)(B_KDT(F) + ((size_t)c * 1024 + dk) * 64 + 8 * t8) = pack8f(kd[0], kd[1], kd[2], kd[3], kd[4], kd[5], kd[6], kd[7]);
            }
            LDS_WAIT();
        }
    }
    for (int u = gw; u < NCHUNK * 16; u += NGW) {
        const int c = u >> 4, dv = (u & 15) * 128 + 2 * lane;
        unsigned w[64];
#pragma unroll
        for (int t = 0; t < 64; ++t) w[t] = *(const unsigned*)(H + (size_t)(64 * c + t) * NPAD + C_AV + dv);
#pragma unroll
        for (int t8 = 0; t8 < 8; ++t8) {
            const unsigned* x = w + 8 * t8;
            u32x4 lo = {(x[0] & 0xffffu) | (x[1] << 16), (x[2] & 0xffffu) | (x[3] << 16), (x[4] & 0xffffu) | (x[5] << 16), (x[6] & 0xffffu) | (x[7] << 16)};
            u32x4 hi = {(x[0] >> 16) | (x[1] & 0xffff0000u), (x[2] >> 16) | (x[3] & 0xffff0000u), (x[4] >> 16) | (x[5] & 0xffff0000u), (x[6] >> 16) | (x[7] & 0xffff0000u)};
            *(u32x4*)(B_VT(F) + ((size_t)c * 2048 + dv) * 64 + 8 * t8) = lo;
            *(u32x4*)(B_VT(F) + ((size_t)c * 2048 + dv + 1) * 64 + 8 * t8) = hi;
        }
    }
}

__device__ __forceinline__ void post_phase(Frame& F, int l, float lam_init, const float* gla_g, const float* dlam, const float* diff_g) {
    int lane_ = hw_lane(); asm volatile("" : "+v"(lane_));
    const int gw = F.vcu * NWAVES + F.wave, NGW = F.G * NWAVES, lane = lane_;
    float lam;
    { const float* lp = dlam + (size_t)l * 512;
      const float p0 = lp[lane] * lp[128 + lane] + lp[64 + lane] * lp[192 + lane];
      const float p1 = lp[256 + lane] * lp[384 + lane] + lp[320 + lane] * lp[448 + lane];
      lam = expf(wave_sum(p0)) - expf(wave_sum(p1)) + lam_init; }
    { const float* g = gla_g + (size_t)l * 512;
      const f32x4 ga = *(const f32x4*)(g + 8 * lane), gb = *(const f32x4*)(g + 8 * lane + 4);
      for (int u0 = gw; u0 < SEQ * 4; u0 += 2 * NGW) {
          f32x4 a[2], b[2]; u32x4 gr[2]; float ss[2];
#pragma unroll
          for (int k = 0; k < 2; ++k) { const int u = u0 + k * NGW, t = u >> 2, hd = u & 3;
              const float* src = B_OA(F) + (size_t)t * 2048 + hd * 512 + 8 * lane;
              a[k] = *(const f32x4*)src; b[k] = *(const f32x4*)(src + 4);
              gr[k] = *(const u32x4*)(B_H(F) + (size_t)t * NPAD + C_AG + hd * 512 + 8 * lane);
              ss[k] = (a[k][0] * a[k][0] + a[k][1] * a[k][1]) + (a[k][2] * a[k][2] + a[k][3] * a[k][3]) + (b[k][0] * b[k][0] + b[k][1] * b[k][1]) + (b[k][2] * b[k][2] + b[k][3] * b[k][3]); }
          wave_sum2(ss[0], ss[1]);
#pragma unroll
          for (int k = 0; k < 2; ++k) { const int u = u0 + k * NGW, t = u >> 2, hd = u & 3;
              const float rs = rsqrtf(ss[k] * (1.f / 512.f) + 1e-6f);
              u32x4 o;
              o.x = cvtpk_c(a[k][0] * rs * ga[0] * silu(bflo(gr[k].x)), a[k][1] * rs * ga[1] * silu(bfhi(gr[k].x)));
              o.y = cvtpk_c(a[k][2] * rs * ga[2] * silu(bflo(gr[k].y)), a[k][3] * rs * ga[3] * silu(bfhi(gr[k].y)));
              o.z = cvtpk_c(b[k][0] * rs * gb[0] * silu(bflo(gr[k].z)), b[k][1] * rs * gb[1] * silu(bfhi(gr[k].z)));
              o.w = cvtpk_c(b[k][2] * rs * gb[2] * silu(bflo(gr[k].w)), b[k][3] * rs * gb[3] * silu(bfhi(gr[k].w)));
              *(u32x4*)(B_O(F) + (size_t)t * DM + hd * 512 + 8 * lane) = o; }
      } }
    { const float* g = diff_g + (size_t)l * 256;
      const f32x4 g4 = *(const f32x4*)(g + 4 * lane); const float post = 1.f - lam_init;
      for (int u0 = gw; u0 < SEQ * 4; u0 += 2 * NGW) {
          f32x4 d[2]; u32x2 gr[2]; float ss[2];
#pragma unroll
          for (int k = 0; k < 2; ++k) { const int u = u0 + k * NGW, t = u >> 2, hd = u & 3;
              const float* src = B_OD(F) + (size_t)t * 2048 + hd * 512 + 4 * lane;
              const f32x4 a0 = *(const f32x4*)src, a1 = *(const f32x4*)(src + 256);
              gr[k] = *(const u32x2*)(B_H(F) + (size_t)t * NPAD + C_BG + hd * 256 + 4 * lane);
              d[k] = a0 - a1 * lam;
              ss[k] = (d[k][0] * d[k][0] + d[k][1] * d[k][1]) + (d[k][2] * d[k][2] + d[k][3] * d[k][3]); }
          wave_sum2(ss[0], ss[1]);
#pragma unroll
          for (int k = 0; k < 2; ++k) { const int u = u0 + k * NGW, t = u >> 2, hd = u & 3;
              const float rs = rsqrtf(ss[k] * (1.f / 256.f) + 1e-6f) * post;
              u32x2 o;
              o.x = cvtpk_c(d[k][0] * rs * g4[0] * silu(bflo(gr[k].x)), d[k][1] * rs * g4[1] * silu(bfhi(gr[k].x)));
              o.y = cvtpk_c(d[k][2] * rs * g4[2] * silu(bflo(gr[k].y)), d[k][3] * rs * g4[3] * silu(bfhi(gr[k].y)));
              *(u32x2*)(B_O(F) + (size_t)t * DM + 2048 + hd * 256 + 4 * lane) = o; }
      } }
}

__device__ __forceinline__ void ln_phase(Frame& F, int l, const float* ln_g, const float* ln_b, float* outp, bool dry) {
    int lane_ = hw_lane(); asm volatile("" : "+v"(lane_));
    const int gw = F.vcu * NWAVES + F.wave, NGW = F.G * NWAVES, lane = lane_;
    const float* g = ln_g + (size_t)l * DM; const float* b = ln_b + (size_t)l * DM;
    float* dst = dry ? B_OA(F) : ((l == DEPTH - 1) ? outp : B_XF(F));
    for (int t = gw; t < SEQ; t += NGW) {
        const f32x4* xr = (const f32x4*)(B_XF(F) + (size_t)t * DM) + lane;
        f32x4 v[16]; float s = 0.f;
#pragma unroll
        for (int j = 0; j < 16; ++j) { v[j] = xr[64 * j]; s += (v[j][0] + v[j][1]) + (v[j][2] + v[j][3]); }
        const float mean = wave_sum(s) * (1.f / DM); float s2 = 0.f;
#pragma unroll
        for (int j = 0; j < 16; ++j) { v[j] = v[j] - mean; s2 += (v[j][0] * v[j][0] + v[j][1] * v[j][1]) + (v[j][2] * v[j][2] + v[j][3] * v[j][3]); }
        const float rstd = rsqrtf(wave_sum(s2) * (1.f / DM) + 1e-5f);
        f32x4* orow = (f32x4*)(dst + (size_t)t * DM) + lane;
        u32x2* brow = (u32x2*)(B_XB(F) + (size_t)t * DM) + lane;
#pragma unroll
        for (int j = 0; j < 16; ++j) {
            const f32x4 gg = *((const f32x4*)g + lane + 64 * j), bb = *((const f32x4*)b + lane + 64 * j);
            const f32x4 y = v[j] * rstd * gg + bb;
            orow[64 * j] = y;
            u32x2 w; w.x = cvtpk_c(y[0], y[1]); w.y = cvtpk_c(y[2], y[3]); brow[64 * j] = w;
        }
    }
}
namespace gla {
constexpr int KD_ROW = 144, Q_ROW = 528, V_ROW = 144;
constexpr int L_KD = 0, L_Q = L_KD + 256 * KD_ROW, L_V = L_Q + 64 * Q_ROW, L_DEC = L_V + 128 * V_ROW, L_END = L_DEC + 1024;
}
static_assert(gla::L_END <= MISC_OFF, "GLA LDS map");
__device__ __forceinline__ void gla_unit(Frame& F, int unit) {
    using namespace gla;
    int tid_ = (F.wave * 64 + hw_lane()); asm volatile("" : "+v"(tid_));
    const int tid = tid_, lane = tid & 63, c16 = lane & 15, g = lane >> 4, wave = F.wave;
    const int head = unit >> 2, blk = unit & 3;
    const int dv0 = 128 * blk + 16 * wave;
    LAS unsigned char* lds = F.lds;
    f32x4 S[16];
#pragma unroll
    for (int T = 0; T < 16; ++T) S[T] = (f32x4){0.f, 0.f, 0.f, 0.f};
    const bf16_t* kd_g = B_KDT(F) + (size_t)head * 256 * 64 + (size_t)tid * 8;
    const bf16_t* q_g = B_H(F) + (size_t)(tid >> 5) * NPAD + C_AQ + head * 256 + (tid & 31) * 8;
    const bf16_t* v_g = B_VT(F) + ((size_t)head * 512 + 128 * blk) * 64 + (size_t)tid * 8;
    const float* d_g = B_DEC(F) + head * 256 + (tid & 63) * 4;
    const int kd_w = (tid >> 3) * KD_ROW + (tid & 7) * 16;
    const int q_w = (tid >> 5) * Q_ROW + (tid & 31) * 16;
    const int v_w = (tid >> 3) * V_ROW + (tid & 7) * 16;
    u32x4 skd[4], sq[4], sv[2]; f32x4 sd;
#define GLA_LOAD(c_) do { _Pragma("unroll") for (int i = 0; i < 4; ++i) skd[i] = *(const u32x4*)(kd_g + (size_t)(c_) * 1024 * 64 + i * 4096); \
        _Pragma("unroll") for (int i = 0; i < 4; ++i) sq[i] = *(const u32x4*)(q_g + (size_t)(64 * (c_) + 16 * i) * NPAD);                        \
        _Pragma("unroll") for (int i = 0; i < 2; ++i) sv[i] = *(const u32x4*)(v_g + (size_t)(c_) * 2048 * 64 + i * 4096);                        \
        if (tid < 64) sd = *(const f32x4*)(d_g + (size_t)(c_) * 1024); } while (0)
#define GLA_WRITE() do { _Pragma("unroll") for (int i = 0; i < 4; ++i) *(LAS u32x4*)(lds + L_KD + kd_w + i * 64 * KD_ROW) = skd[i];            \
        _Pragma("unroll") for (int i = 0; i < 4; ++i) *(LAS u32x4*)(lds + L_Q + q_w + i * 16 * Q_ROW) = sq[i];                                   \
        _Pragma("unroll") for (int i = 0; i < 2; ++i) *(LAS u32x4*)(lds + L_V + v_w + i * 64 * V_ROW) = sv[i];                                   \
        if (tid < 64) *(LAS f32x4*)(lds + L_DEC + tid * 16) = sd; } while (0)
    const int a_rd = L_KD + c16 * KD_ROW + 16 * g;
    const int b_rd = L_V + (16 * wave + c16) * V_ROW + 16 * g;
    const int q_rd = L_Q + c16 * Q_ROW + 8 * g;
    const int d_rd = L_DEC + 16 * g;
    float* o_l = B_OA(F) + (size_t)(4 * g) * 2048 + head * 512 + dv0 + c16;
    GLA_LOAD(0);
    __syncthreads();
    GLA_WRITE();
    for (int c = 0; c < NCHUNK; ++c) {
        __syncthreads();
        if (c + 1 < NCHUNK) GLA_LOAD(c + 1);
        const bf16x8 vb0 = *(const LAS bf16x8*)(lds + b_rd), vb1 = *(const LAS bf16x8*)(lds + b_rd + 64);
#pragma unroll
        for (int T4 = 0; T4 < 4; ++T4) {
            bf16x8 a[4][2]; f32x4 d4[4];
#pragma unroll
            for (int i = 0; i < 4; ++i) { const int T = 4 * T4 + i;
                a[i][0] = *(const LAS bf16x8*)(lds + a_rd + T * 16 * KD_ROW); a[i][1] = *(const LAS bf16x8*)(lds + a_rd + T * 16 * KD_ROW + 64);
                d4[i] = *(const LAS f32x4*)(lds + d_rd + 64 * T); }
#pragma unroll
            for (int i = 0; i < 4; ++i) { const int T = 4 * T4 + i;
                f32x4 acc = (f32x4){0.f, 0.f, 0.f, 0.f};
                acc = MFMA16(a[i][0], vb0, acc); acc = MFMA16(a[i][1], vb1, acc);
                S[T] = S[T] * d4[i] + acc; }
        }
        bf16x8 sb[8];
#pragma unroll
        for (int s = 0; s < 8; ++s) sb[s] = pack8f(S[2 * s][0], S[2 * s][1], S[2 * s][2], S[2 * s][3], S[2 * s + 1][0], S[2 * s + 1][1], S[2 * s + 1][2], S[2 * s + 1][3]);
#pragma unroll
        for (int tt = 0; tt < 4; ++tt) {
            u32x2 ql[8], qh[8];
#pragma unroll
            for (int s = 0; s < 8; ++s) { ql[s] = *(const LAS u32x2*)(lds + q_rd + tt * 16 * Q_ROW + 64 * s); qh[s] = *(const LAS u32x2*)(lds + q_rd + tt * 16 * Q_ROW + 64 * s + 32); }
            f32x4 acc = (f32x4){0.f, 0.f, 0.f, 0.f};
#pragma unroll
            for (int s = 0; s < 8; ++s) { const u32x4 aw = {ql[s].x, ql[s].y, qh[s].x, qh[s].y}; acc = MFMA16(__builtin_bit_cast(bf16x8, aw), sb[s], acc); }
            float* op = o_l + (size_t)(64 * c + 16 * tt) * 2048;
#pragma unroll
            for (int r = 0; r < 4; ++r) op[(size_t)r * 2048] = acc[r] * 0.0625f;
        }
        __syncthreads();
        if (c + 1 < NCHUNK) GLA_WRITE();
    }
#undef GLA_LOAD
#undef GLA_WRITE
}
__device__ __forceinline__ unsigned f2key(float s) { const unsigned b = __float_as_uint(s); return b ^ ((b >> 31) ? 0xFFFFFFFFu : 0x80000000u); }
__device__ __forceinline__ unsigned half_of(unsigned long long b, int hh) { return hh ? (unsigned)(b >> 32) : (unsigned)b; }
template <int EPL, int NB>
__device__ __forceinline__ void compactK(LAS unsigned* cv, int& cnt, unsigned& thr, int lane32, int hh) {
    unsigned k[EPL];
#pragma unroll
    for (int i = 0; i < EPL; ++i) { const int e = lane32 + 32 * i; const unsigned v = cv[e]; k[i] = (e < cnt) ? v : 0u; }
    unsigned T = 0u;
    for (int b = 31; b >= 32 - NB; --b) {
        const unsigned cand = T | (1u << b); int clo = 0, chi = 0;
#pragma unroll
        for (int i = 0; i < EPL; ++i) { const unsigned long long m = __ballot(k[i] >= cand); clo += __popc((unsigned)m); chi += __popc((unsigned)(m >> 32)); }
        if ((hh ? chi : clo) >= 256) T = cand;
        if (NB == 32 && clo == 256 && chi == 256) break;
    }
    const unsigned ltm = (1u << lane32) - 1u;
    int kept = 0;
#pragma unroll
    for (int i = 0; i < EPL; ++i) {
        const bool keep = (k[i] >= T) && (k[i] != 0u);
        const unsigned mk = half_of(__ballot(keep), hh);
        const int pos = kept + __popc(mk & ltm);
        if (keep) cv[pos] = k[i];
        kept += __popc(mk);
    }
    cnt = kept; thr = (NB == 32) ? T : (T ? T - 1u : 0u);
}
__device__ __forceinline__ int goff(int row, int ch) { return 512 * row + 16 * ((ch & 16) | ((ch & 15) ^ (((row & 3) << 2) | (((row >> 2) & 1) << 1)))); }

#ifndef SP_REPF
#define SP_REPF 1
#endif
#ifndef SP_REPB
#define SP_REPB 1
#endif
#ifndef SP_REPK
#define SP_REPK 1
#endif
#ifndef SP_REPX
#define SP_REPX 1
#endif
constexpr int SP_CAND = 0, SP_OL = 65536, SP_SEL = 131072, SP_END = SP_SEL + 8192;
static_assert(SP_END <= MISC_OFF, "sparse LDS map");
__device__ __forceinline__ void sparse_unit(Frame& F, int l, int unit) {
    int tid_ = (F.wave * 64 + hw_lane()); asm volatile("" : "+v"(tid_));
    const int tid = tid_, lane = tid & 63, wave = F.wave, r32 = lane & 31, hh = lane >> 5, c16 = lane & 15, g = lane >> 4;
    const int t0 = 16 * unit, tq0 = t0 + 2 * wave;
    const int N = 64 * ((t0 >> 6) + 1), nkb = N >> 5, ntile = (nkb + 7) >> 3;
    LAS unsigned char* reg = F.lds + SP_CAND + wave * 8192;
    LAS unsigned* cv = (LAS unsigned*)(reg + hh * 4096);
    LAS unsigned short* sel = (LAS unsigned short*)(F.lds + SP_SEL + wave * 1024);
    const bf16_t* H = B_H(F);
    int cnt = 0;
    {
        const int qq = (r32 >> 2) & 1, hd = (r32 & 3) + 4 * (r32 >> 3);
        bf16x8 A[4];
#pragma unroll
        for (int s = 0; s < 4; ++s) A[s] = *(const bf16x8*)(H + (size_t)(tq0 + qq) * NPAD + C_CIQ + hd * 64 + 16 * s + 8 * hh);
        float wv[16];
        { const bf16_t* wp = H + (size_t)(tq0 + hh) * NPAD + C_CIW;
          const bf16x8 w0 = *(const bf16x8*)wp, w1 = *(const bf16x8*)(wp + 8);
#pragma unroll
          for (int j = 0; j < 8; ++j) { wv[j] = bf2f((unsigned short)w0[j]) * 0.03125f; wv[8 + j] = bf2f((unsigned short)w1[j]) * 0.03125f; } }
        unsigned thr = 0u;
        const unsigned ltm = (1u << r32) - 1u;
        const bf16_t* kg = B_IKN(F) + (size_t)tid * 8;
        const int kw = SP_OL + (tid >> 3) * 128 + (((tid & 7) ^ ((tid >> 4) & 7)) * 16);
        int brd[4];
#pragma unroll
        for (int s = 0; s < 4; ++s) brd[s] = SP_OL + r32 * 128 + (((2 * s + hh) ^ ((r32 >> 1) & 7)) * 16);
        u32x4 stgA[4], stgB[4];
#define SP_KLOAD(st_, t_) do { _Pragma("unroll") for (int i = 0; i < 4; ++i) st_[i] = *(const u32x4*)(kg + (size_t)(t_) * 256 * 64 + i * 4096); } while (0)
#define SP_KWRITE(st_, b_) do { _Pragma("unroll") for (int i = 0; i < 4; ++i) *(LAS u32x4*)(F.lds + (b_) * 32768 + kw + i * 8192) = st_[i]; } while (0)
#define SP_TILE(tile_, b_) do {                                                                                                                  \
            { const bool full_ = __any(cnt > 640); if (lane == 0) F.MISC[16 + (b_) * 8 + wave] = full_ ? 1u : 0u; }                              \
            for (int rb_ = 0; rb_ < SP_REPB; ++rb_) __syncthreads();                                                                             \
            bool squeeze_ = __any(F.MISC[16 + (b_) * 8 + (lane & 7)] != 0u);                                                                     \
            const int nb_ = (nkb - 8 * (tile_)) < 8 ? (nkb - 8 * (tile_)) : 8;                                                                   \
            LAS unsigned char* tb_ = F.lds + (b_) * 32768;                                                                                       \
            for (int kb = 0; kb < nb_; kb += 2) {                                                                                                \
                if (squeeze_ || __any(cnt > 960)) { squeeze_ = false;                                                                            \
                    for (int rc_ = 0; rc_ < SP_REPK; ++rc_) compactK<32, 14>(cv, cnt, thr, r32, hh);                                             \
                    if (__any(cnt > 800)) compactK<32, 32>(cv, cnt, thr, r32, hh); }                                                             \
                float sc0 = 0.f, sc1 = 0.f;                                                                                                      \
                for (int rx_ = 0; rx_ < SP_REPX; ++rx_) {                                                                                        \
                bf16x8 B0[4], B1[4];                                                                                                             \
                _Pragma("unroll") for (int s = 0; s < 4; ++s) { B0[s] = *(const LAS bf16x8*)(tb_ + brd[s] + kb * 4096); B1[s] = *(const LAS bf16x8*)(tb_ + brd[s] + kb * 4096 + 4096); } \
                asm volatile("" : "+v"(B0[0]), "+v"(B0[1]), "+v"(B0[2]), "+v"(B0[3]), "+v"(B1[0]), "+v"(B1[1]), "+v"(B1[2]), "+v"(B1[3]));      \
                f32x16 acc0 = {}, acc1 = {};                                                                                                     \
                _Pragma("unroll") for (int s = 0; s < 4; ++s) { acc0 = MFMA32(A[s], B0[s], acc0); acc1 = MFMA32(A[s], B1[s], acc1); }            \
                { f32x2 s0_ = {0.f, 0.f}, s1_ = {0.f, 0.f};                                                                                      \
                _Pragma("unroll") for (int j = 0; j < 16; j += 2) { const int a0 = __float_as_int(acc0[j]), a1 = __float_as_int(acc0[j + 1]), b0 = __float_as_int(acc1[j]), b1 = __float_as_int(acc1[j + 1]); \
                    const f32x2 r0_ = {__int_as_float(a0 > 0 ? a0 : 0), __int_as_float(a1 > 0 ? a1 : 0)}, r1_ = {__int_as_float(b0 > 0 ? b0 : 0), __int_as_float(b1 > 0 ? b1 : 0)}; \
                    const f32x2 w_ = {wv[j], wv[j + 1]};                                                                                         \
                    s0_ = __builtin_elementwise_fma(r0_, w_, s0_); s1_ = __builtin_elementwise_fma(r1_, w_, s1_); }                               \
                sc0 = s0_[0] + s0_[1]; sc1 = s1_[0] + s1_[1]; }                                                                                  \
                asm volatile("" : "+v"(sc0), "+v"(sc1)); }                                                                                       \
                const unsigned ib_ = 16383u - (unsigned)(256 * (tile_) + 32 * kb + r32);                                                         \
                const unsigned key0 = (f2key(sc0) & 0xFFFFC000u) | ib_, key1 = (f2key(sc1) & 0xFFFFC000u) | (ib_ - 32u);                         \
                const bool f0 = key0 > thr, f1 = key1 > thr;                                                                                     \
                const unsigned m0 = half_of(__ballot(f0), hh), m1 = half_of(__ballot(f1), hh);                                                   \
                const int pos0 = cnt + __popc(m0 & ltm), pos1 = cnt + __popc(m0) + __popc(m1 & ltm);                                             \
                if (f0) cv[pos0] = key0;                                                                                                         \
                if (f1) cv[pos1] = key1;                                                                                                         \
                cnt += __popc(m0) + __popc(m1);                                                                                                  \
            } } while (0)
        SP_KLOAD(stgA, 0);
        SP_KWRITE(stgA, 0);
        __builtin_amdgcn_s_waitcnt(0x0F70);
        if (ntile > 1) SP_KLOAD(stgB, 1);
        for (int tile = 0; tile < ntile; tile += 2) {
            if (tile + 2 < ntile) SP_KLOAD(stgA, tile + 2);
            SP_TILE(tile, 0);
            if (tile + 1 >= ntile) break;
            SP_KWRITE(stgB, 1);
            if (tile + 3 < ntile) SP_KLOAD(stgB, tile + 3);
            SP_TILE(tile + 1, 1);
            if (tile + 2 < ntile) SP_KWRITE(stgA, 0);
        }
#undef SP_TILE
#undef SP_KLOAD
#undef SP_KWRITE
        if (__any(cnt > 256)) {
            compactK<32, 14>(cv, cnt, thr, r32, hh);
            if (__any(cnt > 512)) compactK<32, 32>(cv, cnt, thr, r32, hh); else compactK<16, 32>(cv, cnt, thr, r32, hh);
        }
#pragma unroll
        for (int i = 0; i < 8; ++i) { const int e = r32 + 32 * i; if (e < cnt) sel[hh * 256 + e] = (unsigned short)(16383u - (cv[e] & 0x3FFFu)); }
    }
    LDS_WAIT();
    __syncthreads();
    const int ns0 = __builtin_amdgcn_readlane(cnt, 0), ns1 = __builtin_amdgcn_readlane(cnt, 32);
    const int q4 = c16 >> 2, p4 = c16 & 3;
    const int trx = (q4 << 2) | ((g & 1) << 1);
    const unsigned gb = (unsigned)(uintptr_t)reg;
    unsigned tra[8];
#pragma unroll
    for (int c = 0; c < 8; ++c) tra[c] = gb + 512 * (4 * g + q4) + 8 * (p4 & 1) + 16 * ((2 * c + (p4 >> 1)) ^ trx);
    LAS unsigned short* ol = (LAS unsigned short*)(F.lds + SP_OL + wave * 8192);
#pragma unroll 1
    for (int qi = 0; qi < 2; ++qi) {
        const int tq = tq0 + qi, ns = qi ? ns1 : ns0;
        bf16x8 qf[8];
#pragma unroll
        for (int s = 0; s < 8; ++s) { bf16x8 z = {}; qf[s] = (c16 < 8) ? *(const bf16x8*)(H + (size_t)tq * NPAD + C_CQ + c16 * 256 + 32 * s + 8 * g) : z; }
        f32x4 Z[16];
#pragma unroll
        for (int c = 0; c < 16; ++c) Z[c] = (f32x4){0.f, 0.f, 0.f, 0.f};
        float m = -1e30f, ls = 0.f;
        const int nsb = (ns + 15) >> 4;
        u32x4 datA[8], datB[8];
#define SP_GATHER(d_, j_) do { const int e_ = 16 * (j_) + c16; const int idx_ = (e_ < ns) ? (int)sel[qi * 256 + e_] : 0;                        \
            const bf16_t* rp_ = B_CN(F) + (size_t)idx_ * 256 + 8 * g;                                                                            \
            _Pragma("unroll") for (int i = 0; i < 8; ++i) d_[i] = *(const u32x4*)(rp_ + 32 * i); } while (0)
#define SP_GWRITE(d_) do { _Pragma("unroll") for (int i = 0; i < 8; ++i) *(LAS u32x4*)(reg + goff(c16, 4 * i + g)) = d_[i]; } while (0)
#define TRRD(dst, a, off) asm volatile("ds_read_b64_tr_b16 %0, %1 offset:%2" : "=&v"(dst) : "v"(a), "i"(off) : "memory")
#define SP_QK(d_) do { st = (f32x4){0.f, 0.f, 0.f, 0.f};                                                                                         \
            _Pragma("unroll") for (int s = 0; s < 8; ++s) st = MFMA16(__builtin_bit_cast(bf16x8, d_[s]), qf[s], st); } while (0)
#define SP_STEP(j_) do {                                                                                                                         \
            float mloc = -__builtin_inff();                                                                                                      \
            _Pragma("unroll") for (int r = 0; r < 4; ++r) { const int e = 16 * (j_) + 4 * g + r; const float v = (e < ns) ? st[r] * 0.0625f : -__builtin_inff(); st[r] = v; mloc = fmaxf(mloc, v); } \
            mloc = xmax16(mloc); mloc = xmax32(mloc);                                                                                                      \
            const float mn = fmaxf(m, mloc), alpha = __expf(m - mn);                                                                             \
            float ps = 0.f;                                                                                                                      \
            _Pragma("unroll") for (int r = 0; r < 4; ++r) { const float p = __expf(st[r] - mn); st[r] = p; ps += p; }                            \
            ps = xsum16(ps); ps = xsum32(ps);                                                                                                            \
            ls = ls * alpha + ps; m = mn;                                                                                                        \
            const bf16x8 pa = pack8f(st[0], st[1], st[2], st[3], 0.f, 0.f, 0.f, 0.f);                                                            \
            if (__any(alpha < 1.f)) {                                                                                                            \
                float ar[4];                                                                                                                     \
                _Pragma("unroll") for (int r = 0; r < 4; ++r) ar[r] = bperm_f(4 * g + r, alpha);                                                  \
                _Pragma("unroll") for (int c = 0; c < 16; ++c) _Pragma("unroll") for (int r = 0; r < 4; ++r) Z[c][r] *= ar[r];                   \
            }                                                                                                                                    \
            _Pragma("unroll") for (int c = 0; c < 8; c += 2) {                                                                                   \
                s16x4 l0, l1, l2, l3;                                                                                                            \
                TRRD(l0, tra[c], 0); TRRD(l1, tra[c], 256); TRRD(l2, tra[c + 1], 0); TRRD(l3, tra[c + 1], 256);                                  \
                asm volatile("s_waitcnt lgkmcnt(0)" ::: "memory"); __builtin_amdgcn_sched_barrier(0);                                            \
                Z[c] = MFMA16(pa, ((bf16x8){l0[0], l0[1], l0[2], l0[3], 0, 0, 0, 0}), Z[c]);                                                     \
                Z[c + 8] = MFMA16(pa, ((bf16x8){l1[0], l1[1], l1[2], l1[3], 0, 0, 0, 0}), Z[c + 8]);                                             \
                Z[c + 1] = MFMA16(pa, ((bf16x8){l2[0], l2[1], l2[2], l2[3], 0, 0, 0, 0}), Z[c + 1]);                                             \
                Z[c + 9] = MFMA16(pa, ((bf16x8){l3[0], l3[1], l3[2], l3[3], 0, 0, 0, 0}), Z[c + 9]);                                             \
            } } while (0)
        f32x4 st;
        SP_GATHER(datA, 0);
        if (nsb > 1) SP_GATHER(datB, 1);
        for (int j = 0; j < nsb; j += 2) {
            SP_QK(datA); SP_GWRITE(datA);
            if (j + 2 < nsb) SP_GATHER(datA, j + 2);
            SP_STEP(j);
            if (j + 1 >= nsb) break;
            SP_QK(datB); SP_GWRITE(datB);
            if (j + 3 < nsb) SP_GATHER(datB, j + 3);
            SP_STEP(j + 1);
        }
#undef SP_QK
#undef SP_STEP
#undef TRRD
#undef SP_GATHER
#undef SP_GWRITE
        float inv[4];
#pragma unroll
        for (int r = 0; r < 4; ++r) inv[r] = 1.f / bperm_f(4 * g + r, ls);
        if (g < 2) {
#pragma unroll
            for (int c = 0; c < 16; ++c) {
                const int lat = 16 * c + c16;
#pragma unroll
                for (int r = 0; r < 4; ++r) ol[(qi * 8 + 4 * g + r) * 256 + lat] = (unsigned short)(cvtpk_c(Z[c][r] * inv[r], 0.f) & 0xffffu);
            }
        }
    }
    unsigned short gtv[8][4];
#pragma unroll
    for (int n = 0; n < 8; ++n)
#pragma unroll
        for (int r = 0; r < 4; ++r) gtv[n][r] = H[(size_t)(t0 + 4 * g + r) * NPAD + C_CG + wave * 128 + 16 * n + c16];
    LDS_WAIT();
    __syncthreads();
    {
        const int hd = wave;
        bf16x8 A[8];
#pragma unroll
        for (int s = 0; s < 8; ++s) A[s] = *(const LAS bf16x8*)(F.lds + SP_OL + (c16 >> 1) * 8192 + (((c16 & 1) * 8 + hd) * 256 + 32 * s + 8 * g) * 2);
        const bf16_t* wb = B_WUVT(F) + ((size_t)(l * 8 + hd) * 128 + c16) * 256 + 8 * g;
#pragma unroll 1
        for (int n4 = 0; n4 < 2; ++n4) {
            bf16x8 b[4][8];
#pragma unroll
            for (int n = 0; n < 4; ++n)
#pragma unroll
                for (int s = 0; s < 8; ++s) b[n][s] = *(const bf16x8*)(wb + (size_t)(4 * n4 + n) * 16 * 256 + 32 * s);
#pragma unroll
            for (int n = 0; n < 4; ++n) {
                f32x4 acc = (f32x4){0.f, 0.f, 0.f, 0.f};
#pragma unroll
                for (int s = 0; s < 8; ++s) acc = MFMA16(A[s], b[n][s], acc);
#pragma unroll
                for (int r = 0; r < 4; ++r) { const int t = t0 + 4 * g + r; const int col = hd * 128 + 16 * (4 * n4 + n) + c16;
                    const float gt = bf2f(n4 ? gtv[4 + n][r] : gtv[n][r]);
                    B_O(F)[(size_t)t * DM + 3072 + col] = (bf16_t)(cvtpk_c(acc[r] * silu(gt), 0.f) & 0xffffu); }
            }
        }
    }
}
namespace da2 {
constexpr int VB = 32768, KB0 = 98304, KBS = 16384;
constexpr float C2 = 0.08838834764831845f * 1.4426950408889634f;
static_assert(KB0 + 3 * KBS <= MISC_OFF, "da2 LDS map");
__device__ __forceinline__ void block(Frame& F, int id) {
    int tid_ = F.wave * 64 + hw_lane(); asm volatile("" : "+v"(tid_));
    const int tid = tid_, lane = tid & 63, c16 = lane & 15, g = lane >> 4, wave = F.wave;
    const int qb = 127 - (id >> 3), hm = id & 7, hd = hm >> 1, mp = hm & 1;
    const int P0 = 128 * qb, NT = 2 * qb + 2;
    const int cw = (P0 + 16 * wave) >> 6;
    const bf16_t* H = B_H(F);
    LAS unsigned char* lds = F.lds;
    bf16x8 qf[4];
#pragma unroll
    for (int s = 0; s < 4; ++s) qf[s] = *(const bf16x8*)(H + (size_t)(P0 + 16 * wave + c16) * NPAD + C_BQ + hd * 256 + mp * 128 + 32 * s + 8 * g);
    const bf16_t* Kb = H + C_BK + hd * 256 + mp * 128;
    const bf16_t* Vb = H + C_BV + hd * 256;
    int kofs[2], vofs[4];
#pragma unroll
    for (int i = 0; i < 2; ++i) { const int row = 8 * wave + 4 * i + (lane >> 4); kofs[i] = row * NPAD + 8 * ((lane & 15) ^ (row & 15)); }
#pragma unroll
    for (int i = 0; i < 4; ++i) { const int row = 8 * wave + 2 * i + (lane >> 5), sl = lane & 31; vofs[i] = row * NPAD + 8 * ((sl & 16) | ((sl & 15) ^ (((row & 3) << 2) | (((row >> 2) & 1) << 1)))); }
    int ksw[4];
#pragma unroll
    for (int s = 0; s < 4; ++s) ksw[s] = KB0 + c16 * 256 + (((4 * s + g) ^ c16) * 16);
    const int q4 = c16 >> 2, p4 = c16 & 3, trx = (q4 << 2) | ((g & 1) << 1);
    const unsigned lb = (unsigned)(uintptr_t)lds;
    unsigned tra[8];
#pragma unroll
    for (int c = 0; c < 8; ++c) { tra[c] = lb + 512 * (4 * g + q4) + 8 * (p4 & 1) + 16 * ((2 * c + (p4 >> 1)) ^ trx); }
    f32x4 O[16];
#pragma unroll
    for (int c = 0; c < 16; ++c) O[c] = (f32x4){0.f, 0.f, 0.f, 0.f};
    float m = -1e30f, l = 0.f;
    f32x4 st[4], sn[4];
#define DA_DMAK(t_, slot_) do { const int tt_ = (t_) < NT ? (t_) : NT - 1; _Pragma("unroll") for (int i = 0; i < 2; ++i)                                \
        __builtin_amdgcn_global_load_lds((const unsigned*)(Kb + (size_t)(64 * tt_) * NPAD + kofs[i]), (LAS unsigned*)(lds + KB0 + (slot_) * KBS + (2 * wave + i) * 1024), 16, 0, 0); } while (0)
#define DA_DMAV(t_, buf_) do { const int tt_ = (t_) < NT ? (t_) : NT - 1; _Pragma("unroll") for (int i = 0; i < 4; ++i)                                 \
        __builtin_amdgcn_global_load_lds((const unsigned*)(Vb + (size_t)(64 * tt_) * NPAD + vofs[i]), (LAS unsigned*)(lds + (buf_) * VB + (4 * wave + i) * 1024), 16, 0, 0); } while (0)
#define DA_TR(dst, a, off) asm volatile("ds_read_b64_tr_b16 %0, %1 offset:%2" : "=&v"(dst) : "v"(a), "i"(off) : "memory")
#define DA_TR8(A_, c_, o_, L0, H0, L1, H1, L2, H2, L3, H3) do { const unsigned ta_ = tra[c_] + (A_);                                             \
        DA_TR(L0, ta_, (o_) + 0); DA_TR(H0, ta_, (o_) + 8192); DA_TR(L1, ta_, (o_) + 256); DA_TR(H1, ta_, (o_) + 8448);                           \
        DA_TR(L2, ta_, (o_) + 16384); DA_TR(H2, ta_, (o_) + 24576); DA_TR(L3, ta_, (o_) + 16640); DA_TR(H3, ta_, (o_) + 24832); } while (0)
#define DA_MM4(c_, L0, H0, L1, H1, L2, H2, L3, H3) do {                                                                                          \
        O[c_] = MFMA16(pa0, ((bf16x8){L0[0], L0[1], L0[2], L0[3], H0[0], H0[1], H0[2], H0[3]}), O[c_]);                                          \
        O[c_ + 8] = MFMA16(pa0, ((bf16x8){L1[0], L1[1], L1[2], L1[3], H1[0], H1[1], H1[2], H1[3]}), O[c_ + 8]);                                  \
        O[c_] = MFMA16(pa1, ((bf16x8){L2[0], L2[1], L2[2], L2[3], H2[0], H2[1], H2[2], H2[3]}), O[c_]);                                          \
        O[c_ + 8] = MFMA16(pa1, ((bf16x8){L3[0], L3[1], L3[2], L3[3], H3[0], H3[1], H3[2], H3[3]}), O[c_ + 8]); } while (0)
#define DA_WAITL(n_) do { asm volatile("s_waitcnt lgkmcnt(" #n_ ")" ::: "memory"); __builtin_amdgcn_sched_barrier(0); } while (0)
#define DA_QK(dst_, koff_) do { bf16x8 a_[4][4];                            \
        _Pragma("unroll") for (int T = 0; T < 4; ++T) _Pragma("unroll") for (int s = 0; s < 4; ++s) a_[T][s] = *(const LAS bf16x8*)(lds + (koff_) + ksw[s] + T * 4096); \
        asm volatile("" : "+v"(a_[0][0]), "+v"(a_[0][1]), "+v"(a_[0][2]), "+v"(a_[0][3]), "+v"(a_[1][0]), "+v"(a_[1][1]), "+v"(a_[1][2]), "+v"(a_[1][3]), \
                          "+v"(a_[2][0]), "+v"(a_[2][1]), "+v"(a_[2][2]), "+v"(a_[2][3]), "+v"(a_[3][0]), "+v"(a_[3][1]), "+v"(a_[3][2]), "+v"(a_[3][3])); \
        _Pragma("unroll") for (int T = 0; T < 4; ++T) dst_[T] = (f32x4){0.f, 0.f, 0.f, 0.f};                                                     \
        _Pragma("unroll") for (int s = 0; s < 4; ++s) _Pragma("unroll") for (int T = 0; T < 4; ++T) dst_[T] = MFMA16(a_[T][s], qf[s], dst_[T]); } while (0)
#define DA_SM() \
        float mloc = st[0][0];                                                                                                                   \
        _Pragma("unroll") for (int T = 0; T < 4; ++T) _Pragma("unroll") for (int r = 0; r < 4; ++r) mloc = fmaxf(mloc, st[T][r]);                \
        mloc = xmax16(mloc); mloc = xmax32(mloc);                                              \
        const float mn = fmaxf(m, mloc), alpha = __builtin_amdgcn_exp2f((m - mn) * C2), mnL = -mn * C2;                                         \
        float ps = 0.f;                                                                                                                          \
        _Pragma("unroll") for (int T = 0; T < 4; ++T) _Pragma("unroll") for (int r = 0; r < 4; ++r) { const float p = __builtin_amdgcn_exp2f(fmaf(st[T][r], C2, mnL)); st[T][r] = p; ps += p; } \
        ps = xsum16(ps); ps = xsum32(ps);                                                                              \
        l = l * alpha + ps; m = mn;                                                                                                              \
        const bf16x8 pa0 = pack8f(st[0][0], st[0][1], st[0][2], st[0][3], st[1][0], st[1][1], st[1][2], st[1][3]);                               \
        const bf16x8 pa1 = pack8f(st[2][0], st[2][1], st[2][2], st[2][3], st[3][0], st[3][1], st[3][2], st[3][3]);
#define DA_RESC() do { if (__any(alpha < 1.f)) { float ar[4];                                                                                    \
            _Pragma("unroll") for (int r = 0; r < 4; ++r) ar[r] = bperm_f(4 * g + r, alpha);                                                     \
            _Pragma("unroll") for (int c = 0; c < 16; ++c) _Pragma("unroll") for (int r = 0; r < 4; ++r) O[c][r] *= ar[r]; } } while (0)
#define DA_PV(A_, o_) do { s16x4 xl0, xh0, xl1, xh1, xl2, xh2, xl3, xh3, yl0, yh0, yl1, yh1, yl2, yh2, yl3, yh3;                                 \
          LDS_WAIT();                                                                                                                            \
          DA_TR8(A_, 0, o_, xl0, xh0, xl1, xh1, xl2, xh2, xl3, xh3);                                                                             \
          DA_TR8(A_, 1, o_, yl0, yh0, yl1, yh1, yl2, yh2, yl3, yh3); DA_WAITL(8); DA_MM4(0, xl0, xh0, xl1, xh1, xl2, xh2, xl3, xh3);             \
          DA_TR8(A_, 2, o_, xl0, xh0, xl1, xh1, xl2, xh2, xl3, xh3); DA_WAITL(8); DA_MM4(1, yl0, yh0, yl1, yh1, yl2, yh2, yl3, yh3);             \
          DA_TR8(A_, 3, o_, yl0, yh0, yl1, yh1, yl2, yh2, yl3, yh3); DA_WAITL(8); DA_MM4(2, xl0, xh0, xl1, xh1, xl2, xh2, xl3, xh3);             \
          DA_TR8(A_, 4, o_, xl0, xh0, xl1, xh1, xl2, xh2, xl3, xh3); DA_WAITL(8); DA_MM4(3, yl0, yh0, yl1, yh1, yl2, yh2, yl3, yh3);             \
          DA_TR8(A_, 5, o_, yl0, yh0, yl1, yh1, yl2, yh2, yl3, yh3); DA_WAITL(8); DA_MM4(4, xl0, xh0, xl1, xh1, xl2, xh2, xl3, xh3);             \
          DA_TR8(A_, 6, o_, xl0, xh0, xl1, xh1, xl2, xh2, xl3, xh3); DA_WAITL(8); DA_MM4(5, yl0, yh0, yl1, yh1, yl2, yh2, yl3, yh3);             \
          DA_TR8(A_, 7, o_, yl0, yh0, yl1, yh1, yl2, yh2, yl3, yh3); DA_WAITL(8); DA_MM4(6, xl0, xh0, xl1, xh1, xl2, xh2, xl3, xh3);             \
          DA_WAITL(0); DA_MM4(7, yl0, yh0, yl1, yh1, yl2, yh2, yl3, yh3); } while (0)
#define DA_ITER(t_, p_, A_, o_) do {                                                                                                             \
        asm volatile("s_waitcnt vmcnt(6)" ::: "memory"); __builtin_amdgcn_s_barrier(); asm volatile("" ::: "memory");                            \
        DA_DMAK((t_) + 3, (p_)); DA_DMAV((t_) + 2, ((p_) + 2) % 3);                                                                              \
        const bool nxt_ = ((t_) + 1 < NT) && ((t_) + 1 <= cw);                                                                                   \
          \
        if (nxt_) DA_QK(sn, (((p_) + 1) % 3) * KBS);                                                                                             \
        if ((t_) <= cw) { DA_SM() DA_RESC(); DA_PV(A_, o_); }                                                                                    \
        if (nxt_) { _Pragma("unroll") for (int T = 0; T < 4; ++T) st[T] = sn[T]; } } while (0)
    asm volatile("s_waitcnt vmcnt(0)" ::: "memory");
    __syncthreads();
    DA_DMAK(0, 0); DA_DMAV(0, 0); DA_DMAK(1, 1);
    DA_DMAK(2, 2); DA_DMAV(1, 1);
    asm volatile("s_waitcnt vmcnt(6)" ::: "memory"); __builtin_amdgcn_s_barrier(); asm volatile("" ::: "memory");
    DA_QK(st, 0);
    for (int t = 0; t < NT; t += 3) {
        DA_ITER(t, 0, 0u, 0);
        if (t + 1 >= NT) break;
        DA_ITER(t + 1, 1, 0u, 32768);
        if (t + 2 >= NT) break;
        DA_ITER(t + 2, 2, 65536u, 0);
    }
    asm volatile("s_waitcnt vmcnt(0)" ::: "memory");
#undef DA_ITER
#undef DA_PV
#undef DA_RESC
#undef DA_SM
#undef DA_QK
#undef DA_TR8
#undef DA_MM4
#undef DA_WAITL
#undef DA_TR
#undef DA_DMAK
#undef DA_DMAV
    float inv[4];
#pragma unroll
    for (int r = 0; r < 4; ++r) inv[r] = 1.f / bperm_f(4 * g + r, l);
    float* Op = B_OD(F) + (size_t)(P0 + 16 * wave + 4 * g) * 2048 + hd * 512 + mp * 256 + c16;
#pragma unroll
    for (int c = 0; c < 16; ++c)
#pragma unroll
        for (int r = 0; r < 4; ++r) Op[(size_t)r * 2048 + 16 * c] = O[c][r] * inv[r];
}
}
__device__ __forceinline__ dattn::BlockRef dattn_ref(const bf16_t* H, float* OD, int id) {
    dattn::BlockRef r; const int qb = 63 - (id >> 4), ph = id & 15, hd = ph >> 2, mp = (ph >> 1) & 1, e = ph & 1;
    r.Q = H + (size_t)(qb * 256) * NPAD + C_BQ + hd * 256 + mp * 128; r.K = H + C_BK + hd * 256 + mp * 128; r.V = H + C_BV + hd * 256 + e * 128;
    r.O = OD + (size_t)(qb * 256) * 2048 + hd * 512 + mp * 256 + e * 128; r.P0 = qb * 256; return r;
}
#ifndef REPP
#define REPP 1
#endif
#ifndef REPBAR
#define REPBAR 1
#endif
#ifndef REPA
#define REPA 1
#endif
#ifndef REPB
#define REPB 1
#endif
#ifndef REPC
#define REPC 1
#endif
#ifndef REPG1
#define REPG1 1
#endif
#ifndef REPS
#define REPS 1
#endif
#ifndef MIXMASK
#define MIXMASK 7
#endif
__device__ __forceinline__ void mix_phase(Frame& F, int l) {
    if (MIXMASK & 1) for (int rep = 0; rep < REPA; ++rep) { const int qx = rep * 16 + l * 4 + 0;
        for (int u = grab(F, qx); u < 16; u = grab(F, qx)) gla_unit(F, u); }
#ifndef USE_DA2
#define USE_DA2 1
#endif
#if USE_DA2
    if (MIXMASK & 2) for (int rep = 0; rep < REPB; ++rep) { const int qx = rep * 16 + l * 4 + 1;
        for (int u = grab(F, qx); u < 1024; u = grab(F, qx)) da2::block(F, u);
        __syncthreads();
    }
#else
    if (MIXMASK & 2) for (int rep = 0; rep < REPB; ++rep) { const int qx = rep * 16 + l * 4 + 1;
        int cur = grab(F, qx);
        if (cur < 1024) {
            dattn::Seam S;
            dattn::BlockRef rc = dattn_ref(B_H(F), B_OD(F), cur);
            dattn::prime(rc, (char*)F.lds, S, F.wave);
            for (;;) {
                const int nx = grab(F, qx); const bool last = nx >= 1024;
                const dattn::BlockRef rn = last ? rc : dattn_ref(B_H(F), B_OD(F), nx);
                dattn::block(rc, rn, (char*)F.lds, S, F.wave);
                if (last) break;
                rc = rn;
            }
            VM_WAIT(); __syncthreads();
        }
    }
#endif
    if (MIXMASK & 4) for (int rep = 0; rep < REPC; ++rep) { const int qx = rep * 16 + l * 4 + 2;
        for (int u = grab(F, qx); u < SEQ / 16; u = grab(F, qx)) sparse_unit(F, l, SEQ / 16 - 1 - u); }
}

struct Args { const float* in[14]; float* out; unsigned char* ws; int ph_lo, ph_hi, li, pad; };
constexpr int NPHASE = 1 + 6 * DEPTH;
__global__ void __launch_bounds__(NWAVES * 64, 2) trunk_fwd(Args args) {
    extern __shared__ __attribute__((aligned(16))) unsigned char lds[];
    Frame F;
    F.lds = (LAS unsigned char*)lds;
    F.MISC = (volatile LAS unsigned*)(F.lds + MISC_OFF);
    F.wave = __builtin_amdgcn_readfirstlane((int)threadIdx.x >> 6);
    F.G = gridDim.x; { const int bx = blockIdx.x; F.vcu = (F.G % 8 == 0) ? (bx % 8) * (F.G / 8) + bx / 8 : bx; }
    F.ws = args.ws;
    F.ctl = (gu32*)(args.ws + WS_CTL);
    if (threadIdx.x < 128) ((LAS unsigned*)(F.lds + MISC_OFF))[threadIdx.x] = 0u;
    __syncthreads();
    XcdBarrier bar = xcd_barrier_post((unsigned*)(F.ctl + CW_BAR), F.MISC + 0);
#ifndef PMASK
#define PMASK 0x7f
#endif
#define IN(k) true
#define SEAM(k) do { if ((k) + 1 < NPHASE) { XcdBarrier b2_ = bar; unsigned xx_ = b2_.x; asm volatile("" : "+s"(xx_)); b2_.x = xx_; for (int rb_ = 0; rb_ < REPBAR; ++rb_) xcd_barrier(b2_); } } while (0)
    if ((PMASK & 1) && IN(0)) { for (int rp_ = 0; rp_ < REPP; ++rp_) p0_prologue(F, args.in[0], args.in[1], args.in[2], args.in[11]); SEAM(0); }
    for (int l = 0; l < DEPTH; ++l) {
        const int pb = 1 + 6 * l;
        const float lam_init = 0.8f - 0.6f * expf(-0.3f * (float)l);
        if ((PMASK & 2) && IN(pb + 0)) {
            pg8::Gemm g{B_XB(F), B_WTIN(F) + (size_t)l * NPAD * DM, SEQ, NPAD, DM}; pg8::StaticOrder S; S.init(SEQ, NPAD, F.G, (int)blockIdx.x);
            pg8::EpiBf16Plain E{B_H(F), NPAD};
            for (int rep = 0; rep < REPG1; ++rep) pg8::gemm_phase<pg8::EpiBf16Plain, pg8::StaticOrder, true, true>(F.lds, g, S, E, F.wave);
            SEAM(pb + 0);
        }
        if ((PMASK & 4) && IN(pb + 1)) { for (int rep = 0; rep < REPS; ++rep) prep_phase(F, l, args.in[3], args.in[4], args.in[8], args.in[9], args.in[10]); SEAM(pb + 1); }
        if ((PMASK & 8) && IN(pb + 2)) { mix_phase(F, l); SEAM(pb + 2); }
        if ((PMASK & 16) && IN(pb + 3)) { for (int rep = 0; rep < REPS; ++rep) post_phase(F, l, lam_init, args.in[5], args.in[6], args.in[7]); SEAM(pb + 3); }
        if ((PMASK & 32) && IN(pb + 4)) {
            pg8::Gemm g{B_O(F), B_WTOUT(F) + (size_t)l * DM * DM, SEQ, DM, DM}; pg8::StaticOrder S; S.init(SEQ, DM, F.G, (int)blockIdx.x);
            pg8::EpiResid E{l == 0 ? args.in[0] : B_XF(F), B_XF(F), DM, 1.6817928305074290f};
            pg8::gemm_phase<pg8::EpiResid, pg8::StaticOrder, true, true>(F.lds, g, S, E, F.wave);
            SEAM(pb + 4);
        }
        if ((PMASK & 64) && IN(pb + 5)) {
#if defined(REPLN)
            ln_phase(F, l, args.in[12], args.in[13], args.out, true);
#endif
            ln_phase(F, l, args.in[12], args.in[13], args.out, false); SEAM(pb + 5); }
    }
#undef IN
#undef SEAM
}

#ifndef MK_N_LAUNCHES
#define MK_N_LAUNCHES 1
#endif
extern "C" void kernel_launch(void* const* d_in, const int* in_sizes, int n_in, void* d_out, int out_size, void* d_ws, size_t ws_size, hipStream_t stream) {
    static int grid = 0;
    if (grid == 0) {
        if (n_in != 14 || in_sizes[0] != SEQ * DM || out_size != SEQ * DM || ws_size < WS_END) {
            fprintf(stderr, "kernel_launch: shape mismatch (n_in %d, in0 %d, out %d, ws %zu; need ws >= %zu)\n", n_in, n_in > 0 ? in_sizes[0] : -1, out_size, ws_size, (size_t)WS_END); grid = -1; return; }
        int dev = 0, cus = 0, per_cu = 0;
        if (hipGetDevice(&dev) != hipSuccess || hipDeviceGetAttribute(&cus, hipDeviceAttributeMultiprocessorCount, dev) != hipSuccess) { grid = -1; return; }
        if (hipFuncSetAttribute((const void*)trunk_fwd, hipFuncAttributeMaxDynamicSharedMemorySize, LDS_BYTES) != hipSuccess) { fprintf(stderr, "kernel_launch: hipFuncSetAttribute failed\n"); grid = -1; return; }
        if (hipOccupancyMaxActiveBlocksPerMultiprocessor(&per_cu, (const void*)trunk_fwd, NWAVES * 64, LDS_BYTES) != hipSuccess || per_cu < 1)
            fprintf(stderr, "kernel_launch: occupancy query reports %d workgroups per CU\n", per_cu);
        (void)hipGetLastError();
        grid = cus;
    }
    if (grid < 0) return;
    if (hipMemsetAsync((char*)d_ws + WS_CTL, 0, CTL_ZERO_BYTES, stream) != hipSuccess) return;
    Args a{};
    for (int i = 0; i < 14; ++i) a.in[i] = (const float*)d_in[i];
    a.out = (float*)d_out; a.ws = (unsigned char*)d_ws;
    a.ph_lo = 0; a.ph_hi = NPHASE; a.li = 0; a.pad = 0;
    hipLaunchKernelGGL(trunk_fwd, dim3(grid), dim3(NWAVES * 64), LDS_BYTES, stream, a);
    const hipError_t le = hipPeekAtLastError();
    if (le != hipSuccess) fprintf(stderr, "kernel_launch: launch failed: %s\n", hipGetErrorName(le));
}
```

```cpp
#include <hip/hip_runtime.h>
#include <cstdio>
#include <cstdint>

#define GAS __attribute__((address_space(1)))
#define LAS __attribute__((address_space(3)))
typedef unsigned short bf16_t;
typedef short s16x4 __attribute__((ext_vector_type(4)));
typedef float f32x16 __attribute__((ext_vector_type(16)));
typedef unsigned u32x2 __attribute__((ext_vector_type(2)));
typedef GAS unsigned gu32;

__device__ __forceinline__ int hw_lane() { int r; asm volatile("v_mbcnt_lo_u32_b32 %0, -1, 0\n\tv_mbcnt_hi_u32_b32 %0, -1, %0" : "=v"(r)); return r; }

constexpr int SEQ = 16384, DM = 4096, DEPTH = 4, NIN = 14688, NPAD = 14848;
constexpr int CHUNK = 64, NCHUNK = SEQ / CHUNK;
constexpr int C_AQ = 0, C_AK = 1024, C_AV = 2048, C_AG = 4096, C_BQ = 6144, C_BK = 7168, C_BV = 8192, C_BG = 9216, C_CQ = 10240,
              C_CKV = 12288, C_CIQ = 12544, C_CG = 13568, C_CIK = 14592, C_AA = 14656, C_CIW = 14672;
__host__ __device__ __forceinline__ int srccol(int n) {
    if (n < 4096) return n;
    if (n < 6144) return n + 16;
    if (n < 13568) return n + 16;
    if (n < 14592) return n + 96;
    if (n < 14656) return n - 1008;
    if (n < 14672) return n - 10560;
    if (n < 14688) return n - 1024;
    return -1;
}
namespace pg8 {
#define PG8_LAS __attribute__((address_space(3)))
typedef unsigned short bf16_t;
typedef short bf16x8 __attribute__((ext_vector_type(8)));
typedef float f32x4 __attribute__((ext_vector_type(4)));
typedef unsigned u32x4 __attribute__((ext_vector_type(4)));
constexpr int BM = 256, BK = 64, HALF = 128, HTB = HALF * BK * 2  , STAGE_BYTES = 8 * HTB, NXCD = 8, WGM = 8;

__host__ __device__ __forceinline__ int lds_byte(int r, int c) { const int st = (r >> 4) * 2 + (c >> 5), rr = r & 15, cc = c & 31, ob = rr * 64 + cc * 2; return st * 1024 + (ob ^ (((ob >> 9) & 1) << 5)); }
__host__ __device__ __forceinline__ void stage_rc(int b, int& R, int& C) { const int st = b / 1024, sb = b % 1024, swz = sb ^ (((sb >> 9) & 1) << 5); R = (st >> 1) * 16 + swz / 64; C = (st & 1) * 32 + (swz % 64) / 2; }
__host__ __device__ __forceinline__ int perm32(int rho) { const int n = rho >> 4, i = rho & 15; return 8 * (i >> 2) + 4 * n + (i & 3); }

struct Unit { int pm, pn; };
struct Gemm { const bf16_t* A; const bf16_t* Bt; int M, N, K; };

struct StaticOrder {
    int nM, nN, nwg, G, c;
    __host__ __device__ void init(int M, int N, int G_, int c_) { nM = M / BM; nN = N / BM; nwg = nM * nN; G = G_; c = c_; }
    __host__ __device__ bool next(int i, Unit& u) const {
        const long L = (long)i * G + c; if (L >= nwg) return false;
        int wgid = (int)L; { const int q = nwg / NXCD, r = nwg % NXCD, xcd = wgid % NXCD, off = wgid / NXCD; wgid = (xcd < r ? xcd * (q + 1) : r * (q + 1) + (xcd - r) * q) + off; }
        const int nig = WGM * nN, gid = wgid / nig, fm = gid * WGM, gsz = (nM - fm) < WGM ? (nM - fm) : WGM;
        u.pm = fm + ((wgid % nig) % gsz); u.pn = (wgid % nig) / gsz; return true;
    }
    __device__ __forceinline__ void a_ready(const Unit&) const {}
    __device__ __forceinline__ void done(const Unit&) const {}
};

__device__ __forceinline__ unsigned cvt_pk_bf16(float lo, float hi) { unsigned r; asm volatile("v_cvt_pk_bf16_f32 %0, %1, %2" : "=v"(r) : "v"(lo), "v"(hi)); return r; }
typedef float f32x2 __attribute__((ext_vector_type(2)));
struct EpiBf16Plain {
    static constexpr bool PERM = true, AFTER_DRAIN = false;
    bf16_t* O; int ldc;
    __device__ __forceinline__ void operator()(const f32x4 (&acc)[2][2][4][2], const Unit& u, int wr, int wc, int fr, int fq) const {
        const int row0 = u.pm * BM + wr * 64 + fr, col0 = u.pn * BM + wc * 32 + 8 * fq;
#pragma unroll
        for (int ai = 0; ai < 2; ++ai)
#pragma unroll
            for (int m = 0; m < 4; ++m) { bf16_t* rowp = O + (size_t)(row0 + ai * HALF + m * 16) * ldc + col0;
#pragma unroll
                for (int bj = 0; bj < 2; ++bj) { const f32x4 v0 = acc[ai][bj][m][0], v1 = acc[ai][bj][m][1];
                    u32x4 w; w.x = cvt_pk_bf16(v0[0], v0[1]); w.y = cvt_pk_bf16(v0[2], v0[3]); w.z = cvt_pk_bf16(v1[0], v1[1]); w.w = cvt_pk_bf16(v1[2], v1[3]);
                    *(u32x4*)(rowp + bj * HALF) = w; } }
    }
};
struct EpiResid {
    static constexpr bool PERM = false, AFTER_DRAIN = false;
    const float* Xin; float* Xout; int ldc; float alpha;
    __device__ __forceinline__ void operator()(const f32x4 (&acc)[2][2][4][2], const Unit& u, int wr, int wc, int fr, int fq) const {
        const int row0 = u.pm * BM + wr * 64 + fr, col0 = u.pn * BM + wc * 32 + 4 * fq;
#pragma unroll
        for (int ai = 0; ai < 2; ++ai)
#pragma unroll
            for (int m = 0; m < 4; ++m) { const size_t off = (size_t)(row0 + ai * HALF + m * 16) * ldc + col0;
#pragma unroll
                for (int bj = 0; bj < 2; ++bj)
#pragma unroll
                    for (int n = 0; n < 2; ++n) { const f32x4 xi = *(const f32x4*)(Xin + off + bj * HALF + n * 16);
                        *(f32x4*)(Xout + off + bj * HALF + n * 16) = xi * alpha + acc[ai][bj][m][n]; }
                asm volatile("" ::: "memory"); }
    }
};
struct EpiResidB {
    static constexpr bool PERM = false, AFTER_DRAIN = false;
    const bf16_t* Xin; float* Xout; int ldc; float alpha;
    __device__ __forceinline__ void operator()(const f32x4 (&acc)[2][2][4][2], const Unit& u, int wr, int wc, int fr, int fq) const {
        const int row0 = u.pm * BM + wr * 64 + fr, col0 = u.pn * BM + wc * 32 + 4 * fq;
#pragma unroll
        for (int ai = 0; ai < 2; ++ai)
#pragma unroll
            for (int m = 0; m < 4; ++m) { const size_t off = (size_t)(row0 + ai * HALF + m * 16) * ldc + col0;
#pragma unroll
                for (int bj = 0; bj < 2; ++bj)
#pragma unroll
                    for (int n = 0; n < 2; ++n) { const unsigned long long w = *(const unsigned long long*)(Xin + off + bj * HALF + n * 16);
                        const unsigned lo = (unsigned)w, hi = (unsigned)(w >> 32);
                        const f32x4 xi = {__uint_as_float(lo << 16), __uint_as_float(lo & 0xffff0000u), __uint_as_float(hi << 16), __uint_as_float(hi & 0xffff0000u)};
                        *(f32x4*)(Xout + off + bj * HALF + n * 16) = xi * alpha + acc[ai][bj][m][n]; }
                asm volatile("" ::: "memory"); }
    }
};
template <class Epi, class Sched, bool ALIGN_EPI = false, bool SP2 = false>
__device__ __forceinline__ void gemm_phase(PG8_LAS unsigned char* lds, const Gemm g, const Sched& S, const Epi& E, int wave_id) {
    int tid_ = wave_id * 64 + hw_lane(); asm volatile("" : "+v"(tid_));
    const int tid = tid_, wid = __builtin_amdgcn_readfirstlane(tid >> 6), lane = tid & 63, wr = wid >> 2, wc = wid & 3, fr = lane & 15, fq = lane >> 4;
    const int K = g.K, nt = K / BK;
    unsigned voffA[2], voffB[2];
#pragma unroll
    for (int i = 0; i < 2; ++i) { int R, C; stage_rc(tid * 16 + i * 8192, R, C); const int Rb = Epi::PERM ? ((R & ~31) + perm32(R & 31)) : R;
        voffA[i] = (unsigned)(R * K + C) * 2u; voffB[i] = (unsigned)(Rb * K + C) * 2u; }
    const size_t kstep = (size_t)(BK * 2);
    const size_t hstep = (size_t)HALF * K * 2;
    const size_t tstep = 2 * hstep;
    const unsigned ldsw = (unsigned)wid * 1024u;
    const int aoff = lds_byte(wr * 64 + fr, fq * 8), boff = lds_byte(wc * 32 + fr, fq * 8);
#define PG8_SA(b, h) (((b) * 2 + (h)) * HTB)
#define PG8_SB(b, h) ((4 + (b) * 2 + (h)) * HTB)
#define PG8_STAGE(bufoff, gbase, voff) do { _Pragma("unroll") for (int _i = 0; _i < 2; ++_i) \
        __builtin_amdgcn_global_load_lds((const unsigned*)((const char*)(gbase) + (voff)[_i]), (PG8_LAS unsigned*)(lds + (bufoff) + ldsw + _i * 8192), 16, 0, 0); } while (0)
#define PG8_LDA(dst, b, h) do { _Pragma("unroll") for (int m = 0; m < 4; ++m) _Pragma("unroll") for (int k = 0; k < 2; ++k) dst[m][k] = *(const PG8_LAS bf16x8*)(lds + PG8_SA(b, h) + aoff + m * 2048 + k * 1024); } while (0)
#define PG8_LDB(dst, b, h) do { _Pragma("unroll") for (int n = 0; n < 2; ++n) _Pragma("unroll") for (int k = 0; k < 2; ++k) dst[n][k] = *(const PG8_LAS bf16x8*)(lds + PG8_SB(b, h) + boff + n * 2048 + k * 1024); } while (0)
#define PG8_MMA(ai, bj, At, Bt) do { __builtin_amdgcn_s_setprio(1); _Pragma("unroll") for (int m = 0; m < 4; ++m) _Pragma("unroll") for (int n = 0; n < 2; ++n) _Pragma("unroll") for (int k = 0; k < 2; ++k) \
        acc[ai][bj][m][n] = __builtin_amdgcn_mfma_f32_16x16x32_bf16(Bt[n][k], At[m][k], acc[ai][bj][m][n], 0, 0, 0); __builtin_amdgcn_s_setprio(0); } while (0)
#define PG8_WAIT_V(n) asm volatile("s_waitcnt vmcnt(" #n ")" ::: "memory")
#define PG8_WAIT_L(n) asm volatile("s_waitcnt lgkmcnt(" #n ")" ::: "memory")
#define PG8_BAR __builtin_amdgcn_s_barrier()
#define PG8_SCHED __builtin_amdgcn_sched_barrier(0)
    Unit cur, nxt; int ui = 0;
    if (!S.next(0, cur)) return;
    f32x4 acc[2][2][4][2];
#pragma unroll
    for (int a = 0; a < 2; ++a)
#pragma unroll
        for (int b = 0; b < 2; ++b)
#pragma unroll
            for (int m = 0; m < 4; ++m)
#pragma unroll
                for (int n = 0; n < 2; ++n) acc[a][b][m][n] = (f32x4){0.f, 0.f, 0.f, 0.f};
    bf16x8 At[4][2], B0[2][2], B1[2][2];
    const char* cA = (const char*)g.A + (size_t)cur.pm * tstep; const char* cB = (const char*)g.Bt + (size_t)cur.pn * tstep;
    S.a_ready(cur);
    if constexpr (SP2) {
        PG8_STAGE(PG8_SB(0, 0), cB, voffB); PG8_STAGE(PG8_SB(0, 1), cB + hstep, voffB); PG8_STAGE(PG8_SA(0, 0), cA, voffA); PG8_STAGE(PG8_SA(0, 1), cA + hstep, voffA);
        if (wr == 1) PG8_BAR;
        PG8_WAIT_V(2); PG8_BAR;
        PG8_STAGE(PG8_SB(1, 0), cB + kstep, voffB); PG8_STAGE(PG8_SA(1, 0), cA + kstep, voffA); PG8_STAGE(PG8_SB(1, 1), cB + hstep + kstep, voffB);
        PG8_WAIT_V(6); PG8_BAR;
    } else {
        PG8_STAGE(PG8_SB(0, 0), cB, voffB); PG8_STAGE(PG8_SA(0, 0), cA, voffA); PG8_STAGE(PG8_SB(0, 1), cB + hstep, voffB); PG8_STAGE(PG8_SA(0, 1), cA + hstep, voffA);
        if (wr == 1) PG8_BAR;
        PG8_WAIT_V(4); PG8_BAR;
        PG8_STAGE(PG8_SB(1, 0), cB + kstep, voffB); PG8_STAGE(PG8_SA(1, 0), cA + kstep, voffA); PG8_STAGE(PG8_SB(1, 1), cB + hstep + kstep, voffB);
        PG8_WAIT_V(6); PG8_BAR;
    }
    for (;;) {
        const bool has_next = S.next(ui + 1, nxt);
        const char* nA = has_next ? (const char*)g.A + (size_t)nxt.pm * tstep : cA; const char* nB = has_next ? (const char*)g.Bt + (size_t)nxt.pn * tstep : cB;
        for (int t = 0; t < nt; t += 2) {
            const bool last = (t == nt - 2);
            const char* a1 = cA + (size_t)(t + 1) * kstep;
            const char* a2 = last ? nA : cA + (size_t)(t + 2) * kstep; const char* b2 = last ? nB : cB + (size_t)(t + 2) * kstep;
            const char* a3 = a2 + kstep; const char* b3 = b2 + kstep;
            if (last && has_next) S.a_ready(nxt);
            if constexpr (SP2) {
            PG8_LDB(B0, 0, 0); PG8_LDB(B1, 0, 1); PG8_SCHED; PG8_LDA(At, 0, 0); PG8_STAGE(PG8_SA(1, 1), a1 + hstep, voffA);
            PG8_WAIT_V(8); PG8_WAIT_L(0); PG8_BAR; PG8_MMA(0, 0, At, B0); PG8_MMA(0, 1, At, B1); PG8_BAR; PG8_SCHED;
            PG8_LDA(At, 0, 1); PG8_STAGE(PG8_SB(0, 0), b2, voffB); PG8_STAGE(PG8_SB(0, 1), b2 + hstep, voffB); PG8_STAGE(PG8_SA(0, 0), a2, voffA);
            PG8_WAIT_V(8); PG8_WAIT_L(0); PG8_BAR; PG8_MMA(1, 0, At, B0); PG8_MMA(1, 1, At, B1); PG8_BAR; PG8_SCHED;
            PG8_LDB(B0, 1, 0); PG8_LDB(B1, 1, 1); PG8_SCHED; PG8_LDA(At, 1, 0); PG8_STAGE(PG8_SA(0, 1), a2 + hstep, voffA);
            PG8_WAIT_V(8); PG8_WAIT_L(0); PG8_BAR; PG8_MMA(0, 0, At, B0); PG8_MMA(0, 1, At, B1); PG8_BAR; PG8_SCHED;
            PG8_LDA(At, 1, 1); PG8_STAGE(PG8_SB(1, 0), b3, voffB); PG8_STAGE(PG8_SB(1, 1), b3 + hstep, voffB); PG8_STAGE(PG8_SA(1, 0), a3, voffA);
            PG8_WAIT_V(8); PG8_WAIT_L(0); PG8_BAR; PG8_MMA(1, 0, At, B0); PG8_MMA(1, 1, At, B1); PG8_BAR; PG8_SCHED;
            } else {
            PG8_LDB(B0, 0, 0); PG8_SCHED; PG8_LDA(At, 0, 0); PG8_STAGE(PG8_SA(1, 1), a1 + hstep, voffA);
            PG8_WAIT_L(8); PG8_BAR; PG8_WAIT_L(0); PG8_MMA(0, 0, At, B0); PG8_BAR; PG8_SCHED;
            PG8_LDB(B1, 0, 1); PG8_STAGE(PG8_SB(0, 0), b2, voffB);
            PG8_BAR; PG8_WAIT_L(0); PG8_MMA(0, 1, At, B1); PG8_BAR;
            PG8_LDA(At, 0, 1); PG8_STAGE(PG8_SA(0, 0), a2, voffA);
            PG8_BAR; PG8_WAIT_L(0); PG8_MMA(1, 0, At, B0); PG8_BAR; PG8_SCHED;
            PG8_STAGE(PG8_SB(0, 1), b2 + hstep, voffB);
            PG8_WAIT_V(6); PG8_BAR; PG8_MMA(1, 1, At, B1); PG8_BAR;
            PG8_LDB(B0, 1, 0); PG8_SCHED; PG8_LDA(At, 1, 0); PG8_STAGE(PG8_SA(0, 1), a2 + hstep, voffA);
            PG8_WAIT_L(8); PG8_BAR; PG8_WAIT_L(0); PG8_MMA(0, 0, At, B0); PG8_BAR; PG8_SCHED;
            PG8_LDB(B1, 1, 1); PG8_STAGE(PG8_SB(1, 0), b3, voffB);
            PG8_BAR; PG8_WAIT_L(0); PG8_MMA(0, 1, At, B1); PG8_BAR;
            PG8_LDA(At, 1, 1); PG8_STAGE(PG8_SA(1, 0), a3, voffA);
            PG8_BAR; PG8_WAIT_L(0); PG8_MMA(1, 0, At, B0); PG8_BAR; PG8_SCHED;
            PG8_STAGE(PG8_SB(1, 1), b3 + hstep, voffB);
            PG8_WAIT_V(6); PG8_BAR; PG8_MMA(1, 1, At, B1); PG8_BAR;
            }
        }
        if constexpr (ALIGN_EPI) { if (wr == 0) PG8_BAR; }
        if constexpr (!Epi::AFTER_DRAIN) { E(acc, cur, wr, wc, fr, fq); S.done(cur); }
        if (!has_next) break;
#pragma unroll
        for (int a = 0; a < 2; ++a)
#pragma unroll
            for (int b = 0; b < 2; ++b)
#pragma unroll
                for (int m = 0; m < 4; ++m)
#pragma unroll
                    for (int n = 0; n < 2; ++n) acc[a][b][m][n] = (f32x4){0.f, 0.f, 0.f, 0.f};
        cur = nxt; cA = nA; cB = nB; ++ui;
        if constexpr (ALIGN_EPI) { if (wr == 1) PG8_BAR; }
    }
    PG8_WAIT_V(0);
    if constexpr (!ALIGN_EPI) { if (wr == 0) PG8_BAR; }
    PG8_BAR;
    if constexpr (Epi::AFTER_DRAIN) { E.fused(acc, cur, wr, wc, fr, fq, lds, wid, lane); S.done(cur); }
#undef PG8_SA
#undef PG8_SB
#undef PG8_STAGE
#undef PG8_LDA
#undef PG8_LDB
#undef PG8_MMA
#undef PG8_WAIT_V
#undef PG8_WAIT_L
#undef PG8_BAR
#undef PG8_SCHED
}
}
using pg8::bf16x8; using pg8::f32x4; using pg8::u32x4;
namespace dattn {
constexpr int D = 128, LDQ = NPAD, LDK = NPAD, LDO = 2048;
constexpr float SCALE = 0.08838834764831845f;
constexpr float THR = 8.f;
constexpr int NW = 8, QBLK = 32, KVBLK = 64, QB = NW * QBLK;
constexpr int SHM_V = KVBLK * D * 2, SHM_K = KVBLK * D * 2;
constexpr int LDS_BYTES = 2 * SHM_V + 2 * SHM_K + NW * 64 * 4;

#define KSWZ(row, colB) ((row) * 256 + ((colB) ^ (((row) & 7) << 4)))
#define SBAR() __builtin_amdgcn_sched_barrier(0)
__device__ __forceinline__ int v_st(int k, int c) { const int kk = (k & ~0xC) | ((k & 4) << 1) | ((k & 8) >> 1); return ((kk >> 3) * 4 + (c >> 5)) * 512 + ((kk & 7) * 32 + (c & 31)) * 2; }
__device__ __forceinline__ int v_rd_base(int lane) { return ((lane & 3) << 3) | (((lane >> 2) & 3) << 6) | (((lane >> 4) & 1) << 5) | (((lane >> 5) & 1) << 8); }
constexpr int v_rd_off(int d0, int ks, int half) { return d0 * 512 + ks * 4096 + half * 2048; }
__device__ __forceinline__ int crow(int r, int hi) { return (r & 3) + 8 * (r >> 2) + 4 * hi; }
__device__ __forceinline__ unsigned cvtpk(float lo, float hi) { unsigned r; asm volatile("v_cvt_pk_bf16_f32 %0, %1, %2" : "=v"(r) : "v"(lo), "v"(hi)); return r; }
__device__ __forceinline__ bf16x8 load8(const bf16_t* p) { return *reinterpret_cast<const bf16x8*>(p); }

__device__ __forceinline__ void partialSM(f32x16& p0, f32x16& p1, float& m_reg, float& mn, float& alpha) {
    float pmax = p0[0]; for (int r = 1; r < 16; ++r) pmax = fmaxf(pmax, p0[r]); for (int r = 0; r < 16; ++r) pmax = fmaxf(pmax, p1[r]);
    { auto rr = __builtin_amdgcn_permlane32_swap(__float_as_uint(pmax), __float_as_uint(pmax), false, false);
      pmax = fmaxf(__uint_as_float(rr[0]), __uint_as_float(rr[1])); }
    constexpr float C2 = 1.4426950408889634f * SCALE;
    if (__builtin_expect(__all((pmax - m_reg) * SCALE <= THR), 1)) { mn = m_reg; alpha = 1.f; }
    else { mn = fmaxf(m_reg, pmax); alpha = __builtin_amdgcn_exp2f((m_reg - mn) * C2); m_reg = mn; }
    const float mnL = -mn * C2;
    for (int r = 0; r < 16; ++r) p0[r] = fmaf(p0[r], C2, mnL); for (int r = 0; r < 16; ++r) p1[r] = fmaf(p1[r], C2, mnL);
    for (int r = 0; r < 16; ++r) p0[r] = __builtin_amdgcn_exp2f(p0[r]);
}
__device__ __forceinline__ void finishSM(f32x16& p0, f32x16& p1, float alpha, float& l_reg, bf16x8& pa0, bf16x8& pa1, bf16x8& pa2, bf16x8& pa3) {
    for (int r = 0; r < 16; ++r) p1[r] = __builtin_amdgcn_exp2f(p1[r]);
    float ps = 0; for (int r = 0; r < 16; ++r) ps += p0[r]; for (int r = 0; r < 16; ++r) ps += p1[r];
    { auto rr = __builtin_amdgcn_permlane32_swap(__float_as_uint(ps), __float_as_uint(ps), false, false);
      ps = __uint_as_float(rr[0]) + __uint_as_float(rr[1]); }
    l_reg = l_reg * alpha + ps;
#define PK4(P, B_, OUT) do { unsigned a0 = cvtpk(P[B_+0], P[B_+1]), a1 = cvtpk(P[B_+2], P[B_+3]);                          \
        unsigned b0 = cvtpk(P[B_+4], P[B_+5]), b1 = cvtpk(P[B_+6], P[B_+7]);                                             \
        auto r0 = __builtin_amdgcn_permlane32_swap(a0, b0, false, false); auto r1 = __builtin_amdgcn_permlane32_swap(a1, b1, false, false); \
        u32x4 w = {r0[0], r1[0], r0[1], r1[1]}; OUT = *reinterpret_cast<bf16x8*>(&w); } while (0)
    PK4(p0, 0, pa0); PK4(p0, 8, pa1); PK4(p1, 0, pa2); PK4(p1, 8, pa3);
#undef PK4
}
template <int KB>
__device__ __forceinline__ void qkt(f32x16& p0, f32x16& p1, const char* K_lds, int r32, int hi, const bf16x8* qr) {
    p0 = f32x16{}; p1 = f32x16{};
    const char* kb[4];
#pragma unroll
    for (int dd = 0; dd < 4; ++dd) kb[dd] = K_lds + KB * SHM_K + KSWZ(r32, (dd * 16 + hi * 8) * 2);
#pragma unroll
    for (int d0 = 0; d0 < 8; ++d0) { const char* a = kb[d0 & 3] + (d0 >> 2) * 128;
        bf16x8 b0 = *reinterpret_cast<const bf16x8*>(a);
        bf16x8 b1 = *reinterpret_cast<const bf16x8*>(a + 32 * 256);
        p0 = __builtin_amdgcn_mfma_f32_32x32x16_bf16(b0, qr[d0], p0, 0, 0, 0);
        p1 = __builtin_amdgcn_mfma_f32_32x32x16_bf16(b1, qr[d0], p1, 0, 0, 0); }
}
template <int VB>
__device__ __forceinline__ void pv_tile(f32x16* o, int vb0, bf16x8 pa0, bf16x8 pa1, bf16x8 pa2, bf16x8 pa3) {
#define TRRD(dst, off) asm volatile("ds_read_b64_tr_b16 %0, %1 offset:%2" : "=&v"(dst) : "v"(vb0), "i"(off) : "memory")
#define PV_D0(d0) do { s16x4 l0, l1, l2, l3, h0, h1, h2, h3; constexpr int b_ = VB * SHM_V + v_rd_off(d0, 0, 0);   \
        TRRD(l0, b_); TRRD(h0, b_ + 2048); TRRD(l1, b_ + 4096); TRRD(h1, b_ + 6144); TRRD(l2, b_ + 8192); TRRD(h2, b_ + 10240); TRRD(l3, b_ + 12288); TRRD(h3, b_ + 14336); \
        asm volatile("s_waitcnt lgkmcnt(0)" ::: "memory"); SBAR();                                                   \
        o[d0] = __builtin_amdgcn_mfma_f32_32x32x16_bf16(pa0, (bf16x8){l0[0], l0[1], l0[2], l0[3], h0[0], h0[1], h0[2], h0[3]}, o[d0], 0, 0, 0);   \
        o[d0] = __builtin_amdgcn_mfma_f32_32x32x16_bf16(pa1, (bf16x8){l1[0], l1[1], l1[2], l1[3], h1[0], h1[1], h1[2], h1[3]}, o[d0], 0, 0, 0);   \
        o[d0] = __builtin_amdgcn_mfma_f32_32x32x16_bf16(pa2, (bf16x8){l2[0], l2[1], l2[2], l2[3], h2[0], h2[1], h2[2], h2[3]}, o[d0], 0, 0, 0);   \
        o[d0] = __builtin_amdgcn_mfma_f32_32x32x16_bf16(pa3, (bf16x8){l3[0], l3[1], l3[2], l3[3], h3[0], h3[1], h3[2], h3[3]}, o[d0], 0, 0, 0); } while (0)
    PV_D0(0); PV_D0(1); PV_D0(2); PV_D0(3);
#undef PV_D0
#undef TRRD
}

struct BlockRef { const bf16_t* Q; const bf16_t* K; const bf16_t* V; float* O; int P0; };
struct Seam { bf16x8 qr[8]; bf16x8 st_v0, st_v1, st_k0, st_k1; };
#define ROW(p, k0, rr) ((p) + (size_t)((k0) + (rr)) * LDK + sc)
#define VMW() asm volatile("s_waitcnt vmcnt(0)" ::: "memory")
#define VMWN(n) asm volatile("s_waitcnt vmcnt(%0)" :: "i"(n) : "memory")
#define SLOAD_H(Kp, Vp, k0) do { S.st_v0 = load8(ROW(Vp, k0, sr)); S.st_v1 = load8(ROW(Vp, k0, 32 + sr));              \
                         S.st_k0 = load8(ROW(Kp, k0, sr)); S.st_k1 = load8(ROW(Kp, k0, 32 + sr)); } while (0)
#define SWRITE_HK(bf) do { *(bf16x8*)(K_lds + (bf) * SHM_K + kws) = S.st_k0; *(bf16x8*)(K_lds + (bf) * SHM_K + kws + 32 * 256) = S.st_k1; } while (0)
#define SWRITE_HV(bf) do { *(bf16x8*)(V_lds + (bf) * SHM_V + vst0) = S.st_v0; *(bf16x8*)(V_lds + (bf) * SHM_V + vst1) = S.st_v1; } while (0)
#define SWRITE_H(bf) do { SWRITE_HV(bf); SWRITE_HK(bf); } while (0)
__device__ __forceinline__ void prime(const BlockRef& cur, char* lds, Seam& S, int wave_id) {
    int tid_ = wave_id * 64 + hw_lane(); asm volatile("" : "+v"(tid_));
    const int tid = tid_, wid = __builtin_amdgcn_readfirstlane(tid >> 6), lane = tid & 63, r32 = lane & 31, hi = lane >> 5;
    const int sr = tid >> 4, sc = (tid & 15) * 8, kws = KSWZ(sr, sc * 2); char* K_lds = lds + 2 * SHM_V;
#pragma unroll
    for (int d0 = 0; d0 < 8; ++d0) S.qr[d0] = load8(cur.Q + (size_t)(wid * QBLK + r32) * LDQ + d0 * 16 + hi * 8);
    SLOAD_H(cur.K, cur.V, 0); VMW(); SWRITE_HK(0);
    __syncthreads();
}
__device__ __forceinline__ void block(const BlockRef& cur, const BlockRef& nxt, char* lds, Seam& S, int wave_id) {
    int tid_ = wave_id * 64 + hw_lane(); asm volatile("" : "+v"(tid_));
    const int tid = tid_, wid = __builtin_amdgcn_readfirstlane(tid >> 6), lane = tid & 63, r32 = lane & 31, hi = lane >> 5;
    const int NT = cur.P0 / KVBLK + 4;
    const int qlo = cur.P0 + wid * QBLK;
    const int qend = qlo | 63;
    char* V_lds = lds; char* K_lds = lds + 2 * SHM_V;
    float* ws = (float*)(lds + 2 * SHM_V + 2 * SHM_K) + wid * 64; float* li_l = ws, * al_l = ws + 32;
    float m_reg = -1e30f, l_reg = 0; f32x16 o[4] = {};
    const int sr = tid >> 4, sc = (tid & 15) * 8, vst0 = v_st(sr, sc), vst1 = v_st(32 + sr, sc), kws = KSWZ(sr, sc * 2);
    const int vb0 = (int)(uintptr_t)V_lds + v_rd_base(lane);
    const bf16_t* Kh = cur.K; const bf16_t* Vh = cur.V;
#define RESC(a) do { if (__any((a) < 1.f)) { if (hi == 0) al_l[r32] = (a); asm volatile("s_waitcnt lgkmcnt(0)" ::: "memory");              \
                     for (int d_ = 0; d_ < 4; ++d_) for (int r = 0; r < 16; ++r) o[d_][r] *= al_l[crow(r, hi)]; } } while (0)
#define KBASE(t) ((t) * KVBLK)
#define MASKT(P0_, P1_, t) do { if (KBASE(t) > qend) { const float NEG_ = -__builtin_inff(); _Pragma("unroll") for (int r_ = 0; r_ < 16; ++r_) { P0_[r_] = NEG_; P1_[r_] = NEG_; } } } while (0)
    constexpr int NQL = 8;
#define SEAM_K0() do { VMWN(NQL); SWRITE_HK(0); SBAR(); } while (0)
    f32x16 pA0, pA1, pB0, pB1; float mnA, mnB, alA, alB; bf16x8 pa0, pa1, pa2, pa3;
    SWRITE_HV(0); SBAR();
    if (NT > 1) { SLOAD_H(Kh, Vh, KBASE(1)); }
    SBAR(); qkt<0>(pA0, pA1, K_lds, r32, hi, S.qr);
    MASKT(pA0, pA1, 0); partialSM(pA0, pA1, m_reg, mnA, alA);
    if (NT > 1) { VMW(); SWRITE_H(1); }
    __syncthreads();
#define HALF_STEP(PX0, PX1, mnX, alX, PY0, PY1, alY, t, KB, VB, SB) do {                                                      \
        SBAR(); qkt<KB>(PX0, PX1, K_lds, r32, hi, S.qr);                                                                      \
        finishSM(PY0, PY1, alY, l_reg, pa0, pa1, pa2, pa3); SBAR();                                                           \
        if ((t) + 1 < NT) { SLOAD_H(Kh, Vh, KBASE((t) + 1)); SBAR(); }                                                        \
        pv_tile<VB>(o, vb0, pa0, pa1, pa2, pa3); MASKT(PX0, PX1, (t)); partialSM(PX0, PX1, m_reg, mnX, alX);                  \
        __syncthreads();                                                                                                      \
        if ((t) + 1 < NT) { VMW(); SWRITE_H(SB); }                                                                            \
        RESC(alX); __syncthreads(); } while (0)
    for (int t = 1; t + 1 < NT; t += 2) {
        HALF_STEP(pB0, pB1, mnB, alB, pA0, pA1, alA, t, 1, 0, 0);
        HALF_STEP(pA0, pA1, mnA, alA, pB0, pB1, alB, t + 1, 0, 1, 1);
    }
    SBAR(); qkt<1>(pB0, pB1, K_lds, r32, hi, S.qr); SBAR();
    SLOAD_H(nxt.K, nxt.V, 0); SBAR();
#pragma unroll
    for (int d0 = 0; d0 < 8; ++d0) S.qr[d0] = load8(nxt.Q + (size_t)(wid * QBLK + r32) * LDQ + d0 * 16 + hi * 8);
    SBAR();
    finishSM(pA0, pA1, alA, l_reg, pa0, pa1, pa2, pa3); SBAR();
    pv_tile<0>(o, vb0, pa0, pa1, pa2, pa3);
    MASKT(pB0, pB1, NT - 1); partialSM(pB0, pB1, m_reg, mnB, alB); __syncthreads(); RESC(alB);
    finishSM(pB0, pB1, alB, l_reg, pa0, pa1, pa2, pa3); SBAR(); pv_tile<1>(o, vb0, pa0, pa1, pa2, pa3);
    SBAR(); SEAM_K0();
    if (hi == 0) li_l[r32] = l_reg; asm volatile("s_waitcnt lgkmcnt(0)" ::: "memory");
    float rli[16];
#pragma unroll
    for (int r = 0; r < 16; ++r) rli[r] = __builtin_amdgcn_rcpf(li_l[crow(r, hi)]);
    float* Ow = cur.O + (size_t)(wid * QBLK) * LDO;
#pragma unroll
    for (int r = 0; r < 16; ++r) { const int orow = crow(r, hi);
#pragma unroll
        for (int d0 = 0; d0 < 4; ++d0) Ow[(size_t)orow * LDO + d0 * 32 + r32] = o[d0][r] * rli[r]; }
    __syncthreads();
#undef RESC
#undef KBASE
#undef MASKT
#undef SEAM_K0
#undef HALF_STEP
}
#undef ROW
#undef VMW
#undef VMWN
#undef SLOAD_H
#undef SWRITE_HK
#undef SWRITE_HV
#undef SWRITE_H
#undef KSWZ
#undef SBAR
}
#define XB_TMO      128
#define XB_XCNT(j)  (256  + 64 * (j))
#define XB_XSUB(j)  (1280 + 64 * (j))
#define XB_XGEN(j)  (2304 + 64 * (j))
#define XB_TOP      3328
#define XB_TOPGEN   3392
#define XCD_BAR_WORDS 3456
#define XB_SPIN_CAP (1u << 18)

__device__ __forceinline__ unsigned xb_ld(unsigned* p)              { return __hip_atomic_load(p, __ATOMIC_RELAXED, __HIP_MEMORY_SCOPE_AGENT); }
__device__ __forceinline__ unsigned xb_add(unsigned* p, unsigned v) { return __hip_atomic_fetch_add(p, v, __ATOMIC_RELAXED, __HIP_MEMORY_SCOPE_AGENT); }
__device__ __forceinline__ unsigned xb_xcc_id() { return (unsigned)__builtin_amdgcn_s_getreg((3 << 11) | 20) & 0xFu; }
#define XB_SPIN(cond, bar) do { unsigned _sp = 0; while (cond) { __builtin_amdgcn_s_sleep(1); \
    if ((++_sp & 255u) == 0u) { if (xb_ld(&(bar)[XB_TMO])) break; if (_sp > XB_SPIN_CAP) { atomicAdd(&(bar)[XB_TMO], 1u); break; } } } } while (0)

struct XcdBarrier {
    unsigned* bar; unsigned x;
    volatile LAS unsigned* st;
};

__device__ __forceinline__ XcdBarrier xcd_barrier_post(unsigned* bar, volatile LAS unsigned* st) {
    XcdBarrier b; b.bar = bar; b.x = xb_xcc_id(); b.st = st;
    if (threadIdx.x == 0) (void)xb_add(&bar[XB_XCNT(b.x)], 1u);
    return b;
}
__device__ __forceinline__ void xcd_barrier_complete(unsigned* bar, unsigned x, unsigned& nloc, unsigned& nx) {
    const unsigned G = gridDim.x * gridDim.y * gridDim.z;
    unsigned sum, cnt, mine, sp = 0u;
    for (;;) {
        sum = 0u; cnt = 0u; mine = 0u;
#pragma unroll
        for (unsigned j = 0; j < 16; ++j) { const unsigned c = xb_ld(&bar[XB_XCNT(j)]); sum += c; cnt += (c > 0u) ? 1u : 0u; mine = (j == x) ? c : mine; }
        if (sum == G) break;
        __builtin_amdgcn_s_sleep(1);
        if ((++sp & 255u) == 0u) { if (xb_ld(&bar[XB_TMO])) break; if (sp > XB_SPIN_CAP) { atomicAdd(&bar[XB_TMO], 1u); break; } }
    }
    nloc = mine > 0u ? mine : 1u; nx = cnt > 0u ? cnt : 1u;
}

__device__ __forceinline__ void xcd_barrier(const XcdBarrier& b) {
    asm volatile("s_waitcnt vmcnt(0)" ::: "memory");
    __syncthreads();
    if (threadIdx.x == 0) {
        unsigned* bar = b.bar;
        __builtin_amdgcn_s_waitcnt(0);
        unsigned nloc = b.st[0], nx = b.st[1];
        if (nloc == 0u) { xcd_barrier_complete(bar, b.x, nloc, nx); b.st[0] = nloc; b.st[1] = nx; }
        const unsigned old = xb_add(&bar[XB_XSUB(b.x)], 1u);
        const unsigned gen = old / nloc;
        if (old + 1u == (gen + 1u) * nloc) {
            __builtin_amdgcn_fence(__ATOMIC_RELEASE, "agent");
            asm volatile("s_waitcnt vmcnt(0)" ::: "memory");
            const unsigned og = xb_add(&bar[XB_TOP], 1u);
            const unsigned tg = og / nx;
            if (og + 1u == (tg + 1u) * nx) xb_add(&bar[XB_TOPGEN], 1u);
            else XB_SPIN(xb_ld(&bar[XB_TOPGEN]) == tg, bar);
            __builtin_amdgcn_fence(__ATOMIC_ACQUIRE, "agent");
            xb_add(&bar[XB_XGEN(b.x)], 1u);
            asm volatile("s_waitcnt vmcnt(0)" ::: "memory");
        } else {
            XB_SPIN(xb_ld(&bar[XB_XGEN(b.x)]) == gen, bar);
            __builtin_amdgcn_fence(__ATOMIC_ACQUIRE, "agent");
            asm volatile("s_waitcnt vmcnt(0)" ::: "memory");
        }
    }
    __syncthreads();
}
constexpr size_t MiB = 1u << 20;
constexpr size_t WS_CTL = 0, CTL_ZERO_BYTES = 1 * MiB;
constexpr size_t WS_WTIN = 2 * MiB;
constexpr size_t WS_WTOUT = WS_WTIN + (size_t)DEPTH * NPAD * DM * 2;
constexpr size_t WS_WUVT = WS_WTOUT + (size_t)DEPTH * DM * DM * 2;
constexpr size_t WS_XB = WS_WUVT + 2 * MiB;
constexpr size_t WS_XF = WS_XB + (size_t)SEQ * DM * 2;
constexpr size_t WS_H = WS_XF + (size_t)SEQ * DM * 4;
constexpr size_t WS_O = WS_H + (size_t)SEQ * NPAD * 2;
constexpr size_t WS_CN = WS_O + (size_t)SEQ * DM * 2;
constexpr size_t WS_IKN = WS_CN + (size_t)SEQ * 256 * 2;
constexpr size_t WS_KDT = WS_IKN + (size_t)SEQ * 64 * 2;
constexpr size_t WS_DEC = WS_KDT + (size_t)NCHUNK * 1024 * 64 * 2;
constexpr size_t WS_VT = WS_DEC + (size_t)NCHUNK * 1024 * 4;
constexpr size_t WS_OA = WS_VT + (size_t)NCHUNK * 2048 * 64 * 2;
constexpr size_t WS_OD = WS_OA + (size_t)SEQ * 2048 * 4;
constexpr size_t WS_END = WS_OD + (size_t)SEQ * 2048 * 4;
constexpr int CW_TMO = 0;
constexpr int CW_BAR = 4096, BAR_STRIDE = 4096;
constexpr int CW_Q = 200000;
static_assert((CW_Q + 64 * 16 + 64) * 4 <= (int)CTL_ZERO_BYTES && CW_BAR + 32 * BAR_STRIDE <= CW_Q, "CTL map");
constexpr int NWAVES = 8;
constexpr int WREG = 18432;
constexpr int MISC_OFF = NWAVES * WREG;
constexpr int LDS_BYTES = MISC_OFF + 512;
static_assert(pg8::STAGE_BYTES <= MISC_OFF && dattn::LDS_BYTES <= MISC_OFF, "LDS map");

#define LDS_WAIT() asm volatile("s_waitcnt lgkmcnt(0)" ::: "memory")
#define VM_WAIT() asm volatile("s_waitcnt vmcnt(0)" ::: "memory")
typedef __bf16 bf16x2v __attribute__((ext_vector_type(2)));
typedef float f32x2 __attribute__((ext_vector_type(2)));
__device__ __forceinline__ unsigned cvtpk_c(float lo, float hi) { f32x2 v = {lo, hi}; bf16x2v b = __builtin_convertvector(v, bf16x2v); return __builtin_bit_cast(unsigned, b); }
__device__ __forceinline__ float bf2f(unsigned b) { return __uint_as_float(b << 16); }
__device__ __forceinline__ float bflo(unsigned w) { return __uint_as_float(w << 16); }
__device__ __forceinline__ float bfhi(unsigned w) { return __uint_as_float(w & 0xffff0000u); }
__device__ __forceinline__ bf16x8 pack8f(float a0, float a1, float a2, float a3, float a4, float a5, float a6, float a7) {
    u32x4 w = {cvtpk_c(a0, a1), cvtpk_c(a2, a3), cvtpk_c(a4, a5), cvtpk_c(a6, a7)}; return __builtin_bit_cast(bf16x8, w); }
__device__ __forceinline__ float bperm_f(int src_lane, float v) { return __int_as_float(__builtin_amdgcn_ds_bpermute(src_lane << 2, __float_as_int(v))); }
__device__ __forceinline__ float xmax16(float x) { const auto r = __builtin_amdgcn_permlane16_swap(__float_as_uint(x), __float_as_uint(x), false, false); return fmaxf(__uint_as_float(r[0]), __uint_as_float(r[1])); }
__device__ __forceinline__ float xmax32(float x) { const auto r = __builtin_amdgcn_permlane32_swap(__float_as_uint(x), __float_as_uint(x), false, false); return fmaxf(__uint_as_float(r[0]), __uint_as_float(r[1])); }
__device__ __forceinline__ float xsum16(float x) { const auto r = __builtin_amdgcn_permlane16_swap(__float_as_uint(x), __float_as_uint(x), false, false); return __uint_as_float(r[0]) + __uint_as_float(r[1]); }
__device__ __forceinline__ float xsum32(float x) { const auto r = __builtin_amdgcn_permlane32_swap(__float_as_uint(x), __float_as_uint(x), false, false); return __uint_as_float(r[0]) + __uint_as_float(r[1]); }
__device__ __forceinline__ float wave_sum(float v) {
    const int ln = hw_lane();
#pragma unroll
    for (int o = 1; o < 64; o <<= 1) v += bperm_f(ln ^ o, v);
    return v;
}
__device__ __forceinline__ void wave_sum2(float& a, float& b) {
    const int ln = hw_lane();
#pragma unroll
    for (int o = 1; o < 64; o <<= 1) { const float ta = bperm_f(ln ^ o, a), tb = bperm_f(ln ^ o, b); a += ta; b += tb; }
}
__device__ __forceinline__ float silu(float x) { return x / (1.f + __expf(-x)); }
#define MFMA16(a, b, c) __builtin_amdgcn_mfma_f32_16x16x32_bf16((a), (b), (c), 0, 0, 0)
#define MFMA32(a, b, c) __builtin_amdgcn_mfma_f32_32x32x16_bf16((a), (b), (c), 0, 0, 0)

struct Frame {
    LAS unsigned char* lds;
    volatile LAS unsigned* MISC;
    gu32* ctl;
    unsigned char* ws;
    int wave, vcu, G;
};
#define B_WTIN(F)  ((bf16_t*)((F).ws + WS_WTIN))
#define B_WTOUT(F) ((bf16_t*)((F).ws + WS_WTOUT))
#define B_WUVT(F)  ((bf16_t*)((F).ws + WS_WUVT))
#define B_XB(F)    ((bf16_t*)((F).ws + WS_XB))
#define B_XF(F)    ((float*)((F).ws + WS_XF))
#define B_H(F)     ((bf16_t*)((F).ws + WS_H))
#define B_O(F)     ((bf16_t*)((F).ws + WS_O))
#define B_CN(F)    ((bf16_t*)((F).ws + WS_CN))
#define B_IKN(F)   ((bf16_t*)((F).ws + WS_IKN))
#define B_KDT(F)   ((bf16_t*)((F).ws + WS_KDT))
#define B_DEC(F)   ((float*)((F).ws + WS_DEC))
#define B_VT(F)    ((bf16_t*)((F).ws + WS_VT))
#define B_OA(F)    ((float*)((F).ws + WS_OA))
#define B_OD(F)    ((float*)((F).ws + WS_OD))
__device__ __forceinline__ int grab(Frame& F, int qidx) {
    if ((F.wave * 64 + hw_lane()) == 0) F.MISC[2] = __hip_atomic_fetch_add((unsigned*)(F.ctl + CW_Q + 64 * qidx), 1u, __ATOMIC_RELAXED, __HIP_MEMORY_SCOPE_AGENT);
    __syncthreads(); const int v = (int)F.MISC[2]; __syncthreads(); return v;
}
template <bool REMAP>
__device__ __forceinline__ void tr_item(const float* W, int K, int ldw, bf16_t* WT, int nblk, LAS float* scr, int item, int lane) {
    const int kb = item / nblk, nb = item - kb * nblk, k0 = 64 * kb, n0 = 32 * nb;
    const int q = lane & 7, r = lane >> 3;
    const int sc = REMAP ? srccol(n0 + 4 * q) : n0 + 4 * q;
    f32x4 v[8];
#pragma unroll
    for (int i = 0; i < 8; ++i) v[i] = sc >= 0 ? *(const f32x4*)(W + (size_t)(k0 + 8 * i + r) * ldw + sc) : (f32x4){0.f, 0.f, 0.f, 0.f};
#pragma unroll
    for (int i = 0; i < 8; ++i) { LAS float* d = scr + (8 * i + r) * 33 + 4 * q; d[0] = v[i][0]; d[1] = v[i][1]; d[2] = v[i][2]; d[3] = v[i][3]; }
    LDS_WAIT();
    const int c = lane & 7;
#pragma unroll
    for (int j = 0; j < 4; ++j) { const int nn = (lane >> 3) + 8 * j; const LAS float* s = scr + (8 * c) * 33 + nn;
        u32x4 o; o.x = cvtpk_c(s[0 * 33], s[1 * 33]); o.y = cvtpk_c(s[2 * 33], s[3 * 33]); o.z = cvtpk_c(s[4 * 33], s[5 * 33]); o.w = cvtpk_c(s[6 * 33], s[7 * 33]);
        *(u32x4*)(WT + (size_t)(n0 + nn) * K + k0 + 8 * c) = o; }
    LDS_WAIT();
}
__device__ __forceinline__ void p0_prologue(Frame& F, const float* x_in, const float* w_in, const float* w_out, const float* w_uv) {
    LAS float* scr = (LAS float*)(F.lds + F.wave * 16384);
    const int gw = F.vcu * NWAVES + F.wave, NGW = F.G * NWAVES;
    constexpr int I_IN = (DM / 64) * (NPAD / 32), I_OUT = (DM / 64) * (DM / 32), I_UV = (256 / 64) * (128 / 32);
    constexpr int N_IN = DEPTH * I_IN, N_OUT = DEPTH * I_OUT, N_UV = DEPTH * 8 * I_UV;
    for (int it = gw; it < N_IN + N_OUT + N_UV; it += NGW) {
        int r = it;
        if (r < N_IN) { const int l = r / I_IN; r -= l * I_IN;
            tr_item<true>(w_in + (size_t)l * DM * NIN, DM, NIN, B_WTIN(F) + (size_t)l * NPAD * DM, NPAD / 32, scr, r, hw_lane()); continue; }
        r -= N_IN;
        if (r < N_OUT) { const int l = r / I_OUT; r -= l * I_OUT;
            tr_item<false>(w_out + (size_t)l * DM * DM, DM, DM, B_WTOUT(F) + (size_t)l * DM * DM, DM / 32, scr, r, hw_lane()); continue; }
        r -= N_OUT;
        { const int lh = r / I_UV; r -= lh * I_UV;
          tr_item<false>(w_uv + (size_t)lh * 256 * 128, 256, 128, B_WUVT(F) + (size_t)lh * 128 * 256, 128 / 32, scr, r, hw_lane()); }
    }
    const f32x4* xs = (const f32x4*)x_in;
    for (size_t i = (size_t)gw * 64 + hw_lane(); i < (size_t)SEQ * DM / 8; i += (size_t)NGW * 64) {
        const f32x4 a = xs[2 * i], b = xs[2 * i + 1];
        u32x4 o = {cvtpk_c(a[0], a[1]), cvtpk_c(a[2], a[3]), cvtpk_c(b[0], b[1]), cvtpk_c(b[2], b[3])};
        *(u32x4*)(B_XB(F) + 8 * i) = o;
    }
}

__device__ __forceinline__ void prep_phase(Frame& F, int l, const float* w_gate2, const float* b_gate, const float* kv_g, const float* ik_g, const float* ik_b) {
    int lane_ = hw_lane(); asm volatile("" : "+v"(lane_));
    const int gw = F.vcu * NWAVES + F.wave, NGW = F.G * NWAVES, lane = lane_;
    const bf16_t* H = B_H(F);
    {
        const float* kvg = kv_g + l * 256; const float* ikg = ik_g + l * 64; const float* ikb = ik_b + l * 64;
        const f32x4 g4 = *(const f32x4*)(kvg + 4 * lane); const float g1 = ikg[lane], b1 = ikb[lane];
        for (int t0 = gw; t0 < SEQ; t0 += 2 * NGW) {
            float v[2][4], x[2], ss[2];
#pragma unroll
            for (int k = 0; k < 2; ++k) { const bf16_t* hr = H + (size_t)(t0 + k * NGW) * NPAD;
                const u32x2 raw = *(const u32x2*)(hr + C_CKV + 4 * lane);
                v[k][0] = bflo(raw.x); v[k][1] = bfhi(raw.x); v[k][2] = bflo(raw.y); v[k][3] = bfhi(raw.y);
                x[k] = bf2f(hr[C_CIK + lane]);
                ss[k] = (v[k][0] * v[k][0] + v[k][1] * v[k][1]) + (v[k][2] * v[k][2] + v[k][3] * v[k][3]); }
            float mu[2] = {x[0], x[1]};
            wave_sum2(ss[0], ss[1]); wave_sum2(mu[0], mu[1]);
            float dv[2], var[2];
#pragma unroll
            for (int k = 0; k < 2; ++k) { dv[k] = x[k] - mu[k] * (1.f / 64.f); var[k] = dv[k] * dv[k]; }
            wave_sum2(var[0], var[1]);
#pragma unroll
            for (int k = 0; k < 2; ++k) { const int t = t0 + k * NGW;
                const float rs = rsqrtf(ss[k] * (1.f / 256.f) + 1e-6f);
                u32x2 o; o.x = cvtpk_c(v[k][0] * rs * g4[0], v[k][1] * rs * g4[1]); o.y = cvtpk_c(v[k][2] * rs * g4[2], v[k][3] * rs * g4[3]);
                *(u32x2*)(B_CN(F) + (size_t)t * 256 + 4 * lane) = o;
                const float y = dv[k] * rsqrtf(var[k] * (1.f / 64.f) + 1e-5f) * g1 + b1;
                B_IKN(F)[(size_t)t * 64 + lane] = (bf16_t)(cvtpk_c(y, 0.f) & 0xffffu); }
        }
    }
    {
        LAS float* aas = (LAS float*)(F.lds + F.wave * 16384);
        const float* W2 = w_gate2 + (size_t)l * 16 * 1024; const float* BG = b_gate + (size_t)l * 1024;
        for (int u = gw; u < NCHUNK * 16; u += NGW) {
            const int c = u >> 4, dk = (u & 15) * 64 + lane;
            { const bf16_t* ap = H + (size_t)(64 * c + lane) * NPAD + C_AA;
              const bf16x8 a0 = *(const bf16x8*)ap, a1 = *(const bf16x8*)(ap + 8);
#pragma unroll
              for (int j = 0; j < 8; ++j) { aas[lane * 16 + j] = bf2f((unsigned short)a0[j]); aas[lane * 16 + 8 + j] = bf2f((unsigned short)a1[j]); } }
            float w2[16];
#pragma unroll
            for (int r = 0; r < 16; ++r) w2[r] = W2[r * 1024 + dk];
            const float bgv = BG[dk];
            unsigned short kq[64];
#pragma unroll
            for (int t = 0; t < 64; ++t) kq[t] = H[(size_t)(64 * c + t) * NPAD + C_AK + dk];
            LDS_WAIT();
            float la[64]; float total = 0.f;
#pragma unroll
            for (int t = 0; t < 64; ++t) {
                float z = bgv;
#pragma unroll
                for (int r = 0; r < 16; ++r) z += aas[t * 16 + r] * w2[r];
                la[t] = (fminf(z, 0.f) - __logf(1.f + __expf(-fabsf(z)))) * (1.f / 16.f);
                total += la[t];
            }
            B_DEC(F)[(size_t)c * 1024 + dk] = __expf(total);
            float run = 0.f;
#pragma unroll
            for (int t8 = 0; t8 < 8; ++t8) {
                float kd[8];
#pragma unroll
                for (int j = 0; j < 8; ++j) { const int t = 8 * t8 + j;
                    run += la[t];
                    kd[j] = bf2f(kq[t]) * __expf(total - run); }
                *(bf16x8*)(B_KDT(F) + ((size_t)c * 1024 + dk) * 64 + 8 * t8) = pack8f(kd[0], kd[1], kd[2], kd[3], kd[4], kd[5], kd[6], kd[7]);
            }
            LDS_WAIT();
        }
    }
    for (int u = gw; u < NCHUNK * 16; u += NGW) {
        const int c = u >> 4, dv = (u & 15) * 128 + 2 * lane;
        unsigned w[64];
#pragma unroll
        for (int t = 0; t < 64; ++t) w[t] = *(const unsigned*)(H + (size_t)(64 * c + t) * NPAD + C_AV + dv);
#pragma unroll
        for (int t8 = 0; t8 < 8; ++t8) {
            const unsigned* x = w + 8 * t8;
            u32x4 lo = {(x[0] & 0xffffu) | (x[1] << 16), (x[2] & 0xffffu) | (x[3] << 16), (x[4] & 0xffffu) | (x[5] << 16), (x[6] & 0xffffu) | (x[7] << 16)};
            u32x4 hi = {(x[0] >> 16) | (x[1] & 0xffff0000u), (x[2] >> 16) | (x[3] & 0xffff0000u), (x[4] >> 16) | (x[5] & 0xffff0000u), (x[6] >> 16) | (x[7] & 0xffff0000u)};
            *(u32x4*)(B_VT(F) + ((size_t)c * 2048 + dv) * 64 + 8 * t8) = lo;
            *(u32x4*)(B_VT(F) + ((size_t)c * 2048 + dv + 1) * 64 + 8 * t8) = hi;
        }
    }
}

__device__ __forceinline__ void post_phase(Frame& F, int l, float lam_init, const float* gla_g, const float* dlam, const float* diff_g) {
    int lane_ = hw_lane(); asm volatile("" : "+v"(lane_));
    const int gw = F.vcu * NWAVES + F.wave, NGW = F.G * NWAVES, lane = lane_;
    float lam;
    { const float* lp = dlam + (size_t)l * 512;
      const float p0 = lp[lane] * lp[128 + lane] + lp[64 + lane] * lp[192 + lane];
      const float p1 = lp[256 + lane] * lp[384 + lane] + lp[320 + lane] * lp[448 + lane];
      lam = expf(wave_sum(p0)) - expf(wave_sum(p1)) + lam_init; }
    { const float* g = gla_g + (size_t)l * 512;
      const f32x4 ga = *(const f32x4*)(g + 8 * lane), gb = *(const f32x4*)(g + 8 * lane + 4);
      for (int u0 = gw; u0 < SEQ * 4; u0 += 2 * NGW) {
          f32x4 a[2], b[2]; u32x4 gr[2]; float ss[2];
#pragma unroll
          for (int k = 0; k < 2; ++k) { const int u = u0 + k * NGW, t = u >> 2, hd = u & 3;
              const float* src = B_OA(F) + (size_t)t * 2048 + hd * 512 + 8 * lane;
              a[k] = *(const f32x4*)src; b[k] = *(const f32x4*)(src + 4);
              gr[k] = *(const u32x4*)(B_H(F) + (size_t)t * NPAD + C_AG + hd * 512 + 8 * lane);
              ss[k] = (a[k][0] * a[k][0] + a[k][1] * a[k][1]) + (a[k][2] * a[k][2] + a[k][3] * a[k][3]) + (b[k][0] * b[k][0] + b[k][1] * b[k][1]) + (b[k][2] * b[k][2] + b[k][3] * b[k][3]); }
          wave_sum2(ss[0], ss[1]);
#pragma unroll
          for (int k = 0; k < 2; ++k) { const int u = u0 + k * NGW, t = u >> 2, hd = u & 3;
              const float rs = rsqrtf(ss[k] * (1.f / 512.f) + 1e-6f);
              u32x4 o;
              o.x = cvtpk_c(a[k][0] * rs * ga[0] * silu(bflo(gr[k].x)), a[k][1] * rs * ga[1] * silu(bfhi(gr[k].x)));
              o.y = cvtpk_c(a[k][2] * rs * ga[2] * silu(bflo(gr[k].y)), a[k][3] * rs * ga[3] * silu(bfhi(gr[k].y)));
              o.z = cvtpk_c(b[k][0] * rs * gb[0] * silu(bflo(gr[k].z)), b[k][1] * rs * gb[1] * silu(bfhi(gr[k].z)));
              o.w = cvtpk_c(b[k][2] * rs * gb[2] * silu(bflo(gr[k].w)), b[k][3] * rs * gb[3] * silu(bfhi(gr[k].w)));
              *(u32x4*)(B_O(F) + (size_t)t * DM + hd * 512 + 8 * lane) = o; }
      } }
    { const float* g = diff_g + (size_t)l * 256;
      const f32x4 g4 = *(const f32x4*)(g + 4 * lane); const float post = 1.f - lam_init;
      for (int u0 = gw; u0 < SEQ * 4; u0 += 2 * NGW) {
          f32x4 d[2]; u32x2 gr[2]; float ss[2];
#pragma unroll
          for (int k = 0; k < 2; ++k) { const int u = u0 + k * NGW, t = u >> 2, hd = u & 3;
              const float* src = B_OD(F) + (size_t)t * 2048 + hd * 512 + 4 * lane;
              const f32x4 a0 = *(const f32x4*)src, a1 = *(const f32x4*)(src + 256);
              gr[k] = *(const u32x2*)(B_H(F) + (size_t)t * NPAD + C_BG + hd * 256 + 4 * lane);
              d[k] = a0 - a1 * lam;
              ss[k] = (d[k][0] * d[k][0] + d[k][1] * d[k][1]) + (d[k][2] * d[k][2] + d[k][3] * d[k][3]); }
          wave_sum2(ss[0], ss[1]);
#pragma unroll
          for (int k = 0; k < 2; ++k) { const int u = u0 + k * NGW, t = u >> 2, hd = u & 3;
              const float rs = rsqrtf(ss[k] * (1.f / 256.f) + 1e-6f) * post;
              u32x2 o;
              o.x = cvtpk_c(d[k][0] * rs * g4[0] * silu(bflo(gr[k].x)), d[k][1] * rs * g4[1] * silu(bfhi(gr[k].x)));
              o.y = cvtpk_c(d[k][2] * rs * g4[2] * silu(bflo(gr[k].y)), d[k][3] * rs * g4[3] * silu(bfhi(gr[k].y)));
              *(u32x2*)(B_O(F) + (size_t)t * DM + 2048 + hd * 256 + 4 * lane) = o; }
      } }
}

__device__ __forceinline__ void ln_phase(Frame& F, int l, const float* ln_g, const float* ln_b, float* outp, bool dry) {
    int lane_ = hw_lane(); asm volatile("" : "+v"(lane_));
    const int gw = F.vcu * NWAVES + F.wave, NGW = F.G * NWAVES, lane = lane_;
    const float* g = ln_g + (size_t)l * DM; const float* b = ln_b + (size_t)l * DM;
    float* dst = dry ? B_OA(F) : ((l == DEPTH - 1) ? outp : B_XF(F));
    for (int t = gw; t < SEQ; t += NGW) {
        const f32x4* xr = (const f32x4*)(B_XF(F) + (size_t)t * DM) + lane;
        f32x4 v[16]; float s = 0.f;
#pragma unroll
        for (int j = 0; j < 16; ++j) { v[j] = xr[64 * j]; s += (v[j][0] + v[j][1]) + (v[j][2] + v[j][3]); }
        const float mean = wave_sum(s) * (1.f / DM); float s2 = 0.f;
#pragma unroll
        for (int j = 0; j < 16; ++j) { v[j] = v[j] - mean; s2 += (v[j][0] * v[j][0] + v[j][1] * v[j][1]) + (v[j][2] * v[j][2] + v[j][3] * v[j][3]); }
        const float rstd = rsqrtf(wave_sum(s2) * (1.f / DM) + 1e-5f);
        f32x4* orow = (f32x4*)(dst + (size_t)t * DM) + lane;
        u32x2* brow = (u32x2*)(B_XB(F) + (size_t)t * DM) + lane;
#pragma unroll
        for (int j = 0; j < 16; ++j) {
            const f32x4 gg = *((const f32x4*)g + lane + 64 * j), bb = *((const f32x4*)b + lane + 64 * j);
            const f32x4 y = v[j] * rstd * gg + bb;
            orow[64 * j] = y;
            u32x2 w; w.x = cvtpk_c(y[0], y[1]); w.y = cvtpk_c(y[2], y[3]); brow[64 * j] = w;
        }
    }
}
namespace gla {
constexpr int KD_ROW = 144, Q_ROW = 528, V_ROW = 144;
constexpr int L_KD = 0, L_Q = L_KD + 256 * KD_ROW, L_V = L_Q + 64 * Q_ROW, L_DEC = L_V + 128 * V_ROW, L_END = L_DEC + 1024;
}
static_assert(gla::L_END <= MISC_OFF, "GLA LDS map");
__device__ __forceinline__ void gla_unit(Frame& F, int unit) {
    using namespace gla;
    int tid_ = (F.wave * 64 + hw_lane()); asm volatile("" : "+v"(tid_));
    const int tid = tid_, lane = tid & 63, c16 = lane & 15, g = lane >> 4, wave = F.wave;
    const int head = unit >> 2, blk = unit & 3;
    const int dv0 = 128 * blk + 16 * wave;
    LAS unsigned char* lds = F.lds;
    f32x4 S[16];
#pragma unroll
    for (int T = 0; T < 16; ++T) S[T] = (f32x4){0.f, 0.f, 0.f, 0.f};
    const bf16_t* kd_g = B_KDT(F) + (size_t)head * 256 * 64 + (size_t)tid * 8;
    const bf16_t* q_g = B_H(F) + (size_t)(tid >> 5) * NPAD + C_AQ + head * 256 + (tid & 31) * 8;
    const bf16_t* v_g = B_VT(F) + ((size_t)head * 512 + 128 * blk) * 64 + (size_t)tid * 8;
    const float* d_g = B_DEC(F) + head * 256 + (tid & 63) * 4;
    const int kd_w = (tid >> 3) * KD_ROW + (tid & 7) * 16;
    const int q_w = (tid >> 5) * Q_ROW + (tid & 31) * 16;
    const int v_w = (tid >> 3) * V_ROW + (tid & 7) * 16;
    u32x4 skd[4], sq[4], sv[2]; f32x4 sd;
#define GLA_LOAD(c_) do { _Pragma("unroll") for (int i = 0; i < 4; ++i) skd[i] = *(const u32x4*)(kd_g + (size_t)(c_) * 1024 * 64 + i * 4096); \
        _Pragma("unroll") for (int i = 0; i < 4; ++i) sq[i] = *(const u32x4*)(q_g + (size_t)(64 * (c_) + 16 * i) * NPAD);                        \
        _Pragma("unroll") for (int i = 0; i < 2; ++i) sv[i] = *(const u32x4*)(v_g + (size_t)(c_) * 2048 * 64 + i * 4096);                        \
        if (tid < 64) sd = *(const f32x4*)(d_g + (size_t)(c_) * 1024); } while (0)
#define GLA_WRITE() do { _Pragma("unroll") for (int i = 0; i < 4; ++i) *(LAS u32x4*)(lds + L_KD + kd_w + i * 64 * KD_ROW) = skd[i];            \
        _Pragma("unroll") for (int i = 0; i < 4; ++i) *(LAS u32x4*)(lds + L_Q + q_w + i * 16 * Q_ROW) = sq[i];                                   \
        _Pragma("unroll") for (int i = 0; i < 2; ++i) *(LAS u32x4*)(lds + L_V + v_w + i * 64 * V_ROW) = sv[i];                                   \
        if (tid < 64) *(LAS f32x4*)(lds + L_DEC + tid * 16) = sd; } while (0)
    const int a_rd = L_KD + c16 * KD_ROW + 16 * g;
    const int b_rd = L_V + (16 * wave + c16) * V_ROW + 16 * g;
    const int q_rd = L_Q + c16 * Q_ROW + 8 * g;
    const int d_rd = L_DEC + 16 * g;
    float* o_l = B_OA(F) + (size_t)(4 * g) * 2048 + head * 512 + dv0 + c16;
    GLA_LOAD(0);
    __syncthreads();
    GLA_WRITE();
    for (int c = 0; c < NCHUNK; ++c) {
        __syncthreads();
        if (c + 1 < NCHUNK) GLA_LOAD(c + 1);
        const bf16x8 vb0 = *(const LAS bf16x8*)(lds + b_rd), vb1 = *(const LAS bf16x8*)(lds + b_rd + 64);
#pragma unroll
        for (int T4 = 0; T4 < 4; ++T4) {
            bf16x8 a[4][2]; f32x4 d4[4];
#pragma unroll
            for (int i = 0; i < 4; ++i) { const int T = 4 * T4 + i;
                a[i][0] = *(const LAS bf16x8*)(lds + a_rd + T * 16 * KD_ROW); a[i][1] = *(const LAS bf16x8*)(lds + a_rd + T * 16 * KD_ROW + 64);
                d4[i] = *(const LAS f32x4*)(lds + d_rd + 64 * T); }
#pragma unroll
            for (int i = 0; i < 4; ++i) { const int T = 4 * T4 + i;
                f32x4 acc = (f32x4){0.f, 0.f, 0.f, 0.f};
                acc = MFMA16(a[i][0], vb0, acc); acc = MFMA16(a[i][1], vb1, acc);
                S[T] = S[T] * d4[i] + acc; }
        }
        bf16x8 sb[8];
#pragma unroll
        for (int s = 0; s < 8; ++s) sb[s] = pack8f(S[2 * s][0], S[2 * s][1], S[2 * s][2], S[2 * s][3], S[2 * s + 1][0], S[2 * s + 1][1], S[2 * s + 1][2], S[2 * s + 1][3]);
#pragma unroll
        for (int tt = 0; tt < 4; ++tt) {
            u32x2 ql[8], qh[8];
#pragma unroll
            for (int s = 0; s < 8; ++s) { ql[s] = *(const LAS u32x2*)(lds + q_rd + tt * 16 * Q_ROW + 64 * s); qh[s] = *(const LAS u32x2*)(lds + q_rd + tt * 16 * Q_ROW + 64 * s + 32); }
            f32x4 acc = (f32x4){0.f, 0.f, 0.f, 0.f};
#pragma unroll
            for (int s = 0; s < 8; ++s) { const u32x4 aw = {ql[s].x, ql[s].y, qh[s].x, qh[s].y}; acc = MFMA16(__builtin_bit_cast(bf16x8, aw), sb[s], acc); }
            float* op = o_l + (size_t)(64 * c + 16 * tt) * 2048;
#pragma unroll
            for (int r = 0; r < 4; ++r) op[(size_t)r * 2048] = acc[r] * 0.0625f;
        }
        __syncthreads();
        if (c + 1 < NCHUNK) GLA_WRITE();
    }
#undef GLA_LOAD
#undef GLA_WRITE
}
__device__ __forceinline__ unsigned f2key(float s) { const unsigned b = __float_as_uint(s); return b ^ ((b >> 31) ? 0xFFFFFFFFu : 0x80000000u); }
__device__ __forceinline__ unsigned half_of(unsigned long long b, int hh) { return hh ? (unsigned)(b >> 32) : (unsigned)b; }
#define SP_DPP(v_, ctrl_, rm_, bc_) ((unsigned)__builtin_amdgcn_update_dpp(0, (int)(v_), (ctrl_), (rm_), 0xF, (bc_)))
__device__ __forceinline__ unsigned hsum32(unsigned v) {
    v += SP_DPP(v, 0xB1, 0xF, true); v += SP_DPP(v, 0x4E, 0xF, true); v += SP_DPP(v, 0x141, 0xF, true); v += SP_DPP(v, 0x140, 0xF, true);
    const auto r = __builtin_amdgcn_permlane16_swap(v, v, false, false); return r[0] + r[1]; }
__device__ __forceinline__ unsigned hmax32(unsigned v) {
    unsigned t;
    t = SP_DPP(v, 0xB1, 0xF, true); v = v > t ? v : t; t = SP_DPP(v, 0x4E, 0xF, true); v = v > t ? v : t;
    t = SP_DPP(v, 0x141, 0xF, true); v = v > t ? v : t; t = SP_DPP(v, 0x140, 0xF, true); v = v > t ? v : t;
    const auto r = __builtin_amdgcn_permlane16_swap(v, v, false, false); return r[0] > r[1] ? r[0] : r[1]; }
__device__ __forceinline__ unsigned hscan32(unsigned v) {
    v += SP_DPP(v, 0x111, 0xF, true); v += SP_DPP(v, 0x112, 0xF, true); v += SP_DPP(v, 0x114, 0xF, true); v += SP_DPP(v, 0x118, 0xF, true);
    v += SP_DPP(v, 0x142, 0xA, false);
    return v; }
template <int EPL, int NB>
__device__ __forceinline__ void compactK(LAS unsigned* cv, int& cnt, unsigned& thr, int lane32, int hh) {
    unsigned k[EPL];
#pragma unroll
    for (int i = 0; i < EPL; ++i) { const int e = lane32 + 32 * i; const unsigned v = cv[e]; k[i] = (e < cnt) ? v : 0u; }
    unsigned M = 0u;
#pragma unroll
    for (int i = 0; i < EPL; ++i) M = k[i] > M ? k[i] : M;
    M = hmax32(M);
    const bool big = cnt >= 256;
    const unsigned x = M ^ thr;
    const int hb = (big && x) ? 31 - __clz(x) : -1;
    const int h0 = __builtin_amdgcn_readlane(hb, 0), h1 = __builtin_amdgcn_readlane(hb, 32);
    const int b0 = h0 > h1 ? h0 : h1;
    unsigned T = big ? (M & ~((2u << (b0 & 31)) - 1u)) : 0u;
    for (int b = b0; b >= 32 - NB; --b) {
        const unsigned cand = T | (1u << b);
        unsigned c = 0u;
#pragma unroll
        for (int i = 0; i < EPL; ++i) c += (k[i] >= cand) ? 1u : 0u;
        c = hsum32(c);
        if (c >= 256u) T = cand;
        if (NB == 32 && __all(c == 256u)) break;
    }
    unsigned n = 0u;
#pragma unroll
    for (int i = 0; i < EPL; ++i) n += ((k[i] >= T) && (k[i] != 0u)) ? 1u : 0u;
    const unsigned inc = hscan32(n);
    unsigned pos = inc - n;
#pragma unroll
    for (int i = 0; i < EPL; ++i) { const bool keep = (k[i] >= T) && (k[i] != 0u); if (keep) cv[pos] = k[i]; pos += keep ? 1u : 0u; }
    const int t0 = __builtin_amdgcn_readlane((int)inc, 31), t1 = __builtin_amdgcn_readlane((int)inc, 63);
    cnt = hh ? t1 : t0; thr = (NB == 32) ? T : (T ? T - 1u : 0u);
}
__device__ __forceinline__ int goff(int row, int ch) { return 512 * row + 16 * ((ch & 16) | ((ch & 15) ^ (((row & 3) << 2) | (((row >> 2) & 1) << 1)))); }

#ifndef SP_REPF
#define SP_REPF 1
#endif
#ifndef SP_REPB
#define SP_REPB 1
#endif
#ifndef SP_REPK
#define SP_REPK 1
#endif
#ifndef SP_DRY
#define SP_DRY 0
#endif
#ifndef SP_REPM
#define SP_REPM 1
#endif
#ifndef SP_REPL
#define SP_REPL 1
#endif
constexpr int SP_CAND = 0, SP_OL = 65536, SP_SEL = 131072, SP_END = SP_SEL + 8192;
static_assert(SP_END <= MISC_OFF, "sparse LDS map");
__device__ __forceinline__ void sparse_unit(Frame& F, int l, int unit) {
    int tid_ = (F.wave * 64 + hw_lane()); asm volatile("" : "+v"(tid_));
    const int tid = tid_, lane = tid & 63, wave = F.wave, r32 = lane & 31, hh = lane >> 5, c16 = lane & 15, g = lane >> 4;
    const int t0 = 16 * unit, tq0 = t0 + 2 * wave;
    const int N = 64 * ((t0 >> 6) + 1), nkb = N >> 5, ntile = (nkb + 7) >> 3;
    LAS unsigned char* reg = F.lds + SP_CAND + wave * 8192;
    LAS unsigned* cv = (LAS unsigned*)(reg + hh * 4096);
    LAS unsigned short* sel = (LAS unsigned short*)(F.lds + SP_SEL + wave * 1024);
    const bf16_t* H = B_H(F);
    int cnt = 0;
    {
        const int qq = (r32 >> 2) & 1, hd = (r32 & 3) + 4 * (r32 >> 3);
        bf16x8 A[4];
#pragma unroll
        for (int s = 0; s < 4; ++s) A[s] = *(const bf16x8*)(H + (size_t)(tq0 + qq) * NPAD + C_CIQ + hd * 64 + 16 * s + 8 * hh);
        float wv[16];
        { const bf16_t* wp = H + (size_t)(tq0 + hh) * NPAD + C_CIW;
          const bf16x8 w0 = *(const bf16x8*)wp, w1 = *(const bf16x8*)(wp + 8);
#pragma unroll
          for (int j = 0; j < 8; ++j) { wv[j] = bf2f((unsigned short)w0[j]) * 0.03125f; wv[8 + j] = bf2f((unsigned short)w1[j]) * 0.03125f; } }
        unsigned thr = 0u;
        const unsigned ltm = (1u << r32) - 1u;
        const bf16_t* kg = B_IKN(F) + (size_t)tid * 8;
        const int kw = SP_OL + (tid >> 3) * 128 + (((tid & 7) ^ ((tid >> 4) & 7)) * 16);
        int brd[4];
#pragma unroll
        for (int s = 0; s < 4; ++s) brd[s] = SP_OL + r32 * 128 + (((2 * s + hh) ^ ((r32 >> 1) & 7)) * 16);
        u32x4 stg[4];
        bf16x8 B0[4], B1[4];
        f32x16 aX0 = {}, aX1 = {}, aY0 = {}, aY1 = {};
        const f32x16 zz = {};
        float sc0 = 0.f, sc1 = 0.f;
        bool squeeze_ = false;
#define SP_KLOAD(t_) do { _Pragma("unroll") for (int i = 0; i < 4; ++i) stg[i] = *(const u32x4*)(kg + (size_t)(t_) * 256 * 64 + i * 4096); } while (0)
#define SP_KWRITE(b_) do { _Pragma("unroll") for (int i = 0; i < 4; ++i) *(LAS u32x4*)(F.lds + (b_) * 32768 + kw + i * 8192) = stg[i]; } while (0)
#define SP_L(nx_) do { LAS unsigned char* tb_ = F.lds + (((nx_) >> 2) & 1) * 32768 + ((nx_) & 3) * 8192;                                        \
            _Pragma("unroll") for (int s = 0; s < 4; ++s) { B0[s] = *(const LAS bf16x8*)(tb_ + brd[s]); B1[s] = *(const LAS bf16x8*)(tb_ + brd[s] + 4096); } } while (0)
#define SP_FMAC(acc_, x_, w_) asm("v_fmac_f32 %0, %1, %2" : "+v"(acc_) : "v"(x_), "v"(w_))
#define SP_RJ(P0, P1, j) do { const int a0 = __float_as_int(P0[j]), a1 = __float_as_int(P0[(j) + 1]), b0 = __float_as_int(P1[j]), b1 = __float_as_int(P1[(j) + 1]);    \
            const float ra0 = __int_as_float(a0 > 0 ? a0 : 0), ra1 = __int_as_float(a1 > 0 ? a1 : 0), rb0 = __int_as_float(b0 > 0 ? b0 : 0), rb1 = __int_as_float(b1 > 0 ? b1 : 0); \
            SP_FMAC(s0a, ra0, wv[j]); SP_FMAC(s1a, rb0, wv[j]); SP_FMAC(s0b, ra1, wv[(j) + 1]); SP_FMAC(s1b, rb1, wv[(j) + 1]); } while (0)
#define SP_MR(N0, N1, P0, P1) do {                                                                                                               \
            float s0a = 0.f, s0b = 0.f, s1a = 0.f, s1b = 0.f;                                                                                    \
            _Pragma("unroll") for (int s = 0; s < 4; ++s) {                                                                                      \
                N0 = MFMA32(A[s], B0[s], s ? N0 : zz); __builtin_amdgcn_sched_barrier(0);                                                        \
                SP_RJ(P0, P1, 4 * s); __builtin_amdgcn_sched_barrier(0);                                                                         \
                N1 = MFMA32(A[s], B1[s], s ? N1 : zz); __builtin_amdgcn_sched_barrier(0);                                                        \
                SP_RJ(P0, P1, 4 * s + 2); __builtin_amdgcn_sched_barrier(0); }                                                                   \
            sc0 = s0a + s0b; sc1 = s1a + s1b;                                                                                                    \
            asm volatile("" : "+v"(sc0), "+v"(sc1));                                                                                             \
        } while (0)
#define SP_INS(pk_) do {                                                                                                                         \
            if (squeeze_ || __any(cnt > 960)) { squeeze_ = false;                                                                                \
                for (int rc_ = 0; rc_ < SP_REPK; ++rc_) compactK<32, 14>(cv, cnt, thr, r32, hh);                                                 \
                if (__any(cnt > 800)) compactK<32, 32>(cv, cnt, thr, r32, hh); }                                                                 \
            const unsigned ib_ = 16383u - (unsigned)((pk_) + r32);                                                                               \
            const unsigned key0 = (f2key(sc0) & 0xFFFFC000u) | ib_, key1 = (f2key(sc1) & 0xFFFFC000u) | (ib_ - 32u);                             \
            const bool f0 = key0 > thr, f1 = key1 > thr;                                                                                         \
            const unsigned m0 = half_of(__ballot(f0), hh), m1 = half_of(__ballot(f1), hh);                                                       \
            const int pos0 = cnt + __popc(m0 & ltm), pos1 = cnt + __popc(m0) + __popc(m1 & ltm);                                                 \
            if (f0) cv[pos0] = key0;                                                                                                             \
            if (f1) cv[pos1] = key1;                                                                                                             \
            cnt += __popc(m0) + __popc(m1);                                                                                                      \
        } while (0)
        const int ns = nkb >> 1;
#pragma unroll 1
        for (int pass_ = 0; pass_ <= SP_DRY; ++pass_) {
        const bool real_ = pass_ == SP_DRY;
        if (SP_DRY) __syncthreads();
        SP_KLOAD(0);
        SP_KWRITE(0);
        __builtin_amdgcn_s_waitcnt(0x0F70);
        __syncthreads();
        if (ntile > 1) SP_KLOAD(1);
        SP_L(0);
#pragma unroll 1
        for (int st = 0; st <= ns; st += 2) {
            for (int rm_ = 0; rm_ < SP_REPM; ++rm_) SP_MR(aX0, aX1, aY0, aY1);
            if (st + 1 < ns) for (int rl_ = 0; rl_ < SP_REPL; ++rl_) SP_L(st + 1);
            if (st > 0 && real_) SP_INS(64 * (st - 1));
            if (st + 1 > ns) break;
            for (int rm_ = 0; rm_ < SP_REPM; ++rm_) SP_MR(aY0, aY1, aX0, aX1);
            if (st + 2 < ns) {
                const int nx = st + 2;
                if ((nx & 3) == 0) {
                    const int T = nx >> 2, b_ = T & 1;
                    SP_KWRITE(b_);
                    { const bool full_ = __any(cnt > 640); if (lane == 0) F.MISC[16 + b_ * 8 + wave] = full_ ? 1u : 0u; }
                    for (int rb_ = 0; rb_ < SP_REPB; ++rb_) __syncthreads();
                    squeeze_ = __any(F.MISC[16 + b_ * 8 + (lane & 7)] != 0u);
                    if (T + 1 < ntile) SP_KLOAD(T + 1);
                }
                for (int rl_ = 0; rl_ < SP_REPL; ++rl_) SP_L(nx);
            }
            if (real_) SP_INS(64 * st);
        }
        }
#undef SP_KLOAD
#undef SP_KWRITE
#undef SP_L
#undef SP_MR
#undef SP_RJ
#undef SP_FMAC
#undef SP_INS
        if (__any(cnt > 256)) {
            compactK<32, 14>(cv, cnt, thr, r32, hh);
            if (__any(cnt > 512)) compactK<32, 32>(cv, cnt, thr, r32, hh); else compactK<16, 32>(cv, cnt, thr, r32, hh);
        }
#pragma unroll
        for (int i = 0; i < 8; ++i) { const int e = r32 + 32 * i; if (e < cnt) sel[hh * 256 + e] = (unsigned short)(16383u - (cv[e] & 0x3FFFu)); }
    }
    LDS_WAIT();
    __syncthreads();
    const int ns0 = __builtin_amdgcn_readlane(cnt, 0), ns1 = __builtin_amdgcn_readlane(cnt, 32);
    const int q4 = c16 >> 2, p4 = c16 & 3;
    const int trx = (q4 << 2) | ((g & 1) << 1);
    const unsigned gb = (unsigned)(uintptr_t)reg;
    unsigned tra[8];
#pragma unroll
    for (int c = 0; c < 8; ++c) tra[c] = gb + 512 * (4 * g + q4) + 8 * (p4 & 1) + 16 * ((2 * c + (p4 >> 1)) ^ trx);
    LAS unsigned short* ol = (LAS unsigned short*)(F.lds + SP_OL + wave * 8192);
#pragma unroll 1
    for (int qi = 0; qi < 2; ++qi) {
        const int tq = tq0 + qi, ns = qi ? ns1 : ns0;
        bf16x8 qf[8];
#pragma unroll
        for (int s = 0; s < 8; ++s) { bf16x8 z = {}; qf[s] = (c16 < 8) ? *(const bf16x8*)(H + (size_t)tq * NPAD + C_CQ + c16 * 256 + 32 * s + 8 * g) : z; }
        f32x4 Z[16];
#pragma unroll
        for (int c = 0; c < 16; ++c) Z[c] = (f32x4){0.f, 0.f, 0.f, 0.f};
        float m = -1e30f, ls = 0.f;
        const int nsb = (ns + 15) >> 4;
        u32x4 datA[8], datB[8];
#define SP_GATHER(d_, j_) do { const int e_ = 16 * (j_) + c16; const int idx_ = (e_ < ns) ? (int)sel[qi * 256 + e_] : 0;                        \
            const bf16_t* rp_ = B_CN(F) + (size_t)idx_ * 256 + 8 * g;                                                                            \
            _Pragma("unroll") for (int i = 0; i < 8; ++i) d_[i] = *(const u32x4*)(rp_ + 32 * i); } while (0)
#define SP_GWRITE(d_) do { _Pragma("unroll") for (int i = 0; i < 8; ++i) *(LAS u32x4*)(reg + goff(c16, 4 * i + g)) = d_[i]; } while (0)
#define TRRD(dst, a, off) asm volatile("ds_read_b64_tr_b16 %0, %1 offset:%2" : "=&v"(dst) : "v"(a), "i"(off) : "memory")
#define SP_QK(d_) do { st = (f32x4){0.f, 0.f, 0.f, 0.f};                                                                                         \
            _Pragma("unroll") for (int s = 0; s < 8; ++s) st = MFMA16(__builtin_bit_cast(bf16x8, d_[s]), qf[s], st); } while (0)
#define SP_STEP(j_) do {                                                                                                                         \
            float mloc = -__builtin_inff();                                                                                                      \
            _Pragma("unroll") for (int r = 0; r < 4; ++r) { const int e = 16 * (j_) + 4 * g + r; const float v = (e < ns) ? st[r] * 0.0625f : -__builtin_inff(); st[r] = v; mloc = fmaxf(mloc, v); } \
            mloc = xmax16(mloc); mloc = xmax32(mloc);                                                                                                      \
            const float mn = fmaxf(m, mloc), alpha = __expf(m - mn);                                                                             \
            float ps = 0.f;                                                                                                                      \
            _Pragma("unroll") for (int r = 0; r < 4; ++r) { const float p = __expf(st[r] - mn); st[r] = p; ps += p; }                            \
            ps = xsum16(ps); ps = xsum32(ps);                                                                                                            \
            ls = ls * alpha + ps; m = mn;                                                                                                        \
            const bf16x8 pa = pack8f(st[0], st[1], st[2], st[3], 0.f, 0.f, 0.f, 0.f);                                                            \
            if (__any(alpha < 1.f)) {                                                                                                            \
                float ar[4];                                                                                                                     \
                _Pragma("unroll") for (int r = 0; r < 4; ++r) ar[r] = bperm_f(4 * g + r, alpha);                                                  \
                _Pragma("unroll") for (int c = 0; c < 16; ++c) _Pragma("unroll") for (int r = 0; r < 4; ++r) Z[c][r] *= ar[r];                   \
            }                                                                                                                                    \
            _Pragma("unroll") for (int c = 0; c < 8; c += 2) {                                                                                   \
                s16x4 l0, l1, l2, l3;                                                                                                            \
                TRRD(l0, tra[c], 0); TRRD(l1, tra[c], 256); TRRD(l2, tra[c + 1], 0); TRRD(l3, tra[c + 1], 256);                                  \
                asm volatile("s_waitcnt lgkmcnt(0)" ::: "memory"); __builtin_amdgcn_sched_barrier(0);                                            \
                Z[c] = MFMA16(pa, ((bf16x8){l0[0], l0[1], l0[2], l0[3], 0, 0, 0, 0}), Z[c]);                                                     \
                Z[c + 8] = MFMA16(pa, ((bf16x8){l1[0], l1[1], l1[2], l1[3], 0, 0, 0, 0}), Z[c + 8]);                                             \
                Z[c + 1] = MFMA16(pa, ((bf16x8){l2[0], l2[1], l2[2], l2[3], 0, 0, 0, 0}), Z[c + 1]);                                             \
                Z[c + 9] = MFMA16(pa, ((bf16x8){l3[0], l3[1], l3[2], l3[3], 0, 0, 0, 0}), Z[c + 9]);                                             \
            } } while (0)
        f32x4 st;
        SP_GATHER(datA, 0);
        if (nsb > 1) SP_GATHER(datB, 1);
        for (int j = 0; j < nsb; j += 2) {
            SP_QK(datA); SP_GWRITE(datA);
            if (j + 2 < nsb) SP_GATHER(datA, j + 2);
            SP_STEP(j);
            if (j + 1 >= nsb) break;
            SP_QK(datB); SP_GWRITE(datB);
            if (j + 3 < nsb) SP_GATHER(datB, j + 3);
            SP_STEP(j + 1);
        }
#undef SP_QK
#undef SP_STEP
#undef TRRD
#undef SP_GATHER
#undef SP_GWRITE
        float inv[4];
#pragma unroll
        for (int r = 0; r < 4; ++r) inv[r] = 1.f / bperm_f(4 * g + r, ls);
        if (g < 2) {
#pragma unroll
            for (int c = 0; c < 16; ++c) {
                const int lat = 16 * c + c16;
#pragma unroll
                for (int r = 0; r < 4; ++r) ol[(qi * 8 + 4 * g + r) * 256 + lat] = (unsigned short)(cvtpk_c(Z[c][r] * inv[r], 0.f) & 0xffffu);
            }
        }
    }
    unsigned short gtv[8][4];
#pragma unroll
    for (int n = 0; n < 8; ++n)
#pragma unroll
        for (int r = 0; r < 4; ++r) gtv[n][r] = H[(size_t)(t0 + 4 * g + r) * NPAD + C_CG + wave * 128 + 16 * n + c16];
    LDS_WAIT();
    __syncthreads();
    {
        const int hd = wave;
        bf16x8 A[8];
#pragma unroll
        for (int s = 0; s < 8; ++s) A[s] = *(const LAS bf16x8*)(F.lds + SP_OL + (c16 >> 1) * 8192 + (((c16 & 1) * 8 + hd) * 256 + 32 * s + 8 * g) * 2);
        const bf16_t* wb = B_WUVT(F) + ((size_t)(l * 8 + hd) * 128 + c16) * 256 + 8 * g;
#pragma unroll 1
        for (int n4 = 0; n4 < 2; ++n4) {
            bf16x8 b[4][8];
#pragma unroll
            for (int n = 0; n < 4; ++n)
#pragma unroll
                for (int s = 0; s < 8; ++s) b[n][s] = *(const bf16x8*)(wb + (size_t)(4 * n4 + n) * 16 * 256 + 32 * s);
#pragma unroll
            for (int n = 0; n < 4; ++n) {
                f32x4 acc = (f32x4){0.f, 0.f, 0.f, 0.f};
#pragma unroll
                for (int s = 0; s < 8; ++s) acc = MFMA16(A[s], b[n][s], acc);
#pragma unroll
                for (int r = 0; r < 4; ++r) { const int t = t0 + 4 * g + r; const int col = hd * 128 + 16 * (4 * n4 + n) + c16;
                    const float gt = bf2f(n4 ? gtv[4 + n][r] : gtv[n][r]);
                    B_O(F)[(size_t)t * DM + 3072 + col] = (bf16_t)(cvtpk_c(acc[r] * silu(gt), 0.f) & 0xffffu); }
            }
        }
    }
}
namespace da2 {
constexpr int VB = 32768, KB0 = 98304, KBS = 16384;
constexpr float C2 = 0.08838834764831845f * 1.4426950408889634f;
static_assert(KB0 + 3 * KBS <= MISC_OFF, "da2 LDS map");
__device__ __forceinline__ void block(Frame& F, int id) {
    int tid_ = F.wave * 64 + hw_lane(); asm volatile("" : "+v"(tid_));
    const int tid = tid_, lane = tid & 63, c16 = lane & 15, g = lane >> 4, wave = F.wave;
    const int qb = 127 - (id >> 3), hm = id & 7, hd = hm >> 1, mp = hm & 1;
    const int P0 = 128 * qb, NT = 2 * qb + 2;
    const int cw = (P0 + 16 * wave) >> 6;
    const bf16_t* H = B_H(F);
    LAS unsigned char* lds = F.lds;
    bf16x8 qf[4];
#pragma unroll
    for (int s = 0; s < 4; ++s) qf[s] = *(const bf16x8*)(H + (size_t)(P0 + 16 * wave + c16) * NPAD + C_BQ + hd * 256 + mp * 128 + 32 * s + 8 * g);
    const bf16_t* Kb = H + C_BK + hd * 256 + mp * 128;
    const bf16_t* Vb = H + C_BV + hd * 256;
    int kofs[2], vofs[4];
#pragma unroll
    for (int i = 0; i < 2; ++i) { const int row = 8 * wave + 4 * i + (lane >> 4); kofs[i] = row * NPAD + 8 * ((lane & 15) ^ (row & 15)); }
#pragma unroll
    for (int i = 0; i < 4; ++i) { const int row = 8 * wave + 2 * i + (lane >> 5), sl = lane & 31; vofs[i] = row * NPAD + 8 * ((sl & 16) | ((sl & 15) ^ (((row & 3) << 2) | (((row >> 2) & 1) << 1)))); }
    int ksw[4];
#pragma unroll
    for (int s = 0; s < 4; ++s) ksw[s] = KB0 + c16 * 256 + (((4 * s + g) ^ c16) * 16);
    const int q4 = c16 >> 2, p4 = c16 & 3, trx = (q4 << 2) | ((g & 1) << 1);
    const unsigned lb = (unsigned)(uintptr_t)lds;
    unsigned tra[8];
#pragma unroll
    for (int c = 0; c < 8; ++c) { tra[c] = lb + 512 * (4 * g + q4) + 8 * (p4 & 1) + 16 * ((2 * c + (p4 >> 1)) ^ trx); }
    f32x4 O[16];
#pragma unroll
    for (int c = 0; c < 16; ++c) O[c] = (f32x4){0.f, 0.f, 0.f, 0.f};
    float m = -1e30f, l = 0.f;
    f32x4 st[4], sn[4];
#define DA_DMAK(t_, slot_) do { const int tt_ = (t_) < NT ? (t_) : NT - 1; _Pragma("unroll") for (int i = 0; i < 2; ++i)                                \
        __builtin_amdgcn_global_load_lds((const unsigned*)(Kb + (size_t)(64 * tt_) * NPAD + kofs[i]), (LAS unsigned*)(lds + KB0 + (slot_) * KBS + (2 * wave + i) * 1024), 16, 0, 0); } while (0)
#define DA_DMAV(t_, buf_) do { const int tt_ = (t_) < NT ? (t_) : NT - 1; _Pragma("unroll") for (int i = 0; i < 4; ++i)                                 \
        __builtin_amdgcn_global_load_lds((const unsigned*)(Vb + (size_t)(64 * tt_) * NPAD + vofs[i]), (LAS unsigned*)(lds + (buf_) * VB + (4 * wave + i) * 1024), 16, 0, 0); } while (0)
#define DA_TR(dst, a, off) asm volatile("ds_read_b64_tr_b16 %0, %1 offset:%2" : "=&v"(dst) : "v"(a), "i"(off) : "memory")
#define DA_TR8(A_, c_, o_, L0, H0, L1, H1, L2, H2, L3, H3) do { const unsigned ta_ = tra[c_] + (A_);                                             \
        DA_TR(L0, ta_, (o_) + 0); DA_TR(H0, ta_, (o_) + 8192); DA_TR(L1, ta_, (o_) + 256); DA_TR(H1, ta_, (o_) + 8448);                           \
        DA_TR(L2, ta_, (o_) + 16384); DA_TR(H2, ta_, (o_) + 24576); DA_TR(L3, ta_, (o_) + 16640); DA_TR(H3, ta_, (o_) + 24832); } while (0)
#define DA_MM4(c_, L0, H0, L1, H1, L2, H2, L3, H3) do {                                                                                          \
        O[c_] = MFMA16(pa0, ((bf16x8){L0[0], L0[1], L0[2], L0[3], H0[0], H0[1], H0[2], H0[3]}), O[c_]);                                          \
        O[c_ + 8] = MFMA16(pa0, ((bf16x8){L1[0], L1[1], L1[2], L1[3], H1[0], H1[1], H1[2], H1[3]}), O[c_ + 8]);                                  \
        O[c_] = MFMA16(pa1, ((bf16x8){L2[0], L2[1], L2[2], L2[3], H2[0], H2[1], H2[2], H2[3]}), O[c_]);                                          \
        O[c_ + 8] = MFMA16(pa1, ((bf16x8){L3[0], L3[1], L3[2], L3[3], H3[0], H3[1], H3[2], H3[3]}), O[c_ + 8]); } while (0)
#define DA_WAITL(n_) do { asm volatile("s_waitcnt lgkmcnt(" #n_ ")" ::: "memory"); __builtin_amdgcn_sched_barrier(0); } while (0)
#define DA_QK(dst_, koff_) do { bf16x8 a_[4][4];                            \
        _Pragma("unroll") for (int T = 0; T < 4; ++T) _Pragma("unroll") for (int s = 0; s < 4; ++s) a_[T][s] = *(const LAS bf16x8*)(lds + (koff_) + ksw[s] + T * 4096); \
        asm volatile("" : "+v"(a_[0][0]), "+v"(a_[0][1]), "+v"(a_[0][2]), "+v"(a_[0][3]), "+v"(a_[1][0]), "+v"(a_[1][1]), "+v"(a_[1][2]), "+v"(a_[1][3]), \
                          "+v"(a_[2][0]), "+v"(a_[2][1]), "+v"(a_[2][2]), "+v"(a_[2][3]), "+v"(a_[3][0]), "+v"(a_[3][1]), "+v"(a_[3][2]), "+v"(a_[3][3])); \
        _Pragma("unroll") for (int T = 0; T < 4; ++T) dst_[T] = (f32x4){0.f, 0.f, 0.f, 0.f};                                                     \
        _Pragma("unroll") for (int s = 0; s < 4; ++s) _Pragma("unroll") for (int T = 0; T < 4; ++T) dst_[T] = MFMA16(a_[T][s], qf[s], dst_[T]); } while (0)
#define DA_SM() \
        float mloc = st[0][0];                                                                                                                   \
        _Pragma("unroll") for (int T = 0; T < 4; ++T) _Pragma("unroll") for (int r = 0; r < 4; ++r) mloc = fmaxf(mloc, st[T][r]);                \
        mloc = xmax16(mloc); mloc = xmax32(mloc);                                              \
        const float mn = fmaxf(m, mloc), alpha = __builtin_amdgcn_exp2f((m - mn) * C2), mnL = -mn * C2;                                         \
        float ps = 0.f;                                                                                                                          \
        _Pragma("unroll") for (int T = 0; T < 4; ++T) _Pragma("unroll") for (int r = 0; r < 4; ++r) { const float p = __builtin_amdgcn_exp2f(fmaf(st[T][r], C2, mnL)); st[T][r] = p; ps += p; } \
        ps = xsum16(ps); ps = xsum32(ps);                                                                              \
        l = l * alpha + ps; m = mn;                                                                                                              \
        const bf16x8 pa0 = pack8f(st[0][0], st[0][1], st[0][2], st[0][3], st[1][0], st[1][1], st[1][2], st[1][3]);                               \
        const bf16x8 pa1 = pack8f(st[2][0], st[2][1], st[2][2], st[2][3], st[3][0], st[3][1], st[3][2], st[3][3]);
#define DA_RESC() do { if (__any(alpha < 1.f)) { float ar[4];                                                                                    \
            _Pragma("unroll") for (int r = 0; r < 4; ++r) ar[r] = bperm_f(4 * g + r, alpha);                                                     \
            _Pragma("unroll") for (int c = 0; c < 16; ++c) _Pragma("unroll") for (int r = 0; r < 4; ++r) O[c][r] *= ar[r]; } } while (0)
#define DA_PV(A_, o_) do { s16x4 xl0, xh0, xl1, xh1, xl2, xh2, xl3, xh3, yl0, yh0, yl1, yh1, yl2, yh2, yl3, yh3;                                 \
          LDS_WAIT();                                                                                                                            \
          DA_TR8(A_, 0, o_, xl0, xh0, xl1, xh1, xl2, xh2, xl3, xh3);                                                                             \
          DA_TR8(A_, 1, o_, yl0, yh0, yl1, yh1, yl2, yh2, yl3, yh3); DA_WAITL(8); DA_MM4(0, xl0, xh0, xl1, xh1, xl2, xh2, xl3, xh3);             \
          DA_TR8(A_, 2, o_, xl0, xh0, xl1, xh1, xl2, xh2, xl3, xh3); DA_WAITL(8); DA_MM4(1, yl0, yh0, yl1, yh1, yl2, yh2, yl3, yh3);             \
          DA_TR8(A_, 3, o_, yl0, yh0, yl1, yh1, yl2, yh2, yl3, yh3); DA_WAITL(8); DA_MM4(2, xl0, xh0, xl1, xh1, xl2, xh2, xl3, xh3);             \
          DA_TR8(A_, 4, o_, xl0, xh0, xl1, xh1, xl2, xh2, xl3, xh3); DA_WAITL(8); DA_MM4(3, yl0, yh0, yl1, yh1, yl2, yh2, yl3, yh3);             \
          DA_TR8(A_, 5, o_, yl0, yh0, yl1, yh1, yl2, yh2, yl3, yh3); DA_WAITL(8); DA_MM4(4, xl0, xh0, xl1, xh1, xl2, xh2, xl3, xh3);             \
          DA_TR8(A_, 6, o_, xl0, xh0, xl1, xh1, xl2, xh2, xl3, xh3); DA_WAITL(8); DA_MM4(5, yl0, yh0, yl1, yh1, yl2, yh2, yl3, yh3);             \
          DA_TR8(A_, 7, o_, yl0, yh0, yl1, yh1, yl2, yh2, yl3, yh3); DA_WAITL(8); DA_MM4(6, xl0, xh0, xl1, xh1, xl2, xh2, xl3, xh3);             \
          DA_WAITL(0); DA_MM4(7, yl0, yh0, yl1, yh1, yl2, yh2, yl3, yh3); } while (0)
#define DA_ITER(t_, p_, A_, o_) do {                                                                                                             \
        asm volatile("s_waitcnt vmcnt(6)" ::: "memory"); __builtin_amdgcn_s_barrier(); asm volatile("" ::: "memory");                            \
        DA_DMAK((t_) + 3, (p_)); DA_DMAV((t_) + 2, ((p_) + 2) % 3);                                                                              \
        const bool nxt_ = ((t_) + 1 < NT) && ((t_) + 1 <= cw);                                                                                   \
          \
        if (nxt_) DA_QK(sn, (((p_) + 1) % 3) * KBS);                                                                                             \
        if ((t_) <= cw) { DA_SM() DA_RESC(); DA_PV(A_, o_); }                                                                                    \
        if (nxt_) { _Pragma("unroll") for (int T = 0; T < 4; ++T) st[T] = sn[T]; } } while (0)
    asm volatile("s_waitcnt vmcnt(0)" ::: "memory");
    __syncthreads();
    DA_DMAK(0, 0); DA_DMAV(0, 0); DA_DMAK(1, 1);
    DA_DMAK(2, 2); DA_DMAV(1, 1);
    asm volatile("s_waitcnt vmcnt(6)" ::: "memory"); __builtin_amdgcn_s_barrier(); asm volatile("" ::: "memory");
    DA_QK(st, 0);
    for (int t = 0; t < NT; t += 3) {
        DA_ITER(t, 0, 0u, 0);
        if (t + 1 >= NT) break;
        DA_ITER(t + 1, 1, 0u, 32768);
        if (t + 2 >= NT) break;
        DA_ITER(t + 2, 2, 65536u, 0);
    }
    asm volatile("s_waitcnt vmcnt(0)" ::: "memory");
#undef DA_ITER
#undef DA_PV
#undef DA_RESC
#undef DA_SM
#undef DA_QK
#undef DA_TR8
#undef DA_MM4
#undef DA_WAITL
#undef DA_TR
#undef DA_DMAK
#undef DA_DMAV
    float inv[4];
#pragma unroll
    for (int r = 0; r < 4; ++r) inv[r] = 1.f / bperm_f(4 * g + r, l);
    float* Op = B_OD(F) + (size_t)(P0 + 16 * wave + 4 * g) * 2048 + hd * 512 + mp * 256 + c16;
#pragma unroll
    for (int c = 0; c < 16; ++c)
#pragma unroll
        for (int r = 0; r < 4; ++r) Op[(size_t)r * 2048 + 16 * c] = O[c][r] * inv[r];
}
}
__device__ __forceinline__ dattn::BlockRef dattn_ref(const bf16_t* H, float* OD, int id) {
    dattn::BlockRef r; const int qb = 63 - (id >> 4), ph = id & 15, hd = ph >> 2, mp = (ph >> 1) & 1, e = ph & 1;
    r.Q = H + (size_t)(qb * 256) * NPAD + C_BQ + hd * 256 + mp * 128; r.K = H + C_BK + hd * 256 + mp * 128; r.V = H + C_BV + hd * 256 + e * 128;
    r.O = OD + (size_t)(qb * 256) * 2048 + hd * 512 + mp * 256 + e * 128; r.P0 = qb * 256; return r;
}
#ifndef REPP
#define REPP 1
#endif
#ifndef REPBAR
#define REPBAR 1
#endif
#ifndef REPA
#define REPA 1
#endif
#ifndef REPB
#define REPB 1
#endif
#ifndef REPC
#define REPC 1
#endif
#ifndef REPG1
#define REPG1 1
#endif
#ifndef REPS
#define REPS 1
#endif
#ifndef MIXMASK
#define MIXMASK 7
#endif
__device__ __forceinline__ void mix_phase(Frame& F, int l) {
    if (MIXMASK & 1) for (int rep = 0; rep < REPA; ++rep) { const int qx = rep * 16 + l * 4 + 0;
        for (int u = grab(F, qx); u < 16; u = grab(F, qx)) gla_unit(F, u); }
#ifndef USE_DA2
#define USE_DA2 1
#endif
#if USE_DA2
    if (MIXMASK & 2) for (int rep = 0; rep < REPB; ++rep) { const int qx = rep * 16 + l * 4 + 1;
        for (int u = grab(F, qx); u < 1024; u = grab(F, qx)) da2::block(F, u);
        __syncthreads();
    }
#else
    if (MIXMASK & 2) for (int rep = 0; rep < REPB; ++rep) { const int qx = rep * 16 + l * 4 + 1;
        int cur = grab(F, qx);
        if (cur < 1024) {
            dattn::Seam S;
            dattn::BlockRef rc = dattn_ref(B_H(F), B_OD(F), cur);
            dattn::prime(rc, (char*)F.lds, S, F.wave);
            for (;;) {
                const int nx = grab(F, qx); const bool last = nx >= 1024;
                const dattn::BlockRef rn = last ? rc : dattn_ref(B_H(F), B_OD(F), nx);
                dattn::block(rc, rn, (char*)F.lds, S, F.wave);
                if (last) break;
                rc = rn;
            }
            VM_WAIT(); __syncthreads();
        }
    }
#endif
    if (MIXMASK & 4) for (int rep = 0; rep < REPC; ++rep) { const int qx = rep * 16 + l * 4 + 2;
        for (int u = grab(F, qx); u < SEQ / 16; u = grab(F, qx)) sparse_unit(F, l, SEQ / 16 - 1 - u); }
}

struct Args { const float* in[14]; float* out; unsigned char* ws; int ph_lo, ph_hi, li, pad; };
constexpr int NPHASE = 1 + 6 * DEPTH;
__global__ void __launch_bounds__(NWAVES * 64, 2) trunk_fwd(Args args) {
    extern __shared__ __attribute__((aligned(16))) unsigned char lds[];
    Frame F;
    F.lds = (LAS unsigned char*)lds;
    F.MISC = (volatile LAS unsigned*)(F.lds + MISC_OFF);
    F.wave = __builtin_amdgcn_readfirstlane((int)threadIdx.x >> 6);
    F.G = gridDim.x; { const int bx = blockIdx.x; F.vcu = (F.G % 8 == 0) ? (bx % 8) * (F.G / 8) + bx / 8 : bx; }
    F.ws = args.ws;
    F.ctl = (gu32*)(args.ws + WS_CTL);
    if (threadIdx.x < 128) ((LAS unsigned*)(F.lds + MISC_OFF))[threadIdx.x] = 0u;
    __syncthreads();
    XcdBarrier bar = xcd_barrier_post((unsigned*)(F.ctl + CW_BAR), F.MISC + 0);
#ifndef PMASK
#define PMASK 0x7f
#endif
#define IN(k) true
#define SEAM(k) do { if ((k) + 1 < NPHASE) { XcdBarrier b2_ = bar; unsigned xx_ = b2_.x; asm volatile("" : "+s"(xx_)); b2_.x = xx_; for (int rb_ = 0; rb_ < REPBAR; ++rb_) xcd_barrier(b2_); } } while (0)
    if ((PMASK & 1) && IN(0)) { for (int rp_ = 0; rp_ < REPP; ++rp_) p0_prologue(F, args.in[0], args.in[1], args.in[2], args.in[11]); SEAM(0); }
    for (int l = 0; l < DEPTH; ++l) {
        const int pb = 1 + 6 * l;
        const float lam_init = 0.8f - 0.6f * expf(-0.3f * (float)l);
        if ((PMASK & 2) && IN(pb + 0)) {
            pg8::Gemm g{B_XB(F), B_WTIN(F) + (size_t)l * NPAD * DM, SEQ, NPAD, DM}; pg8::StaticOrder S; S.init(SEQ, NPAD, F.G, (int)blockIdx.x);
            pg8::EpiBf16Plain E{B_H(F), NPAD};
            for (int rep = 0; rep < REPG1; ++rep) pg8::gemm_phase<pg8::EpiBf16Plain, pg8::StaticOrder, true, true>(F.lds, g, S, E, F.wave);
            SEAM(pb + 0);
        }
        if ((PMASK & 4) && IN(pb + 1)) { for (int rep = 0; rep < REPS; ++rep) prep_phase(F, l, args.in[3], args.in[4], args.in[8], args.in[9], args.in[10]); SEAM(pb + 1); }
        if ((PMASK & 8) && IN(pb + 2)) { mix_phase(F, l); SEAM(pb + 2); }
        if ((PMASK & 16) && IN(pb + 3)) { for (int rep = 0; rep < REPS; ++rep) post_phase(F, l, lam_init, args.in[5], args.in[6], args.in[7]); SEAM(pb + 3); }
        if ((PMASK & 32) && IN(pb + 4)) {
            pg8::Gemm g{B_O(F), B_WTOUT(F) + (size_t)l * DM * DM, SEQ, DM, DM}; pg8::StaticOrder S; S.init(SEQ, DM, F.G, (int)blockIdx.x);
            pg8::EpiResid E{l == 0 ? args.in[0] : B_XF(F), B_XF(F), DM, 1.6817928305074290f};
            pg8::gemm_phase<pg8::EpiResid, pg8::StaticOrder, true, true>(F.lds, g, S, E, F.wave);
            SEAM(pb + 4);
        }
        if ((PMASK & 64) && IN(pb + 5)) {
#if defined(REPLN)
            ln_phase(F, l, args.in[12], args.in[13], args.out, true);
#endif
            ln_phase(F, l, args.in[12], args.in[13], args.out, false); SEAM(pb + 5); }
    }
#undef IN
#undef SEAM
}

#ifndef MK_N_LAUNCHES
#define MK_N_LAUNCHES 1
#endif
extern "C" void kernel_launch(void* const* d_in, const int* in_sizes, int n_in, void* d_out, int out_size, void* d_ws, size_t ws_size, hipStream_t stream) {
    static int grid = 0;
    if (grid == 0) {
        if (n_in != 14 || in_sizes[0] != SEQ * DM || out_size != SEQ * DM || ws_size < WS_END) {
            fprintf(stderr, "kernel_launch: shape mismatch (n_in %d, in0 %d, out %d, ws %zu; need ws >= %zu)\n", n_in, n_in > 0 ? in_sizes[0] : -1, out_size, ws_size, (size_t)WS_END); grid = -1; return; }
        int dev = 0, cus = 0, per_cu = 0;
        if (hipGetDevice(&dev) != hipSuccess || hipDeviceGetAttribute(&cus, hipDeviceAttributeMultiprocessorCount, dev) != hipSuccess) { grid = -1; return; }
        if (hipFuncSetAttribute((const void*)trunk_fwd, hipFuncAttributeMaxDynamicSharedMemorySize, LDS_BYTES) != hipSuccess) { fprintf(stderr, "kernel_launch: hipFuncSetAttribute failed\n"); grid = -1; return; }
        if (hipOccupancyMaxActiveBlocksPerMultiprocessor(&per_cu, (const void*)trunk_fwd, NWAVES * 64, LDS_BYTES) != hipSuccess || per_cu < 1)
            fprintf(stderr, "kernel_launch: occupancy query reports %d workgroups per CU\n", per_cu);
        (void)hipGetLastError();
        grid = cus;
    }
    if (grid < 0) return;
    if (hipMemsetAsync((char*)d_ws + WS_CTL, 0, CTL_ZERO_BYTES, stream) != hipSuccess) return;
    Args a{};
    for (int i = 0; i < 14; ++i) a.in[i] = (const float*)d_in[i];
    a.out = (float*)d_out; a.ws = (unsigned char*)d_ws;
    a.ph_lo = 0; a.ph_hi = NPHASE; a.li = 0; a.pad = 0;
    hipLaunchKernelGGL(trunk_fwd, dim3(grid), dim3(NWAVES * 64), LDS_BYTES, stream, a);
    const hipError_t le = hipPeekAtLastError();
    if (le != hipSuccess) fprintf(stderr, "kernel_launch: launch failed: %s\n", hipGetErrorName(le));
}
```
